# Optimizing an MI355X kernel written in HIP

```python
import math
import jax, jax.numpy as jnp
from jax import lax
import numpy as np

D_MODEL = 1024
BATCH = 16
SEQ = 4096
DEPTH = 4

CHUNK = 64
SSM_WIDTH = D_MODEL // 2
SSM_GROUP = 16
SSM_GROUPS = SSM_WIDTH // SSM_GROUP
SSM_STATE = 64
DT_MIN = 1e-3
DT_MAX = 1e-1
ATT_WIDTH = D_MODEL // 2
ATT_HEAD_DIM = 64
ATT_HEADS = ATT_WIDTH // ATT_HEAD_DIM
LEFT_CHUNKS = 8
BAND = (LEFT_CHUNKS + 1) * CHUNK
MAX_REL = 128
N_REL = 2 * MAX_REL + 1
D_FF = ((8 * D_MODEL // 3 + 127) // 128) * 128
IN_WIDTH = SSM_WIDTH + 3 * ATT_WIDTH + 2 * D_MODEL
RMS_EPS = 1e-6
MASK_VALUE = -1e30

kernel_name = "hybrid_s5_chunkattn_macaron_sandwich"


def rmsnorm(x, g):
    xf = x.astype(jnp.float32)
    y = xf * lax.rsqrt(jnp.mean(xf * xf, axis=-1, keepdims=True) + RMS_EPS)
    return (y * g.astype(jnp.float32)).astype(x.dtype)


def swiglu(h, w_gate, w_up, w_down):
    return (jax.nn.silu(h @ w_gate) * (h @ w_up)) @ w_down


def s5_scan(u, lam_re, lam_im, log_dt, b_re, b_im, c_re, c_im, d_skip):
    dtype = u.dtype
    bsz, seq, _ = u.shape
    f32 = jnp.float32
    uf = u.astype(f32).reshape(bsz, seq, SSM_GROUPS, SSM_GROUP)
    lr, li = lam_re.astype(f32), lam_im.astype(f32)
    dt = jnp.exp(log_dt.astype(f32))[:, None]
    mag = jnp.exp(lr * dt)
    ang = li * dt
    ab_re, ab_im = mag * jnp.cos(ang), mag * jnp.sin(ang)
    nr, ni = ab_re - 1.0, ab_im
    den = lr * lr + li * li
    f_re = (nr * lr + ni * li) / den
    f_im = (ni * lr - nr * li) / den
    br, bi = b_re.astype(f32), b_im.astype(f32)
    bb_re = f_re[..., None] * br - f_im[..., None] * bi
    bb_im = f_re[..., None] * bi + f_im[..., None] * br
    bu_re = jnp.einsum('bsgh,gph->bsgp', uf, bb_re)
    bu_im = jnp.einsum('bsgh,gph->bsgp', uf, bb_im)
    a_re = jnp.broadcast_to(ab_re, (1, seq, SSM_GROUPS, SSM_STATE))
    a_im = jnp.broadcast_to(ab_im, (1, seq, SSM_GROUPS, SSM_STATE))

    def combine(left, right):
        la_re, la_im, lb_re, lb_im = left
        ra_re, ra_im, rb_re, rb_im = right
        return (ra_re * la_re - ra_im * la_im,
                ra_re * la_im + ra_im * la_re,
                ra_re * lb_re - ra_im * lb_im + rb_re,
                ra_re * lb_im + ra_im * lb_re + rb_im)

    _, _, s_re, s_im = lax.associative_scan(combine, (a_re, a_im, bu_re, bu_im), axis=1)
    y = (jnp.einsum('bsgp,ghp->bsgh', s_re, c_re.astype(f32))
         - jnp.einsum('bsgp,ghp->bsgh', s_im, c_im.astype(f32))
         + d_skip.astype(f32) * uf)
    return y.reshape(bsz, seq, SSM_WIDTH).astype(dtype)


def chunk_attention(q, k, v, rel_bias):
    bsz, seq = q.shape[0], q.shape[1]
    n_chunks = seq // CHUNK
    pad = LEFT_CHUNKS * CHUNK
    kp = jnp.pad(k, ((0, 0), (pad, 0), (0, 0), (0, 0)))
    vp = jnp.pad(v, ((0, 0), (pad, 0), (0, 0), (0, 0)))
    qc = q.reshape(bsz, n_chunks, CHUNK, ATT_HEADS, ATT_HEAD_DIM).transpose(1, 0, 2, 3, 4)
    rel = (jnp.arange(CHUNK)[:, None] + pad) - jnp.arange(BAND)[None, :]
    rel_idx = jnp.clip(rel, -MAX_REL, MAX_REL) + MAX_REL
    bias = rel_bias.astype(jnp.float32)[:, rel_idx]
    scale = ATT_HEAD_DIM ** -0.5

    def one_chunk(args):
        c, q_blk = args
        start = c * CHUNK
        k_band = lax.dynamic_slice_in_dim(kp, start, BAND, axis=1)
        v_band = lax.dynamic_slice_in_dim(vp, start, BAND, axis=1)
        s = jnp.einsum('bqhd,bkhd->bhqk', q_blk, k_band).astype(jnp.float32) * scale + bias
        valid = (start - pad + jnp.arange(BAND)) >= 0
        s = jnp.where(valid, s, MASK_VALUE)
        p = jax.nn.softmax(s, axis=-1).astype(v.dtype)
        return jnp.einsum('bhqk,bkhd->bqhd', p, v_band)

    out = lax.map(one_chunk, (jnp.arange(n_chunks), qc))
    return out.transpose(1, 0, 2, 3, 4).reshape(bsz, seq, ATT_WIDTH)


def hybrid_mixer(h, w_in, lam_re, lam_im, log_dt, b_re, b_im, c_re, c_im, d_skip,
                 w_glu_val, w_glu_gate, w_out_ssm, rel_bias, w_out_att, w_o):
    bsz, seq, _ = h.shape
    proj = h @ w_in
    o1 = SSM_WIDTH
    o2 = o1 + ATT_WIDTH
    o3 = o2 + ATT_WIDTH
    o4 = o3 + ATT_WIDTH
    o5 = o4 + D_MODEL
    u, q, k, v, g_a, g_b = jnp.split(proj, [o1, o2, o3, o4, o5], axis=-1)
    y_a = jax.nn.gelu(s5_scan(u, lam_re, lam_im, log_dt, b_re, b_im, c_re, c_im, d_skip))
    y_a = ((y_a @ w_glu_val) * jax.nn.sigmoid(y_a @ w_glu_gate)) @ w_out_ssm
    hs = (bsz, seq, ATT_HEADS, ATT_HEAD_DIM)
    y_b = chunk_attention(q.reshape(hs), k.reshape(hs), v.reshape(hs), rel_bias) @ w_out_att
    merged = jax.nn.sigmoid(g_a) * y_a + jax.nn.sigmoid(g_b) * y_b
    return merged @ w_o


def setup_inputs(seed: int = 0) -> dict:
    key = jax.random.key(seed)
    ks = jax.random.split(key, 20)
    f32 = jnp.float32
    L, G, P, H = DEPTH, SSM_GROUPS, SSM_STATE, SSM_GROUP

    def nrm(k, shape, scale):
        return jax.random.normal(k, shape, f32) * scale

    x = jax.random.normal(ks[0], (BATCH, SEQ, D_MODEL), f32)
    norm_gains = 1.0 + nrm(ks[1], (L, 6, D_MODEL), 0.05)
    ffn_w_gate = nrm(ks[2], (L, 2, D_MODEL, D_FF), D_MODEL ** -0.5)
    ffn_w_up = nrm(ks[3], (L, 2, D_MODEL, D_FF), D_MODEL ** -0.5)
    ffn_w_down = nrm(ks[4], (L, 2, D_FF, D_MODEL), D_FF ** -0.5)
    w_in = nrm(ks[5], (L, D_MODEL, IN_WIDTH), D_MODEL ** -0.5)
    lam_re = -0.5 + nrm(ks[6], (L, G, P), 0.01)
    lam_im = jnp.pi * jnp.arange(P, dtype=f32) + nrm(ks[7], (L, G, P), 0.01)
    log_dt = math.log(DT_MIN) + jax.random.uniform(ks[8], (L, G), f32) * (math.log(DT_MAX) - math.log(DT_MIN))
    b_re = nrm(ks[9], (L, G, P, H), (2 * H) ** -0.5)
    b_im = nrm(ks[10], (L, G, P, H), (2 * H) ** -0.5)
    c_re = nrm(ks[11], (L, G, H, P), P ** -0.5)
    c_im = nrm(ks[12], (L, G, H, P), P ** -0.5)
    d_skip = nrm(ks[13], (L, G, H), 1.0)
    w_glu_val = nrm(ks[14], (L, SSM_WIDTH, SSM_WIDTH), SSM_WIDTH ** -0.5)
    w_glu_gate = nrm(ks[15], (L, SSM_WIDTH, SSM_WIDTH), SSM_WIDTH ** -0.5)
    w_out_ssm = nrm(ks[16], (L, SSM_WIDTH, D_MODEL), SSM_WIDTH ** -0.5)
    rel_bias = nrm(ks[17], (L, ATT_HEADS, N_REL), 0.1)
    w_out_att = nrm(ks[18], (L, ATT_WIDTH, D_MODEL), ATT_WIDTH ** -0.5)
    w_o = nrm(ks[19], (L, D_MODEL, D_MODEL), D_MODEL ** -0.5)
    return {"x": x, "norm_gains": norm_gains, "ffn_w_gate": ffn_w_gate,
            "ffn_w_up": ffn_w_up, "ffn_w_down": ffn_w_down, "w_in": w_in,
            "lam_re": lam_re, "lam_im": lam_im, "log_dt": log_dt,
            "b_re": b_re, "b_im": b_im, "c_re": c_re, "c_im": c_im,
            "d_skip": d_skip, "w_glu_val": w_glu_val, "w_glu_gate": w_glu_gate,
            "w_out_ssm": w_out_ssm, "rel_bias": rel_bias, "w_out_att": w_out_att,
            "w_o": w_o}


def reference(x, norm_gains, ffn_w_gate, ffn_w_up, ffn_w_down, w_in,
              lam_re, lam_im, log_dt, b_re, b_im, c_re, c_im, d_skip,
              w_glu_val, w_glu_gate, w_out_ssm, rel_bias, w_out_att, w_o):
    for l in range(DEPTH):
        g = norm_gains[l]
        f1 = swiglu(rmsnorm(x, g[0]), ffn_w_gate[l, 0], ffn_w_up[l, 0], ffn_w_down[l, 0])
        x = x + 0.5 * rmsnorm(f1, g[1])
        m = hybrid_mixer(rmsnorm(x, g[2]), w_in[l], lam_re[l], lam_im[l], log_dt[l],
                         b_re[l], b_im[l], c_re[l], c_im[l], d_skip[l],
                         w_glu_val[l], w_glu_gate[l], w_out_ssm[l],
                         rel_bias[l], w_out_att[l], w_o[l])
        x = x + rmsnorm(m, g[3])
        f2 = swiglu(rmsnorm(x, g[4]), ffn_w_gate[l, 1], ffn_w_up[l, 1], ffn_w_down[l, 1])
        x = x + 0.5 * rmsnorm(f2, g[5])
    return x
```

```cpp
#include <hip/hip_runtime.h>
#include <hip/hip_cooperative_groups.h>
#include <cstdio>
#include <cstdint>
namespace cg = cooperative_groups;

#define LAS __attribute__((address_space(3)))
typedef unsigned short bf16_t;
typedef short bf16x8 __attribute__((ext_vector_type(8)));
typedef short s16x4 __attribute__((ext_vector_type(4)));
typedef float f32x4 __attribute__((ext_vector_type(4)));
typedef float f32x2 __attribute__((ext_vector_type(2)));
typedef float f32x16 __attribute__((ext_vector_type(16)));
typedef unsigned u32x4 __attribute__((ext_vector_type(4)));
typedef unsigned u32x2 __attribute__((ext_vector_type(2)));
typedef __bf16 bf2_t __attribute__((ext_vector_type(2)));
#define DI __device__ __forceinline__

constexpr int NTOK = 65536, DM = 1024, FF = 2816, NL = 4, NGRP = 32, SEQ = 4096;
constexpr float RMS_EPS = 1e-6f;
constexpr int NTHREADS = 512, NWAVES = 8;
constexpr int LDS_BYTES = 131072;

constexpr size_t SZ_WGU = (size_t)5632 * 1024 * 2, SZ_WD = (size_t)1024 * 2816 * 2, SZ_WIN = (size_t)4096 * 1024 * 2;
constexpr size_t SZ_WGL = (size_t)1024 * 512 * 2, SZ_WOUT = (size_t)1024 * 1024 * 2, SZ_WO = (size_t)1024 * 1024 * 2;
constexpr size_t OFF_WGU = 0;
constexpr size_t OFF_WD = OFF_WGU + 8 * SZ_WGU;
constexpr size_t OFF_WIN = OFF_WD + 8 * SZ_WD;
constexpr size_t OFF_WGL = OFF_WIN + 4 * SZ_WIN;
constexpr size_t OFF_WOUT = OFF_WGL + 4 * SZ_WGL;
constexpr size_t OFF_WO = OFF_WOUT + 4 * SZ_WOUT;
constexpr size_t SZ_PW1 = (size_t)65 * 64 * 2 * 4;
constexpr size_t SZ_BB1 = (size_t)64 * 16 * 2 * 4;
constexpr size_t SZ_KE1 = (size_t)64 * 256 * 4;
constexpr size_t OFF_PW = OFF_WO + 4 * SZ_WO;
constexpr size_t OFF_BB = OFF_PW + 128 * SZ_PW1;
constexpr size_t OFF_KERN = OFF_BB + 128 * SZ_BB1;
constexpr size_t OFF_W1 = OFF_KERN + 128 * SZ_KE1;
constexpr size_t OFF_W2 = OFF_W1 + (size_t)32 * 256 * 1024 * 2;
constexpr size_t OFF_XN = OFF_W2 + (size_t)32 * 1024 * 1152 * 2;
constexpr size_t OFF_M1 = OFF_XN + (size_t)NTOK * 1024 * 2;
constexpr size_t OFF_SSP = OFF_M1 + (size_t)NTOK * 1024 * 2;
constexpr size_t OFF_OV = OFF_SSP + (size_t)64 * NTOK * 4;
constexpr size_t OFF_H = OFF_OV;
constexpr size_t OFF_U = OFF_OV;
constexpr size_t OFF_Q = OFF_U + (size_t)32 * 1024 * 1152 * 2;
constexpr size_t OFF_K = OFF_Q + (size_t)NTOK * 512 * 2;
constexpr size_t OFF_VT = OFF_K + (size_t)NTOK * 512 * 2;
constexpr size_t OFF_SB = OFF_VT + (size_t)NTOK * 512 * 2;
constexpr size_t OFF_S = OFF_SB + (size_t)NTOK * 1024 * 2;
constexpr size_t OV_MIX = OFF_S + (size_t)32 * 1024 * 128 * 4 - OFF_OV;
constexpr size_t OV_FFN = (size_t)NTOK * 2816 * 2;
constexpr size_t WS_END = OFF_OV + (OV_MIX > OV_FFN ? OV_MIX : OV_FFN);

DI const char* uni_ptr(const char* p) { const unsigned long long v = (unsigned long long)p; const unsigned lo = __builtin_amdgcn_readfirstlane((unsigned)v), hi = __builtin_amdgcn_readfirstlane((unsigned)(v >> 32)); return (const char*)(((unsigned long long)hi << 32) | lo); }
DI int opaque_tid(int wave_s) { int t = wave_s * 64 + (int)__builtin_amdgcn_mbcnt_hi(~0u, __builtin_amdgcn_mbcnt_lo(~0u, 0u)); asm volatile("" : "+v"(t)); return t; }
DI unsigned pk2(float a, float b) { f32x2 v = {a, b}; bf2_t r = __builtin_convertvector(v, bf2_t); return __builtin_bit_cast(unsigned, r); }
DI float bflo(unsigned u) { return __uint_as_float(u << 16); }
DI float bfhi(unsigned u) { return __uint_as_float(u & 0xffff0000u); }
DI float shx(float v, int lane, int o) { return __int_as_float(__builtin_amdgcn_ds_bpermute((lane ^ o) << 2, __float_as_int(v))); }
DI float wave_sum(float v, int lane) {
#pragma unroll
    for (int o = 1; o < 64; o <<= 1) v += shx(v, lane, o);
    return v;
}
DI float fsigmoid(float x) { return __builtin_amdgcn_rcpf(1.f + __expf(-x)); }
DI float fsilu(float x) { return x * fsigmoid(x); }
DI float fgelu_tanh(float x) { return x * fsigmoid(1.5957691216f * (x + 0.044715f * x * x * x)); }
DI u32x4 pack8(const f32x4 a, const f32x4 b) { u32x4 w; w.x = pk2(a[0], a[1]); w.y = pk2(a[2], a[3]); w.z = pk2(b[0], b[1]); w.w = pk2(b[2], b[3]); return w; }
DI void unpack8(const u32x4 w, f32x4& a, f32x4& b) { a = (f32x4){bflo(w.x), bfhi(w.x), bflo(w.y), bfhi(w.y)}; b = (f32x4){bflo(w.z), bfhi(w.z), bflo(w.w), bfhi(w.w)}; }

namespace pg8 {
constexpr int BM = 256, BK = 64, HALF = 128, HTB = HALF * BK * 2, STAGE_BYTES = 8 * HTB, NXCD = 8, WGM = 8;
DI int lds_byte(int r, int c) { const int st = (r >> 4) * 2 + (c >> 5), rr = r & 15, cc = c & 31, ob = rr * 64 + cc * 2; return st * 1024 + (ob ^ (((ob >> 9) & 1) << 5)); }
DI void stage_rc(int b, int& R, int& C) { const int st = b / 1024, sb = b % 1024, swz = sb ^ (((sb >> 9) & 1) << 5); R = (st >> 1) * 16 + swz / 64; C = (st & 1) * 32 + (swz % 64) / 2; }
DI int perm32(int rho) { const int n = rho >> 4, i = rho & 15; return 8 * (i >> 2) + 4 * n + (i & 3); }

struct Unit { int pm, pn, pb; };
struct Gemm { const char* A; const char* B; int lda, ldb; size_t a_pm, a_pb, b_pn, b_pb; int nt0, ntstep; };
struct Order {
    int nM, nN, nB, nwg, G, c, mode;
    DI void init(int nM_, int nN_, int nB_, int mode_, int G_, int c_) { nM = nM_; nN = nN_; nB = nB_; mode = mode_; nwg = nM * nN * nB; G = G_; c = c_; }
    DI bool next(int i, Unit& u) const {
        const long L = (long)i * G + c; if (L >= nwg) return false;
        if (mode == 0) {
            int wgid = (int)L; { const int q = nwg / NXCD, r = nwg % NXCD, xcd = wgid % NXCD, off = wgid / NXCD; wgid = (xcd < r ? xcd * (q + 1) : r * (q + 1) + (xcd - r) * q) + off; }
            const int nig = WGM * nN, gid = wgid / nig, fm = gid * WGM, gsz = (nM - fm) < WGM ? (nM - fm) : WGM;
            u.pm = fm + ((wgid % nig) % gsz); u.pn = (wgid % nig) / gsz; u.pb = 0;
        } else {
            const int per = nM * nN, l = (int)L; u.pb = l / per; const int rem = l % per; u.pm = rem / nN; int pn = rem % nN;
            if (mode == 2 && (i & 1)) pn = nN - 1 - pn;
            u.pn = pn;
        }
        u.pm = __builtin_amdgcn_readfirstlane(u.pm); u.pn = __builtin_amdgcn_readfirstlane(u.pn); u.pb = __builtin_amdgcn_readfirstlane(u.pb);
        return true;
    }
};

template <class Epi>
DI void gemm_phase(LAS unsigned char* lds, const Gemm g, const Order& S, const Epi& E, int wave_s) {
    const int tid = opaque_tid(wave_s);
    const int wid = __builtin_amdgcn_readfirstlane(tid >> 6), lane = tid & 63, wr = wid >> 2, wc = wid & 3, fr = lane & 15, fq = lane >> 4;
    unsigned voffA[2], voffB[2];
#pragma unroll
    for (int i = 0; i < 2; ++i) { int R, C; stage_rc(tid * 16 + i * 8192, R, C); const int Rb = (R & ~31) + perm32(R & 31);
        voffA[i] = (unsigned)(R * g.lda + C) * 2u; voffB[i] = (unsigned)(Rb * g.ldb + C) * 2u; }
    const size_t kstep = (size_t)(BK * 2);
    const size_t hstepA = (size_t)HALF * g.lda * 2, hstepB = (size_t)HALF * g.ldb * 2;
    const unsigned ldsw = (unsigned)wid * 1024u;
    const int aoff = lds_byte(wr * 64 + fr, fq * 8), boff = lds_byte(wc * 32 + fr, fq * 8);
#define PG8_SA(b, h) (((b) * 2 + (h)) * HTB)
#define PG8_SB(b, h) ((4 + (b) * 2 + (h)) * HTB)
#define PG8_STAGE(bufoff, gbase, voff) do { _Pragma("unroll") for (int _i = 0; _i < 2; ++_i) \
        __builtin_amdgcn_global_load_lds((const unsigned*)((const char*)(gbase) + (voff)[_i]), (LAS unsigned*)(lds + (bufoff) + ldsw + _i * 8192), 16, 0, 0); } while (0)
#define PG8_LDA(dst, b, h) do { _Pragma("unroll") for (int m = 0; m < 4; ++m) _Pragma("unroll") for (int k = 0; k < 2; ++k) dst[m][k] = *(const LAS bf16x8*)(lds + PG8_SA(b, h) + aoff + m * 2048 + k * 1024); } while (0)
#define PG8_LDB(dst, b, h) do { _Pragma("unroll") for (int n = 0; n < 2; ++n) _Pragma("unroll") for (int k = 0; k < 2; ++k) dst[n][k] = *(const LAS bf16x8*)(lds + PG8_SB(b, h) + boff + n * 2048 + k * 1024); } while (0)
#define PG8_MMA(ai, bj, At, Bt) do { __builtin_amdgcn_s_setprio(1); _Pragma("unroll") for (int m = 0; m < 4; ++m) _Pragma("unroll") for (int n = 0; n < 2; ++n) _Pragma("unroll") for (int k = 0; k < 2; ++k) \
        acc[ai][bj][m][n] = __builtin_amdgcn_mfma_f32_16x16x32_bf16(Bt[n][k], At[m][k], acc[ai][bj][m][n], 0, 0, 0); __builtin_amdgcn_s_setprio(0); } while (0)
#define PG8_WAIT_V(n) asm volatile("s_waitcnt vmcnt(" #n ")" ::: "memory")
#define PG8_WAIT_L(n) asm volatile("s_waitcnt lgkmcnt(" #n ")" ::: "memory")
#define PG8_BAR __builtin_amdgcn_s_barrier()
#define PG8_SCHED __builtin_amdgcn_sched_barrier(0)
    Unit cur, nxt; int ui = 0;
    if (!S.next(0, cur)) return;
    f32x4 acc[2][2][4][2];
#pragma unroll
    for (int a = 0; a < 2; ++a)
#pragma unroll
        for (int b = 0; b < 2; ++b)
#pragma unroll
            for (int m = 0; m < 4; ++m)
#pragma unroll
                for (int n = 0; n < 2; ++n) acc[a][b][m][n] = (f32x4){0.f, 0.f, 0.f, 0.f};
    bf16x8 At[4][2], B0[2][2], B1[2][2];
    const char* cA = uni_ptr(g.A + (size_t)cur.pb * g.a_pb + (size_t)cur.pm * g.a_pm);
    const char* cB = uni_ptr(g.B + (size_t)cur.pb * g.b_pb + (size_t)cur.pn * g.b_pn);
    PG8_STAGE(PG8_SB(0, 0), cB, voffB); PG8_STAGE(PG8_SB(0, 1), cB + hstepB, voffB); PG8_STAGE(PG8_SA(0, 0), cA, voffA); PG8_STAGE(PG8_SA(0, 1), cA + hstepA, voffA);
    if (wr == 1) PG8_BAR;
    PG8_WAIT_V(2); PG8_BAR;
    PG8_STAGE(PG8_SB(1, 0), cB + kstep, voffB); PG8_STAGE(PG8_SA(1, 0), cA + kstep, voffA); PG8_STAGE(PG8_SB(1, 1), cB + hstepB + kstep, voffB);
    PG8_WAIT_V(6); PG8_BAR;
    for (;;) {
        const bool has_next = S.next(ui + 1, nxt);
        const char* nA = uni_ptr(has_next ? g.A + (size_t)nxt.pb * g.a_pb + (size_t)nxt.pm * g.a_pm : cA);
        const char* nB = uni_ptr(has_next ? g.B + (size_t)nxt.pb * g.b_pb + (size_t)nxt.pn * g.b_pn : cB);
        const int nt = g.nt0 + g.ntstep * cur.pn;
        for (int t = 0; t < nt; t += 2) {
            const bool last = (t == nt - 2);
            if constexpr (Epi::HAS_MID) { if (t == Epi::TMID) E.mid(acc, cur, wr, wc, fr, fq); }
            const char* a1 = cA + (size_t)(t + 1) * kstep;
            const char* a2 = last ? nA : cA + (size_t)(t + 2) * kstep; const char* b2 = last ? nB : cB + (size_t)(t + 2) * kstep;
            const char* a3 = a2 + kstep; const char* b3 = b2 + kstep;
            PG8_LDB(B0, 0, 0); PG8_LDB(B1, 0, 1); PG8_SCHED; PG8_LDA(At, 0, 0); PG8_STAGE(PG8_SA(1, 1), a1 + hstepA, voffA);
            PG8_WAIT_V(8); PG8_WAIT_L(0); PG8_BAR; PG8_MMA(0, 0, At, B0); PG8_MMA(0, 1, At, B1); PG8_BAR; PG8_SCHED;
            PG8_LDA(At, 0, 1); PG8_STAGE(PG8_SB(0, 0), b2, voffB); PG8_STAGE(PG8_SB(0, 1), b2 + hstepB, voffB); PG8_STAGE(PG8_SA(0, 0), a2, voffA);
            PG8_WAIT_V(8); PG8_WAIT_L(0); PG8_BAR; PG8_MMA(1, 0, At, B0); PG8_MMA(1, 1, At, B1); PG8_BAR; PG8_SCHED;
            PG8_LDB(B0, 1, 0); PG8_LDB(B1, 1, 1); PG8_SCHED; PG8_LDA(At, 1, 0); PG8_STAGE(PG8_SA(0, 1), a2 + hstepA, voffA);
            PG8_WAIT_V(8); PG8_WAIT_L(0); PG8_BAR; PG8_MMA(0, 0, At, B0); PG8_MMA(0, 1, At, B1); PG8_BAR; PG8_SCHED;
            PG8_LDA(At, 1, 1); PG8_STAGE(PG8_SB(1, 0), b3, voffB); PG8_STAGE(PG8_SB(1, 1), b3 + hstepB, voffB); PG8_STAGE(PG8_SA(1, 0), a3, voffA);
            PG8_WAIT_V(8); PG8_WAIT_L(0); PG8_BAR; PG8_MMA(1, 0, At, B0); PG8_MMA(1, 1, At, B1); PG8_BAR; PG8_SCHED;
        }
        if (wr == 0) PG8_BAR;
        E(acc, cur, wr, wc, fr, fq);
        if (!has_next) break;
#pragma unroll
        for (int a = 0; a < 2; ++a)
#pragma unroll
            for (int b = 0; b < 2; ++b)
#pragma unroll
                for (int m = 0; m < 4; ++m)
#pragma unroll
                    for (int n = 0; n < 2; ++n) acc[a][b][m][n] = (f32x4){0.f, 0.f, 0.f, 0.f};
        cur = nxt; cA = nA; cB = nB; ++ui;
        if (wr == 1) PG8_BAR;
    }
    PG8_WAIT_V(0);
    PG8_BAR;
#undef PG8_SA
#undef PG8_SB
#undef PG8_STAGE
#undef PG8_LDA
#undef PG8_LDB
#undef PG8_MMA
#undef PG8_WAIT_V
#undef PG8_WAIT_L
#undef PG8_BAR
#undef PG8_SCHED
}
}
using pg8::Unit;
typedef f32x4 AccT[2][2][4][2];

template <int ACT> struct EpiGated {
    static constexpr bool HAS_MID = false; static constexpr int TMID = -1;
    bf16_t* O; int ldc;
    DI void mid(AccT&, const Unit&, int, int, int, int) const {}
    DI void operator()(const AccT& acc, const Unit& u, int wr, int wc, int fr, int fq) const {
        const int row0 = u.pm * 256 + wr * 64 + fr, col0 = u.pn * 128 + wc * 32 + 8 * fq;
#pragma unroll
        for (int ai = 0; ai < 2; ++ai)
#pragma unroll
            for (int m = 0; m < 4; ++m) {
                f32x4 o[2];
#pragma unroll
                for (int n = 0; n < 2; ++n)
#pragma unroll
                    for (int e = 0; e < 4; ++e) { const float a = acc[ai][0][m][n][e], b = acc[ai][1][m][n][e]; o[n][e] = ACT == 0 ? fsilu(a) * b : a * fsigmoid(b); }
                *(u32x4*)(O + (size_t)(row0 + ai * 128 + m * 16) * ldc + col0) = pack8(o[0], o[1]);
            }
    }
};
struct EpiDown {
    static constexpr bool HAS_MID = false; static constexpr int TMID = -1;
    bf16_t* O; float* ssp;
    DI void mid(AccT&, const Unit&, int, int, int, int) const {}
    DI void operator()(const AccT& acc, const Unit& u, int wr, int wc, int fr, int fq) const {
        const int row0 = u.pm * 256 + wr * 64 + fr, col0 = u.pn * 256 + wc * 32 + 8 * fq;
#pragma unroll
        for (int ai = 0; ai < 2; ++ai)
#pragma unroll
            for (int m = 0; m < 4; ++m) {
                const int row = row0 + ai * 128 + m * 16; float ss = 0.f;
#pragma unroll
                for (int bj = 0; bj < 2; ++bj) {
                    const f32x4 v0 = acc[ai][bj][m][0], v1 = acc[ai][bj][m][1];
                    ss += (v0[0] * v0[0] + v0[1] * v0[1]) + (v0[2] * v0[2] + v0[3] * v0[3]) + (v1[0] * v1[0] + v1[1] * v1[1]) + (v1[2] * v1[2] + v1[3] * v1[3]);
                    *(u32x4*)(O + (size_t)row * 1024 + col0 + bj * 128) = pack8(v0, v1);
                }
                ssp[(size_t)(u.pn * 16 + wc * 4 + fq) * NTOK + row] = ss;
            }
    }
};
struct EpiWin {
    static constexpr bool HAS_MID = false; static constexpr int TMID = -1;
    bf16_t *U, *Q, *K, *VT, *R, *SB;
    DI void mid(AccT&, const Unit&, int, int, int, int) const {}
    DI void operator()(const AccT& acc, const Unit& u, int wr, int wc, int fr, int fq) const {
        const int row0 = u.pm * 256 + wr * 64 + fr, pn = u.pn;
        if (pn < 2) {
#pragma unroll
            for (int ai = 0; ai < 2; ++ai)
#pragma unroll
                for (int m = 0; m < 4; ++m) { const int row = row0 + ai * 128 + m * 16, bc = row >> 6, j = row & 63;
#pragma unroll
                    for (int bj = 0; bj < 2; ++bj) { const int c = pn * 256 + bj * 128 + wc * 32 + 8 * fq, gi = c >> 4, h0 = c & 15;
                        *(u32x4*)(U + ((size_t)gi * 1024 + bc) * 1152 + 128 + j * 16 + h0) = pack8(acc[ai][bj][m][0], acc[ai][bj][m][1]); } }
        } else if (pn < 6) {
            bf16_t* O = pn < 4 ? Q : K; const int cb = (pn & 1) * 256 + wc * 32 + 8 * fq;
#pragma unroll
            for (int ai = 0; ai < 2; ++ai)
#pragma unroll
                for (int m = 0; m < 4; ++m) { const int row = row0 + ai * 128 + m * 16;
#pragma unroll
                    for (int bj = 0; bj < 2; ++bj) *(u32x4*)(O + (size_t)row * 512 + cb + bj * 128) = pack8(acc[ai][bj][m][0], acc[ai][bj][m][1]); }
        } else if (pn < 8) {
#pragma unroll
            for (int ai = 0; ai < 2; ++ai)
#pragma unroll
                for (int m = 0; m < 4; ++m) { const int row = row0 + ai * 128 + m * 16, b = row >> 12, s = row & 4095;
#pragma unroll
                    for (int bj = 0; bj < 2; ++bj) { const int c = (pn - 6) * 256 + bj * 128 + wc * 32 + 8 * fq, hd = c >> 6, d0 = c & 63;
                        bf16_t* o = VT + (((size_t)b * 8 + hd) * 64 + d0) * 4096 + s;
                        const u32x4 w = pack8(acc[ai][bj][m][0], acc[ai][bj][m][1]);
                        o[0 * 4096] = (bf16_t)(w.x & 0xffff); o[1 * 4096] = (bf16_t)(w.x >> 16); o[2 * 4096] = (bf16_t)(w.y & 0xffff); o[3 * 4096] = (bf16_t)(w.y >> 16);
                        o[4 * 4096] = (bf16_t)(w.z & 0xffff); o[5 * 4096] = (bf16_t)(w.z >> 16); o[6 * 4096] = (bf16_t)(w.w & 0xffff); o[7 * 4096] = (bf16_t)(w.w >> 16); } }
        } else {
            const int cb = (pn - 8) * 128 + wc * 32 + 8 * fq;
#pragma unroll
            for (int ai = 0; ai < 2; ++ai)
#pragma unroll
                for (int m = 0; m < 4; ++m) { const int row = row0 + ai * 128 + m * 16; f32x4 r[2], sb[2];
#pragma unroll
                    for (int n = 0; n < 2; ++n)
#pragma unroll
                        for (int e = 0; e < 4; ++e) { const float sa = fsigmoid(acc[ai][0][m][n][e]), sbv = fsigmoid(acc[ai][1][m][n][e]); sb[n][e] = sbv; r[n][e] = sa / sbv; }
                    *(u32x4*)(R + (size_t)row * 1024 + cb) = pack8(r[0], r[1]);
                    *(u32x4*)(SB + (size_t)row * 1024 + cb) = pack8(sb[0], sb[1]); }
        }
    }
};
struct EpiS {
    static constexpr bool HAS_MID = false; static constexpr int TMID = -1;
    float* S;
    DI void mid(AccT&, const Unit&, int, int, int, int) const {}
    DI void operator()(const AccT& acc, const Unit& u, int wr, int wc, int fr, int fq) const {
        const int row0 = u.pm * 256 + wr * 64 + fr, col0 = wc * 32 + 8 * fq;
#pragma unroll
        for (int ai = 0; ai < 2; ++ai)
#pragma unroll
            for (int m = 0; m < 4; ++m) { float* o = S + ((size_t)u.pb * 1024 + row0 + ai * 128 + m * 16) * 128 + col0;
                *(f32x4*)o = acc[ai][0][m][0]; *(f32x4*)(o + 4) = acc[ai][0][m][1]; }
    }
};
struct EpiY {
    static constexpr bool HAS_MID = false; static constexpr int TMID = -1;
    bf16_t* YA;
    DI void mid(AccT&, const Unit&, int, int, int, int) const {}
    DI void operator()(const AccT& acc, const Unit& u, int wr, int wc, int fr, int fq) const {
        const int row0 = u.pm * 256 + wr * 64 + fr;
#pragma unroll
        for (int ai = 0; ai < 2; ++ai)
#pragma unroll
            for (int m = 0; m < 4; ++m) { const int row = row0 + ai * 128 + m * 16;
#pragma unroll
                for (int bj = 0; bj < 2; ++bj) { const int c = u.pn * 256 + bj * 128 + wc * 32 + 8 * fq, t = c >> 4, h0 = c & 15; f32x4 o[2];
#pragma unroll
                    for (int n = 0; n < 2; ++n)
#pragma unroll
                        for (int e = 0; e < 4; ++e) o[n][e] = fgelu_tanh(acc[ai][bj][m][n][e]);
                    *(u32x4*)(YA + ((size_t)row * 64 + t) * 512 + u.pb * 16 + h0) = pack8(o[0], o[1]); } }
    }
};
struct EpiMerge {
    static constexpr bool HAS_MID = true; static constexpr int TMID = 8;
    const bf16_t *R, *SB; bf16_t* O; int wave_s;
    DI void scale(AccT& acc, const Unit& u, int, int, int, int, const bf16_t* P) const {
        const int t_ = opaque_tid(wave_s), wid = __builtin_amdgcn_readfirstlane(t_ >> 6), ln = t_ & 63, wr = wid >> 2, wc = wid & 3, fr = ln & 15, fq = ln >> 4;
        const int row0 = u.pm * 256 + wr * 64 + fr, col0 = u.pn * 256 + wc * 32 + 8 * fq;
#pragma unroll
        for (int ai = 0; ai < 2; ++ai)
#pragma unroll
            for (int m = 0; m < 4; ++m)
#pragma unroll
                for (int bj = 0; bj < 2; ++bj) { const u32x4 w = *(const u32x4*)(P + (size_t)(row0 + ai * 128 + m * 16) * 1024 + col0 + bj * 128); f32x4 a, b; unpack8(w, a, b);
                    acc[ai][bj][m][0] *= a; acc[ai][bj][m][1] *= b; }
    }
    DI void mid(AccT& acc, const Unit& u, int wr, int wc, int fr, int fq) const { scale(acc, u, wr, wc, fr, fq, R); }
    DI void operator()(AccT& acc, const Unit& u, int wr, int wc, int fr, int fq) const {
        scale(acc, u, wr, wc, fr, fq, SB);
        const int row0 = u.pm * 256 + wr * 64 + fr, col0 = u.pn * 256 + wc * 32 + 8 * fq;
#pragma unroll
        for (int ai = 0; ai < 2; ++ai)
#pragma unroll
            for (int m = 0; m < 4; ++m)
#pragma unroll
                for (int bj = 0; bj < 2; ++bj) *(u32x4*)(O + (size_t)(row0 + ai * 128 + m * 16) * 1024 + col0 + bj * 128) = pack8(acc[ai][bj][m][0], acc[ai][bj][m][1]);
    }
};

struct Params { const float* in[20]; float* out; unsigned char* ws; };
enum { I_X = 0, I_GAINS, I_WGATE, I_WUP, I_WDOWN, I_WIN, I_LRE, I_LIM, I_LOGDT, I_BRE, I_BIM, I_CRE, I_CIM, I_DSKIP, I_GLUV, I_GLUG, I_OSSM, I_RELB, I_OATT, I_WO };

DI int map_row(int map, int n) {
    if (map == 0) return n;
    if (map == 1) return 256 * (n >> 7) + (n & 127);
    if (map == 2) return 256 * (n >> 7) + 128 + (n & 127);
    if (n < 2048) return n;
    if (n < 3072) { const int j = n - 2048; return 2048 + 256 * (j >> 7) + (j & 127); }
    const int j = n - 3072; return 2048 + 256 * (j >> 7) + 128 + (j & 127);
}
DI void cvt_item(const float* W, int K, int N, bf16_t* WT, int ldk, int koff, int map, LAS float* scr, int item, int lane) {
    const int nblk = N / 32, kb = item / nblk, nb = item % nblk, k0 = 64 * kb, n0 = 32 * nb;
    const float sc = (map == 3 && n0 >= 512 && n0 < 1024) ? 0.125f : 1.f;
#pragma unroll 8
    for (int i = 0; i < 32; ++i) { const int kk = 2 * i + (lane >> 5); scr[kk * 33 + (lane & 31)] = W[(size_t)(k0 + kk) * N + n0 + (lane & 31)] * sc; }
    asm volatile("s_waitcnt lgkmcnt(0)" ::: "memory");
    const int c = lane & 7;
#pragma unroll
    for (int j = 0; j < 4; ++j) { const int n = (lane >> 3) + 8 * j; const LAS float* s = scr + (8 * c) * 33 + n;
        u32x4 o; o.x = pk2(s[0 * 33], s[1 * 33]); o.y = pk2(s[2 * 33], s[3 * 33]); o.z = pk2(s[4 * 33], s[5 * 33]); o.w = pk2(s[6 * 33], s[7 * 33]);
        *(u32x4*)(WT + (size_t)map_row(map, n0 + n) * ldk + koff + k0 + 8 * c) = o; }
    asm volatile("s_waitcnt lgkmcnt(0)" ::: "memory");
}
DI void cvt_matrix(const float* W, int K, int N, bf16_t* WT, int ldk, int koff, int map, LAS float* scr, int gw, int NGW, int lane) {
    const int nitems = (K / 64) * (N / 32);
    for (int it = gw; it < nitems; it += NGW) cvt_item(W, K, N, WT, ldk, koff, map, scr, it, lane);
}

DI void s5_tables(const Params& P, LAS unsigned char* lds, int lg) {
    LAS float* pw = (LAS float*)lds;
    LAS float* bb = pw + 65 * 64 * 2;
    LAS float* cc = bb + 64 * 16 * 2;
    LAS float* ff = cc + 16 * 64 * 2;
    const int tid = threadIdx.x;
    unsigned char* ws = P.ws;
    float* gPW = (float*)(ws + OFF_PW + (size_t)lg * SZ_PW1);
    float* gBB = (float*)(ws + OFF_BB + (size_t)lg * SZ_BB1);
    float* gKE = (float*)(ws + OFF_KERN + (size_t)lg * SZ_KE1);
    const double dt = exp((double)P.in[I_LOGDT][lg]);
    const float* lre = P.in[I_LRE] + (size_t)lg * 64; const float* lim = P.in[I_LIM] + (size_t)lg * 64;
    for (int idx = tid; idx < 65 * 64; idx += NTHREADS) {
        const int tau = idx >> 6, p = idx & 63;
        const double lr = lre[p], li = lim[p];
        const float mag = __expf((float)(lr * dt * tau));
        double rev = li * dt * tau * 0.15915494309189535; rev -= rint(rev);
        const float cs = __builtin_amdgcn_cosf((float)rev), sn = __builtin_amdgcn_sinf((float)rev);
        const float re = mag * cs, im = mag * sn;
        pw[idx * 2] = re; pw[idx * 2 + 1] = im; gPW[idx * 2] = re; gPW[idx * 2 + 1] = im;
        if (tau == 1) {
            const double nr = (double)re - 1.0, ni = im, den = lr * lr + li * li;
            ff[p * 2] = (float)((nr * lr + ni * li) / den); ff[p * 2 + 1] = (float)((ni * lr - nr * li) / den);
        }
    }
    __syncthreads();
    const float* bre = P.in[I_BRE] + (size_t)lg * 1024; const float* bim = P.in[I_BIM] + (size_t)lg * 1024;
    const float* cre = P.in[I_CRE] + (size_t)lg * 1024; const float* cim = P.in[I_CIM] + (size_t)lg * 1024;
    for (int idx = tid; idx < 1024; idx += NTHREADS) {
        const int p = idx >> 4;
        const float fr_ = ff[p * 2], fi_ = ff[p * 2 + 1], br = bre[idx], bi = bim[idx];
        const float re = fr_ * br - fi_ * bi, im = fr_ * bi + fi_ * br;
        bb[idx * 2] = re; bb[idx * 2 + 1] = im; gBB[idx * 2] = re; gBB[idx * 2 + 1] = im;
        cc[idx * 2] = cre[idx]; cc[idx * 2 + 1] = cim[idx];
    }
    __syncthreads();
    const float* dsk = P.in[I_DSKIP] + (size_t)lg * 16;
    for (int pair = tid; pair < 1024; pair += NTHREADS) {
        const int tau = pair >> 4, h = pair & 15;
        float a[16];
#pragma unroll
        for (int j = 0; j < 16; ++j) a[j] = 0.f;
        for (int p = 0; p < 64; ++p) {
            const float cr = cc[(h * 64 + p) * 2], ci = cc[(h * 64 + p) * 2 + 1], pr = pw[(tau * 64 + p) * 2], pi = pw[(tau * 64 + p) * 2 + 1];
            const float xr = cr * pr - ci * pi, xi = cr * pi + ci * pr;
#pragma unroll
            for (int j = 0; j < 16; ++j) a[j] += xr * bb[(p * 16 + j) * 2] - xi * bb[(p * 16 + j) * 2 + 1];
        }
        const float dv = dsk[h];
#pragma unroll
        for (int j = 0; j < 16; ++j) gKE[(size_t)pair * 16 + j] = a[j] + ((tau == 0 && j == h) ? dv : 0.f);
    }
    __syncthreads();
}

DI void build_w12(const Params& P, int l, int wave_s) {
    unsigned char* ws = P.ws;
    const float* gPW = (const float*)(ws + OFF_PW) + (size_t)l * 32 * (65 * 64 * 2);
    const float* gBB = (const float*)(ws + OFF_BB) + (size_t)l * 32 * (64 * 16 * 2);
    const float* gKE = (const float*)(ws + OFF_KERN) + (size_t)l * 32 * (64 * 256);
    bf16_t* W1 = (bf16_t*)(ws + OFF_W1); bf16_t* W2 = (bf16_t*)(ws + OFF_W2);
    const int gt = blockIdx.x * NTHREADS + opaque_tid(wave_s), NT = gridDim.x * NTHREADS;
    for (int it = gt; it < 32 * 256 * 128; it += NT) {
        const int kk = it & 127, n = (it >> 7) & 255, g = it >> 15;
        float v[8];
        if (n >= 128) {
#pragma unroll
            for (int e = 0; e < 8; ++e) v[e] = 0.f;
        } else {
            const int p = n & 63, im = n >> 6, j = kk >> 1, h0 = (kk & 1) * 8;
            const float* pwp = gPW + ((size_t)g * 65 + (63 - j)) * 128 + p * 2; const float pr = pwp[0], pi = pwp[1];
            const float* bp = gBB + ((size_t)g * 64 + p) * 32 + h0 * 2;
#pragma unroll
            for (int e = 0; e < 8; ++e) { const float br = bp[e * 2], bi = bp[e * 2 + 1]; v[e] = im ? (pr * bi + pi * br) : (pr * br - pi * bi); }
        }
        u32x4 o; o.x = pk2(v[0], v[1]); o.y = pk2(v[2], v[3]); o.z = pk2(v[4], v[5]); o.w = pk2(v[6], v[7]);
        *(u32x4*)(W1 + (size_t)it * 8) = o;
    }
    const float* cre = P.in[I_CRE] + (size_t)l * 32 * 1024; const float* cim = P.in[I_CIM] + (size_t)l * 32 * 1024;
    for (int it = gt; it < 32 * 1024 * 144; it += NT) {
        const int kk = it % 144, n = (it / 144) & 1023, g = it / (144 * 1024), t = n >> 4, h = n & 15;
        float v[8];
        if (kk < 16) {
            const int im = kk >> 3, p0 = (kk & 7) * 8;
            const float* pwp = gPW + ((size_t)g * 65 + (t + 1)) * 128 + p0 * 2;
            const float* crp = cre + ((size_t)g * 16 + h) * 64 + p0; const float* cip = cim + ((size_t)g * 16 + h) * 64 + p0;
#pragma unroll
            for (int e = 0; e < 8; ++e) { const float cr = crp[e], ci = cip[e], pr = pwp[e * 2], pi = pwp[e * 2 + 1]; v[e] = im ? -(cr * pi + ci * pr) : (cr * pr - ci * pi); }
        } else {
            const int j = (kk - 16) >> 1, h0 = ((kk - 16) & 1) * 8;
            if (j <= t) { const float* kp = gKE + (((size_t)g * 64 + (t - j)) * 16 + h) * 16 + h0;
#pragma unroll
                for (int e = 0; e < 8; ++e) v[e] = kp[e];
            } else {
#pragma unroll
                for (int e = 0; e < 8; ++e) v[e] = 0.f;
            }
        }
        u32x4 o; o.x = pk2(v[0], v[1]); o.y = pk2(v[2], v[3]); o.z = pk2(v[4], v[5]); o.w = pk2(v[6], v[7]);
        *(u32x4*)(W2 + (size_t)it * 8) = o;
    }
}

DI void ew_phase(const Params& P, const float* src, bool has_m, float coef, const float* gpost, const float* gpre, int wave_s) {
    const int tid_ = opaque_tid(wave_s), lane = tid_ & 63, wave = __builtin_amdgcn_readfirstlane(tid_ >> 6);
    unsigned char* ws = P.ws; float* xres = P.out;
    const bf16_t* M1 = (const bf16_t*)(ws + OFF_M1); const float* ssp = (const float*)(ws + OFF_SSP); bf16_t* XN = (bf16_t*)(ws + OFF_XN);
    const int gw = blockIdx.x * NWAVES + wave, NGW = gridDim.x * NWAVES;
    for (int row = gw; row < NTOK; row += NGW) {
        f32x4 v[4];
#pragma unroll
        for (int j = 0; j < 4; ++j) v[j] = *(const f32x4*)(src + (size_t)row * 1024 + j * 256 + lane * 4);
        if (has_m) {
            const float sv = ssp[(size_t)lane * NTOK + row];
            const float rstd = __builtin_amdgcn_rsqf(wave_sum(sv, lane) * (1.f / 1024.f) + RMS_EPS) * coef;
#pragma unroll
            for (int j = 0; j < 4; ++j) {
                const u32x2 w = *(const u32x2*)(M1 + (size_t)row * 1024 + j * 256 + lane * 4);
                const f32x4 gp = *(const f32x4*)(gpost + j * 256 + lane * 4);
                const f32x4 mv = {bflo(w.x), bfhi(w.x), bflo(w.y), bfhi(w.y)};
                v[j] += gp * mv * rstd;
            }
        }
#pragma unroll
        for (int j = 0; j < 4; ++j) *(f32x4*)(xres + (size_t)row * 1024 + j * 256 + lane * 4) = v[j];
        if (gpre) {
            float ss = 0.f;
#pragma unroll
            for (int j = 0; j < 4; ++j) ss += (v[j][0] * v[j][0] + v[j][1] * v[j][1]) + (v[j][2] * v[j][2] + v[j][3] * v[j][3]);
            const float rstd2 = __builtin_amdgcn_rsqf(wave_sum(ss, lane) * (1.f / 1024.f) + RMS_EPS);
#pragma unroll
            for (int j = 0; j < 4; ++j) { const f32x4 gq = *(const f32x4*)(gpre + j * 256 + lane * 4); const f32x4 o = v[j] * gq * rstd2;
                u32x2 w; w.x = pk2(o[0], o[1]); w.y = pk2(o[2], o[3]);
                *(u32x2*)(XN + (size_t)row * 1024 + j * 256 + lane * 4) = w; }
        }
    }
}

DI void carry_phase(const Params& P, int l, int wave_s) {
    const int tid_ = opaque_tid(wave_s), lane = tid_ & 63, wave = __builtin_amdgcn_readfirstlane(tid_ >> 6);
    unsigned char* ws = P.ws;
    const float* gPW = (const float*)(ws + OFF_PW) + (size_t)l * 32 * (65 * 64 * 2);
    const float* S = (const float*)(ws + OFF_S); bf16_t* U = (bf16_t*)(ws + OFF_U);
    const int gw = blockIdx.x * NWAVES + wave, NGW = gridDim.x * NWAVES;
    for (int task = gw; task < 512; task += NGW) {
        const int g = task >> 4, b = task & 15, p = lane;
        const float ar = gPW[((size_t)g * 65 + 64) * 128 + p * 2], ai = gPW[((size_t)g * 65 + 64) * 128 + p * 2 + 1];
        float xr = 0.f, xi = 0.f;
        const float* sp = S + ((size_t)g * 1024 + b * 64) * 128; bf16_t* up = U + ((size_t)g * 1024 + b * 64) * 1152;
#pragma unroll 8
        for (int c = 0; c < 64; ++c) {
            up[(size_t)c * 1152 + p] = (bf16_t)(pk2(xr, 0.f) & 0xffff); up[(size_t)c * 1152 + 64 + p] = (bf16_t)(pk2(xi, 0.f) & 0xffff);
            const float sr = sp[c * 128 + p], si = sp[c * 128 + 64 + p];
            const float nr = ar * xr - ai * xi + sr, ni = ar * xi + ai * xr + si;
            xr = nr; xi = ni;
        }
    }
}

DI int crow(int reg, int h) { return (reg & 3) + 8 * (reg >> 2) + 4 * h; }
#define MFMA32(a, b, c) __builtin_amdgcn_mfma_f32_32x32x16_bf16((a), (b), (c), 0, 0, 0)
DI bf16x8 pack_step(const f32x16& x, int s) {
    u32x4 p; p.x = pk2(x[8 * s], x[8 * s + 1]); p.y = pk2(x[8 * s + 2], x[8 * s + 3]); p.z = pk2(x[8 * s + 4], x[8 * s + 5]); p.w = pk2(x[8 * s + 6], x[8 * s + 7]);
    return __builtin_bit_cast(bf16x8, p);
}
DI void attn_phase(const Params& P, int l, LAS unsigned char* lds, int wave_s) {
    const int tid_ = opaque_tid(wave_s), lane = tid_ & 63, wave = __builtin_amdgcn_readfirstlane(tid_ >> 6);
    unsigned char* ws = P.ws;
    const bf16_t* Q = (const bf16_t*)(ws + OFF_Q); const bf16_t* K = (const bf16_t*)(ws + OFF_K); const bf16_t* VT = (const bf16_t*)(ws + OFF_VT);
    bf16_t* ZA = (bf16_t*)(ws + OFF_XN);
    LAS float* bt = (LAS float*)lds;
    const float* relb = P.in[I_RELB] + (size_t)l * 8 * 257;
    for (int i = tid_; i < 8 * 257; i += NTHREADS) bt[i] = relb[i];
    __syncthreads();
    const int n = lane & 31, gq = lane >> 5;
    for (int it = blockIdx.x; it < 2048; it += gridDim.x) {
        const int cg4 = it & 15, hd = (it >> 4) & 7, b = it >> 7;
        const int cc = cg4 * 4 + (wave >> 1), qh = wave & 1;
        const size_t tok0 = (size_t)b * SEQ + cc * 64 + qh * 32;
        bf16x8 Qf[4];
        { const bf16_t* qp = Q + (tok0 + n) * 512 + hd * 64 + gq * 8;
#pragma unroll
          for (int ks = 0; ks < 4; ++ks) Qf[ks] = *(const bf16x8*)(qp + ks * 16); }
        f32x16 O0, O1;
#pragma unroll
        for (int i = 0; i < 16; ++i) { O0[i] = 0.f; O1[i] = 0.f; }
        float mrun = -1e30f, lrun = 0.f;
        const LAS float* bth = bt + hd * 257;
        const int kt0 = cc > 8 ? cc - 8 : 0;
        for (int kt = kt0; kt <= cc; ++kt) {
            const bf16_t* kp = K + ((size_t)b * SEQ + kt * 64 + n) * 512 + hd * 64 + gq * 8;
            f32x16 s0, s1;
#pragma unroll
            for (int i = 0; i < 16; ++i) { s0[i] = 0.f; s1[i] = 0.f; }
#pragma unroll
            for (int ks = 0; ks < 4; ++ks) {
                const bf16x8 k0 = *(const bf16x8*)(kp + ks * 16), k1 = *(const bf16x8*)(kp + 32 * 512 + ks * 16);
                s0 = MFMA32(k0, Qf[ks], s0); s1 = MFMA32(k1, Qf[ks], s1);
            }
            const int delta = cc - kt;
            if (delta >= 3) { const float cb = bth[256];
#pragma unroll
                for (int i = 0; i < 16; ++i) { s0[i] += cb; s1[i] += cb; }
            } else { const int base = 64 * delta + qh * 32 + n + 128;
#pragma unroll
                for (int i = 0; i < 16; ++i) { const int key = crow(i, gq); int i0 = base - key, i1 = base - key - 32;
                    i0 = i0 > 256 ? 256 : i0; i1 = i1 > 256 ? 256 : i1; i0 = i0 < 0 ? 0 : i0; i1 = i1 < 0 ? 0 : i1;
                    s0[i] += bth[i0]; s1[i] += bth[i1]; }
            }
            float mx = s0[0];
#pragma unroll
            for (int i = 1; i < 16; ++i) mx = fmaxf(mx, s0[i]);
#pragma unroll
            for (int i = 0; i < 16; ++i) mx = fmaxf(mx, s1[i]);
            mx = fmaxf(mx, shx(mx, lane, 32));
            const float mnew = fmaxf(mrun, mx), alpha = __expf(mrun - mnew); mrun = mnew;
            float ps = 0.f;
#pragma unroll
            for (int i = 0; i < 16; ++i) { s0[i] = __expf(s0[i] - mnew); s1[i] = __expf(s1[i] - mnew); ps += s0[i] + s1[i]; }
            lrun = lrun * alpha + ps;
#pragma unroll
            for (int i = 0; i < 16; ++i) { O0[i] *= alpha; O1[i] *= alpha; }
            const bf16_t* vp = VT + (((size_t)b * 8 + hd) * 64 + n) * SEQ + kt * 64 + gq * 4;
#pragma unroll
            for (int kg = 0; kg < 2; ++kg)
#pragma unroll
                for (int s = 0; s < 2; ++s) {
                    const bf16x8 Pf = pack_step(kg == 0 ? s0 : s1, s);
                    const bf16_t* v0 = vp + 32 * kg + 16 * s;
                    const s16x4 lo0 = *(const s16x4*)(v0), hi0 = *(const s16x4*)(v0 + 8);
                    const s16x4 lo1 = *(const s16x4*)(v0 + (size_t)32 * SEQ), hi1 = *(const s16x4*)(v0 + (size_t)32 * SEQ + 8);
                    const bf16x8 V0 = __builtin_shufflevector(lo0, hi0, 0, 1, 2, 3, 4, 5, 6, 7), V1 = __builtin_shufflevector(lo1, hi1, 0, 1, 2, 3, 4, 5, 6, 7);
                    O0 = MFMA32(V0, Pf, O0); O1 = MFMA32(V1, Pf, O1);
                }
        }
        lrun += shx(lrun, lane, 32);
        const float inv = 1.f / lrun;
        bf16_t* op = ZA + (tok0 + n) * 1024 + 512 + hd * 64 + gq * 4;
#pragma unroll
        for (int g4 = 0; g4 < 4; ++g4) {
            u32x2 w0, w1;
            w0.x = pk2(O0[4 * g4] * inv, O0[4 * g4 + 1] * inv); w0.y = pk2(O0[4 * g4 + 2] * inv, O0[4 * g4 + 3] * inv);
            w1.x = pk2(O1[4 * g4] * inv, O1[4 * g4 + 1] * inv); w1.y = pk2(O1[4 * g4 + 2] * inv, O1[4 * g4 + 3] * inv);
            *(u32x2*)(op + 8 * g4) = w0; *(u32x2*)(op + 32 + 8 * g4) = w1;
        }
    }
    __syncthreads();
}

__global__ void __launch_bounds__(NTHREADS, 2) mk_fwd(Params P) {
    extern __shared__ __attribute__((aligned(16))) unsigned char lds_raw[];
    LAS unsigned char* lds = (LAS unsigned char*)lds_raw;
    cg::grid_group grid = cg::this_grid();
    const int tid = threadIdx.x, lane = tid & 63, wave = __builtin_amdgcn_readfirstlane(tid >> 6);
    const int G = gridDim.x, bx = blockIdx.x;
    unsigned char* ws = P.ws;
    const int gw = bx * NWAVES + wave, NGW = G * NWAVES;

    {
        for (int lg = bx; lg < 128; lg += G) s5_tables(P, lds, lg);
        __syncthreads();
        LAS float* scr = (LAS float*)(lds + wave * 8704);
        for (int l = 0; l < NL; ++l) {
            for (int f = 0; f < 2; ++f) {
                bf16_t* wgu = (bf16_t*)(ws + OFF_WGU + (size_t)(l * 2 + f) * SZ_WGU);
                cvt_matrix(P.in[I_WGATE] + (size_t)(l * 2 + f) * 1024 * 2816, 1024, 2816, wgu, 1024, 0, 1, scr, gw, NGW, lane);
                cvt_matrix(P.in[I_WUP] + (size_t)(l * 2 + f) * 1024 * 2816, 1024, 2816, wgu, 1024, 0, 2, scr, gw, NGW, lane);
                cvt_matrix(P.in[I_WDOWN] + (size_t)(l * 2 + f) * 2816 * 1024, 2816, 1024, (bf16_t*)(ws + OFF_WD + (size_t)(l * 2 + f) * SZ_WD), 2816, 0, 0, scr, gw, NGW, lane);
            }
            cvt_matrix(P.in[I_WIN] + (size_t)l * 1024 * 4096, 1024, 4096, (bf16_t*)(ws + OFF_WIN + (size_t)l * SZ_WIN), 1024, 0, 3, scr, gw, NGW, lane);
            bf16_t* wgl = (bf16_t*)(ws + OFF_WGL + (size_t)l * SZ_WGL);
            cvt_matrix(P.in[I_GLUV] + (size_t)l * 512 * 512, 512, 512, wgl, 512, 0, 1, scr, gw, NGW, lane);
            cvt_matrix(P.in[I_GLUG] + (size_t)l * 512 * 512, 512, 512, wgl, 512, 0, 2, scr, gw, NGW, lane);
            bf16_t* wout = (bf16_t*)(ws + OFF_WOUT + (size_t)l * SZ_WOUT);
            cvt_matrix(P.in[I_OSSM] + (size_t)l * 512 * 1024, 512, 1024, wout, 1024, 0, 0, scr, gw, NGW, lane);
            cvt_matrix(P.in[I_OATT] + (size_t)l * 512 * 1024, 512, 1024, wout, 1024, 512, 0, scr, gw, NGW, lane);
            cvt_matrix(P.in[I_WO] + (size_t)l * 1024 * 1024, 1024, 1024, (bf16_t*)(ws + OFF_WO + (size_t)l * SZ_WO), 1024, 0, 0, scr, gw, NGW, lane);
        }
        ew_phase(P, P.in[I_X], false, 0.f, nullptr, P.in[I_GAINS], wave);
        __syncthreads();
    }
    grid.sync();

    for (int step = 0; step < 12; ++step) {
        const int l = step / 3, s = step % 3;
        unsigned char* ws = P.ws; asm volatile("" : "+s"(ws));
        pg8::Gemm gfin;
        if (s != 1) {
            const int f = s >> 1;
            pg8::Gemm g{(const char*)(ws + OFF_XN), (const char*)(ws + OFF_WGU + (size_t)(l * 2 + f) * SZ_WGU), 1024, 1024, (size_t)256 * 1024 * 2, 0, (size_t)256 * 1024 * 2, 0, 16, 0};
            pg8::Order S; S.init(256, 22, 1, 0, G, bx);
            EpiGated<0> E{(bf16_t*)(ws + OFF_H), 2816};
            pg8::gemm_phase(lds, g, S, E, wave);
            grid.sync();
            gfin = pg8::Gemm{(const char*)(ws + OFF_H), (const char*)(ws + OFF_WD + (size_t)(l * 2 + f) * SZ_WD), 2816, 2816, (size_t)256 * 2816 * 2, 0, (size_t)256 * 2816 * 2, 0, 44, 0};
        } else {
            {
                pg8::Gemm g{(const char*)(ws + OFF_XN), (const char*)(ws + OFF_WIN + (size_t)l * SZ_WIN), 1024, 1024, (size_t)256 * 1024 * 2, 0, (size_t)256 * 1024 * 2, 0, 16, 0};
                pg8::Order S; S.init(256, 16, 1, 0, G, bx);
                EpiWin E{(bf16_t*)(ws + OFF_U), (bf16_t*)(ws + OFF_Q), (bf16_t*)(ws + OFF_K), (bf16_t*)(ws + OFF_VT), (bf16_t*)(ws + OFF_M1), (bf16_t*)(ws + OFF_SB)};
                pg8::gemm_phase(lds, g, S, E, wave);
            }
            grid.sync();
            {
                pg8::Gemm g{(const char*)(ws + OFF_U) + 256, (const char*)(ws + OFF_W1), 1152, 1024, (size_t)256 * 1152 * 2, (size_t)1024 * 1152 * 2, 0, (size_t)256 * 1024 * 2, 16, 0};
                pg8::Order S; S.init(4, 1, 32, 1, G, bx);
                EpiS E{(float*)(ws + OFF_S)};
                pg8::gemm_phase(lds, g, S, E, wave);
                __syncthreads();
                attn_phase(P, l, lds, wave);
            }
            grid.sync();
            carry_phase(P, l, wave);
            grid.sync();
            {
                pg8::Gemm g{(const char*)(ws + OFF_U), (const char*)(ws + OFF_W2), 1152, 1152, (size_t)256 * 1152 * 2, (size_t)1024 * 1152 * 2, (size_t)256 * 1152 * 2, (size_t)1024 * 1152 * 2, 6, 4};
                pg8::Order S; S.init(4, 4, 32, 2, G, bx);
                EpiY E{(bf16_t*)(ws + OFF_Q)};
                pg8::gemm_phase(lds, g, S, E, wave);
            }
            grid.sync();
            {
                pg8::Gemm g{(const char*)(ws + OFF_Q), (const char*)(ws + OFF_WGL + (size_t)l * SZ_WGL), 512, 512, (size_t)256 * 512 * 2, 0, (size_t)256 * 512 * 2, 0, 8, 0};
                pg8::Order S; S.init(256, 4, 1, 0, G, bx);
                EpiGated<1> E{(bf16_t*)(ws + OFF_XN), 1024};
                pg8::gemm_phase(lds, g, S, E, wave);
            }
            grid.sync();
            {
                pg8::Gemm g{(const char*)(ws + OFF_XN), (const char*)(ws + OFF_WOUT + (size_t)l * SZ_WOUT), 1024, 1024, (size_t)256 * 1024 * 2, 0, (size_t)256 * 1024 * 2, 0, 16, 0};
                pg8::Order S; S.init(256, 4, 1, 0, G, bx);
                EpiMerge E{(const bf16_t*)(ws + OFF_M1), (const bf16_t*)(ws + OFF_SB), (bf16_t*)(ws + OFF_K), wave};
                pg8::gemm_phase(lds, g, S, E, wave);
            }
            grid.sync();
            gfin = pg8::Gemm{(const char*)(ws + OFF_K), (const char*)(ws + OFF_WO + (size_t)l * SZ_WO), 1024, 1024, (size_t)256 * 1024 * 2, 0, (size_t)256 * 1024 * 2, 0, 16, 0};
        }
        {
            pg8::Order S; S.init(256, 4, 1, 0, G, bx);
            EpiDown E{(bf16_t*)(ws + OFF_M1), (float*)(ws + OFF_SSP)};
            pg8::gemm_phase(lds, gfin, S, E, wave);
        }
        grid.sync();
        {
            const float* gains = P.in[I_GAINS];
            ew_phase(P, P.out, true, s == 1 ? 1.f : 0.5f, gains + (size_t)(2 * step + 1) * 1024, step == 11 ? nullptr : gains + (size_t)(2 * step + 2) * 1024, wave);
            if (s == 0) build_w12(P, l, wave);
        }
        if (step != 11) grid.sync();
    }
}

extern "C" void kernel_launch(void* const* d_in, const int* in_sizes, int n_in, void* d_out, int out_size, void* d_ws, size_t ws_size, hipStream_t stream) {
    static int grid = 0;
    if (grid == 0) {
        if (n_in != 20 || out_size != NTOK * DM || ws_size < WS_END) { fprintf(stderr, "kernel_launch: unexpected shapes: n_in %d out %d ws %zu (need %zu)\n", n_in, out_size, ws_size, (size_t)WS_END); grid = -1; return; }
        int dev = 0, cus = 0, per_cu = 0;
        hipGetDevice(&dev);
        hipDeviceGetAttribute(&cus, hipDeviceAttributeMultiprocessorCount, dev);
        if (hipFuncSetAttribute((const void*)mk_fwd, hipFuncAttributeMaxDynamicSharedMemorySize, LDS_BYTES) != hipSuccess) { fprintf(stderr, "kernel_launch: hipFuncSetAttribute failed\n"); grid = -1; return; }
        if (hipOccupancyMaxActiveBlocksPerMultiprocessor(&per_cu, (const void*)mk_fwd, NTHREADS, LDS_BYTES) != hipSuccess || per_cu < 1) { fprintf(stderr, "kernel_launch: occupancy query failed (%d)\n", per_cu); per_cu = 1; }
        (void)hipGetLastError();
        grid = cus * per_cu;
    }
    if (grid < 0) return;
    Params p{};
    for (int i = 0; i < 20; ++i) p.in[i] = (const float*)d_in[i];
    p.out = (float*)d_out; p.ws = (unsigned char*)d_ws;
    void* args[] = {&p};
    hipError_t e = hipLaunchCooperativeKernel((const void*)mk_fwd, dim3(grid), dim3(NTHREADS), args, LDS_BYTES, stream);
    if (e != hipSuccess) fprintf(stderr, "cooperative launch failed: %s (grid %d)\n", hipGetErrorString(e), grid);
}
```

```cpp
#include <hip/hip_runtime.h>
#include <hip/hip_cooperative_groups.h>
#include <cstdio>
#include <cstdint>
namespace cg = cooperative_groups;

#define LAS __attribute__((address_space(3)))
typedef unsigned short bf16_t;
typedef short bf16x8 __attribute__((ext_vector_type(8)));
typedef short s16x4 __attribute__((ext_vector_type(4)));
typedef float f32x4 __attribute__((ext_vector_type(4)));
typedef float f32x2 __attribute__((ext_vector_type(2)));
typedef float f32x16 __attribute__((ext_vector_type(16)));
typedef unsigned u32x4 __attribute__((ext_vector_type(4)));
typedef unsigned u32x2 __attribute__((ext_vector_type(2)));
typedef __bf16 bf2_t __attribute__((ext_vector_type(2)));
#define DI __device__ __forceinline__

constexpr int NTOK = 65536, DM = 1024, FF = 2816, NL = 4, NGRP = 32, SEQ = 4096;
constexpr float RMS_EPS = 1e-6f;
constexpr int NTHREADS = 512, NWAVES = 8;
constexpr int LDS_MAIN = 131072, LDS_BYTES = LDS_MAIN + 16;
#ifndef REP_GEMM
#define REP_GEMM 1
#endif
#ifndef REP_SYNC
#define REP_SYNC 1
#endif
#ifndef REP_EW
#define REP_EW 0
#endif
#ifndef REP_PRO
#define REP_PRO 1
#endif
#ifndef REP_CARRY
#define REP_CARRY 1
#endif
#ifndef REP_BUILD
#define REP_BUILD 1
#endif
#define GSYNC() do { _Pragma("unroll 1") for (int rs_ = 0; rs_ < REP_SYNC; ++rs_) xcd_barrier(xbar, wave); } while (0)
#ifndef REP_ATTN
#define REP_ATTN 1
#endif

constexpr size_t SZ_WGU = (size_t)5632 * 1024 * 2, SZ_WD = (size_t)1024 * 2816 * 2, SZ_WIN = (size_t)4096 * 1024 * 2;
constexpr size_t SZ_WGL = (size_t)1024 * 512 * 2, SZ_WOUT = (size_t)1024 * 1024 * 2, SZ_WO = (size_t)1024 * 1024 * 2;
constexpr size_t OFF_WGU = 0;
constexpr size_t OFF_WD = OFF_WGU + 8 * SZ_WGU;
constexpr size_t OFF_WIN = OFF_WD + 8 * SZ_WD;
constexpr size_t OFF_WGL = OFF_WIN + 4 * SZ_WIN;
constexpr size_t OFF_WOUT = OFF_WGL + 4 * SZ_WGL;
constexpr size_t OFF_WO = OFF_WOUT + 4 * SZ_WOUT;
constexpr size_t SZ_PW1 = (size_t)65 * 64 * 2 * 4;
constexpr size_t SZ_BB1 = (size_t)64 * 16 * 2 * 4;
constexpr size_t SZ_KE1 = (size_t)64 * 256 * 4;
constexpr size_t OFF_PW = OFF_WO + 4 * SZ_WO;
constexpr size_t OFF_BB = OFF_PW + 128 * SZ_PW1;
constexpr size_t OFF_KERN = OFF_BB + 128 * SZ_BB1;
constexpr size_t OFF_W1 = OFF_KERN + 128 * SZ_KE1;
constexpr size_t OFF_W2 = OFF_W1 + (size_t)32 * 256 * 1024 * 2;
constexpr size_t OFF_XN = OFF_W2 + (size_t)32 * 1024 * 1152 * 2;
constexpr size_t OFF_M1 = OFF_XN + (size_t)NTOK * 1024 * 2;
constexpr size_t OFF_SSP = OFF_M1 + (size_t)NTOK * 1024 * 2;
constexpr size_t OFF_OV = OFF_SSP + (size_t)64 * NTOK * 4;
constexpr size_t OFF_H = OFF_OV;
constexpr size_t OFF_U = OFF_OV;
constexpr size_t OFF_Q = OFF_U + (size_t)32 * 1024 * 1152 * 2;
constexpr size_t OFF_K = OFF_Q + (size_t)NTOK * 512 * 2;
constexpr size_t OFF_VT = OFF_K + (size_t)NTOK * 512 * 2;
constexpr size_t OFF_SB = OFF_VT + (size_t)NTOK * 512 * 2;
constexpr size_t OFF_S = OFF_SB + (size_t)NTOK * 1024 * 2;
constexpr size_t OV_MIX = OFF_S + (size_t)32 * 1024 * 128 * 4 - OFF_OV;
constexpr size_t OV_FFN = (size_t)NTOK * 2816 * 2;
constexpr size_t OFF_BAR = OFF_OV + (OV_MIX > OV_FFN ? OV_MIX : OV_FFN);
constexpr size_t BAR_BYTES = 16384;
constexpr size_t WS_END = OFF_BAR + BAR_BYTES;

DI const char* uni_ptr(const char* p) { const unsigned long long v = (unsigned long long)p; const unsigned lo = __builtin_amdgcn_readfirstlane((unsigned)v), hi = __builtin_amdgcn_readfirstlane((unsigned)(v >> 32)); return (const char*)(((unsigned long long)hi << 32) | lo); }
DI int opaque_tid(int wave_s) { int t = wave_s * 64 + (int)__builtin_amdgcn_mbcnt_hi(~0u, __builtin_amdgcn_mbcnt_lo(~0u, 0u)); asm volatile("" : "+v"(t)); return t; }
DI unsigned pk2(float a, float b) { f32x2 v = {a, b}; bf2_t r = __builtin_convertvector(v, bf2_t); return __builtin_bit_cast(unsigned, r); }
DI float bflo(unsigned u) { return __uint_as_float(u << 16); }
DI float bfhi(unsigned u) { return __uint_as_float(u & 0xffff0000u); }
DI float shx(float v, int lane, int o) { return __int_as_float(__builtin_amdgcn_ds_bpermute((lane ^ o) << 2, __float_as_int(v))); }
DI float wave_sum(float v, int lane) {
#pragma unroll
    for (int o = 1; o < 64; o <<= 1) v += shx(v, lane, o);
    return v;
}
DI float fsigmoid(float x) { return __builtin_amdgcn_rcpf(1.f + __expf(-x)); }
DI float fsilu(float x) { return x * fsigmoid(x); }
DI float fgelu_tanh(float x) { return x * fsigmoid(1.5957691216f * (x + 0.044715f * x * x * x)); }
DI u32x4 pack8(const f32x4 a, const f32x4 b) { u32x4 w; w.x = pk2(a[0], a[1]); w.y = pk2(a[2], a[3]); w.z = pk2(b[0], b[1]); w.w = pk2(b[2], b[3]); return w; }
DI void unpack8(const u32x4 w, f32x4& a, f32x4& b) { a = (f32x4){bflo(w.x), bfhi(w.x), bflo(w.y), bfhi(w.y)}; b = (f32x4){bflo(w.z), bfhi(w.z), bflo(w.w), bfhi(w.w)}; }


#define XB_TMO      128
#define XB_XCNT(j)  (256  + 64 * (j))
#define XB_XSUB(j)  (1280 + 64 * (j))
#define XB_XGEN(j)  (2304 + 64 * (j))
#define XB_TOP      3328
#define XB_TOPGEN   3392
#define XCD_BAR_WORDS 3456
#define XB_SPIN_CAP (1u << 20)
DI unsigned xb_ld(unsigned* p)              { return __hip_atomic_load(p, __ATOMIC_RELAXED, __HIP_MEMORY_SCOPE_AGENT); }
DI unsigned xb_add(unsigned* p, unsigned v) { return __hip_atomic_fetch_add(p, v, __ATOMIC_RELAXED, __HIP_MEMORY_SCOPE_AGENT); }
DI unsigned xb_xcc_id() { return (unsigned)__builtin_amdgcn_s_getreg((3 << 11) | 20) & 0xFu; }
#define XB_SPIN(cond, bar) do { unsigned _sp = 0; while (cond) { __builtin_amdgcn_s_sleep(1); \
    if ((++_sp & 255u) == 0u) { if (xb_ld(&(bar)[XB_TMO])) break; if (_sp > XB_SPIN_CAP) { atomicAdd(&(bar)[XB_TMO], 1u); break; } } } } while (0)
struct XcdBarrier { unsigned* bar; unsigned x; volatile LAS unsigned* st; };
DI void xcd_barrier_complete(unsigned* bar, unsigned x, unsigned& nloc, unsigned& nx) {
    const unsigned G = gridDim.x;
    unsigned sum, cnt, mine, sp = 0u;
    for (;;) {
        sum = 0u; cnt = 0u; mine = 0u;
#pragma unroll
        for (unsigned j = 0; j < 16; ++j) { const unsigned c = xb_ld(&bar[XB_XCNT(j)]); sum += c; cnt += (c > 0u) ? 1u : 0u; mine = (j == x) ? c : mine; }
        if (sum == G) break;
        __builtin_amdgcn_s_sleep(1);
        if ((++sp & 255u) == 0u) { if (xb_ld(&bar[XB_TMO])) break; if (sp > XB_SPIN_CAP) { atomicAdd(&bar[XB_TMO], 1u); break; } }
    }
    nloc = mine > 0u ? mine : 1u; nx = cnt > 0u ? cnt : 1u;
}
DI void xcd_barrier(const XcdBarrier& b, int wave_s) {
    asm volatile("s_waitcnt vmcnt(0)" ::: "memory");
    __syncthreads();
    if (opaque_tid(wave_s) == 0) {
        unsigned* bar = b.bar;
        __builtin_amdgcn_s_waitcnt(0);
        unsigned nloc = b.st[0], nx = b.st[1];
        if (nloc == 0u) { xcd_barrier_complete(bar, b.x, nloc, nx); b.st[0] = nloc; b.st[1] = nx; }
        const unsigned old = xb_add(&bar[XB_XSUB(b.x)], 1u);
        const unsigned gen = old / nloc;
        if (old + 1u == (gen + 1u) * nloc) {
            __builtin_amdgcn_fence(__ATOMIC_RELEASE, "agent");
            asm volatile("s_waitcnt vmcnt(0)" ::: "memory");
            const unsigned og = xb_add(&bar[XB_TOP], 1u);
            const unsigned tg = og / nx;
            if (og + 1u == (tg + 1u) * nx) xb_add(&bar[XB_TOPGEN], 1u);
            else XB_SPIN(xb_ld(&bar[XB_TOPGEN]) == tg, bar);
            __builtin_amdgcn_fence(__ATOMIC_ACQUIRE, "agent");
            xb_add(&bar[XB_XGEN(b.x)], 1u);
            asm volatile("s_waitcnt vmcnt(0)" ::: "memory");
        } else {
            XB_SPIN(xb_ld(&bar[XB_XGEN(b.x)]) == gen, bar);
            __builtin_amdgcn_fence(__ATOMIC_ACQUIRE, "agent");
            asm volatile("s_waitcnt vmcnt(0)" ::: "memory");
        }
    }
    __syncthreads();
}

namespace pg8 {
constexpr int BM = 256, BK = 64, HALF = 128, HTB = HALF * BK * 2, STAGE_BYTES = 8 * HTB, NXCD = 8, WGM = 8;
DI int lds_byte(int r, int c) { const int st = (r >> 4) * 2 + (c >> 5), rr = r & 15, cc = c & 31, ob = rr * 64 + cc * 2; return st * 1024 + (ob ^ (((ob >> 9) & 1) << 5)); }
DI void stage_rc(int b, int& R, int& C) { const int st = b / 1024, sb = b % 1024, swz = sb ^ (((sb >> 9) & 1) << 5); R = (st >> 1) * 16 + swz / 64; C = (st & 1) * 32 + (swz % 64) / 2; }
DI int perm32(int rho) { const int n = rho >> 4, i = rho & 15; return 8 * (i >> 2) + 4 * n + (i & 3); }

struct Unit { int pm, pn, pb; };
struct Gemm { const char* A; const char* B; int lda, ldb; size_t a_pm, a_pb, b_pn, b_pb; int nt0, ntstep; };
struct Order {
    int nM, nN, nB, nwg, G, c, mode;
    DI void init(int nM_, int nN_, int nB_, int mode_, int G_, int c_) { nM = nM_; nN = nN_; nB = nB_; mode = mode_; nwg = nM * nN * nB; G = G_; c = c_; }
    DI bool next(int i, Unit& u) const {
        const long L = (long)i * G + c; if (L >= nwg) return false;
        if (mode == 0) {
            int wgid = (int)L; { const int q = nwg / NXCD, r = nwg % NXCD, xcd = wgid % NXCD, off = wgid / NXCD; wgid = (xcd < r ? xcd * (q + 1) : r * (q + 1) + (xcd - r) * q) + off; }
            const int nig = WGM * nN, gid = wgid / nig, fm = gid * WGM, gsz = (nM - fm) < WGM ? (nM - fm) : WGM;
            u.pm = fm + ((wgid % nig) % gsz); u.pn = (wgid % nig) / gsz; u.pb = 0;
        } else {
            const int per = nM * nN, l = (int)L; u.pb = l / per; const int rem = l % per; u.pm = rem / nN; int pn = rem % nN;
            if (mode == 2 && (i & 1)) pn = nN - 1 - pn;
            u.pn = pn;
        }
        u.pm = __builtin_amdgcn_readfirstlane(u.pm); u.pn = __builtin_amdgcn_readfirstlane(u.pn); u.pb = __builtin_amdgcn_readfirstlane(u.pb);
        return true;
    }
};

template <class Epi>
DI void gemm_phase(LAS unsigned char* lds, const Gemm g, const Order& S, const Epi& E, int wave_s) {
    const int tid = opaque_tid(wave_s);
    const int wid = __builtin_amdgcn_readfirstlane(tid >> 6), lane = tid & 63, wr = wid >> 2, wc = wid & 3, fr = lane & 15, fq = lane >> 4;
    unsigned voffA[2], voffB[2];
#pragma unroll
    for (int i = 0; i < 2; ++i) { int R, C; stage_rc(tid * 16 + i * 8192, R, C); const int Rb = (R & ~31) + perm32(R & 31);
        voffA[i] = (unsigned)(R * g.lda + C) * 2u; voffB[i] = (unsigned)(Rb * g.ldb + C) * 2u; }
    const size_t kstep = (size_t)(BK * 2);
    const size_t hstepA = (size_t)HALF * g.lda * 2, hstepB = (size_t)HALF * g.ldb * 2;
    const unsigned ldsw = (unsigned)wid * 1024u;
    const int aoff = lds_byte(wr * 64 + fr, fq * 8), boff = lds_byte(wc * 32 + fr, fq * 8);
#define PG8_SA(b, h) (((b) * 2 + (h)) * HTB)
#define PG8_SB(b, h) ((4 + (b) * 2 + (h)) * HTB)
#define PG8_STAGE(bufoff, gbase, voff) do { _Pragma("unroll") for (int _i = 0; _i < 2; ++_i) \
        __builtin_amdgcn_global_load_lds((const unsigned*)((const char*)(gbase) + (voff)[_i]), (LAS unsigned*)(lds + (bufoff) + ldsw + _i * 8192), 16, 0, 0); } while (0)
#define PG8_LDA(dst, b, h) do { _Pragma("unroll") for (int m = 0; m < 4; ++m) _Pragma("unroll") for (int k = 0; k < 2; ++k) dst[m][k] = *(const LAS bf16x8*)(lds + PG8_SA(b, h) + aoff + m * 2048 + k * 1024); } while (0)
#define PG8_LDB(dst, b, h) do { _Pragma("unroll") for (int n = 0; n < 2; ++n) _Pragma("unroll") for (int k = 0; k < 2; ++k) dst[n][k] = *(const LAS bf16x8*)(lds + PG8_SB(b, h) + boff + n * 2048 + k * 1024); } while (0)
#define PG8_MMA(ai, bj, At, Bt) do { __builtin_amdgcn_s_setprio(1); _Pragma("unroll") for (int m = 0; m < 4; ++m) _Pragma("unroll") for (int n = 0; n < 2; ++n) _Pragma("unroll") for (int k = 0; k < 2; ++k) \
        acc[ai][bj][m][n] = __builtin_amdgcn_mfma_f32_16x16x32_bf16(Bt[n][k], At[m][k], acc[ai][bj][m][n], 0, 0, 0); __builtin_amdgcn_s_setprio(0); } while (0)
#define PG8_WAIT_V(n) asm volatile("s_waitcnt vmcnt(" #n ")" ::: "memory")
#define PG8_WAIT_L(n) asm volatile("s_waitcnt lgkmcnt(" #n ")" ::: "memory")
#define PG8_BAR __builtin_amdgcn_s_barrier()
#define PG8_SCHED __builtin_amdgcn_sched_barrier(0)
    Unit cur, nxt; int ui = 0;
    if (!S.next(0, cur)) return;
    f32x4 acc[2][2][4][2];
#pragma unroll
    for (int a = 0; a < 2; ++a)
#pragma unroll
        for (int b = 0; b < 2; ++b)
#pragma unroll
            for (int m = 0; m < 4; ++m)
#pragma unroll
                for (int n = 0; n < 2; ++n) acc[a][b][m][n] = (f32x4){0.f, 0.f, 0.f, 0.f};
    bf16x8 At[4][2], B0[2][2], B1[2][2];
    const char* cA = uni_ptr(g.A + (size_t)cur.pb * g.a_pb + (size_t)cur.pm * g.a_pm);
    const char* cB = uni_ptr(g.B + (size_t)cur.pb * g.b_pb + (size_t)cur.pn * g.b_pn);
    PG8_STAGE(PG8_SB(0, 0), cB, voffB); PG8_STAGE(PG8_SB(0, 1), cB + hstepB, voffB); PG8_STAGE(PG8_SA(0, 0), cA, voffA); PG8_STAGE(PG8_SA(0, 1), cA + hstepA, voffA);
    if (wr == 1) PG8_BAR;
    PG8_WAIT_V(2); PG8_BAR;
    PG8_STAGE(PG8_SB(1, 0), cB + kstep, voffB); PG8_STAGE(PG8_SA(1, 0), cA + kstep, voffA); PG8_STAGE(PG8_SB(1, 1), cB + hstepB + kstep, voffB);
    PG8_WAIT_V(6); PG8_BAR;
    for (;;) {
        const bool has_next = S.next(ui + 1, nxt);
        const char* nA = uni_ptr(has_next ? g.A + (size_t)nxt.pb * g.a_pb + (size_t)nxt.pm * g.a_pm : cA);
        const char* nB = uni_ptr(has_next ? g.B + (size_t)nxt.pb * g.b_pb + (size_t)nxt.pn * g.b_pn : cB);
        const int nt = g.nt0 + g.ntstep * cur.pn;
        for (int t = 0; t < nt; t += 2) {
            const bool last = (t == nt - 2);
            if constexpr (Epi::HAS_MID) { if (t == Epi::TMID) E.mid(acc, cur, wr, wc, fr, fq); }
            const char* a1 = cA + (size_t)(t + 1) * kstep;
            const char* a2 = last ? nA : cA + (size_t)(t + 2) * kstep; const char* b2 = last ? nB : cB + (size_t)(t + 2) * kstep;
            const char* a3 = a2 + kstep; const char* b3 = b2 + kstep;
            PG8_LDB(B0, 0, 0); PG8_LDB(B1, 0, 1); PG8_SCHED; PG8_LDA(At, 0, 0); PG8_STAGE(PG8_SA(1, 1), a1 + hstepA, voffA);
            PG8_WAIT_V(8); PG8_WAIT_L(0); PG8_BAR; PG8_MMA(0, 0, At, B0); PG8_MMA(0, 1, At, B1); PG8_BAR; PG8_SCHED;
            PG8_LDA(At, 0, 1); PG8_STAGE(PG8_SB(0, 0), b2, voffB); PG8_STAGE(PG8_SB(0, 1), b2 + hstepB, voffB); PG8_STAGE(PG8_SA(0, 0), a2, voffA);
            PG8_WAIT_V(8); PG8_WAIT_L(0); PG8_BAR; PG8_MMA(1, 0, At, B0); PG8_MMA(1, 1, At, B1); PG8_BAR; PG8_SCHED;
            PG8_LDB(B0, 1, 0); PG8_LDB(B1, 1, 1); PG8_SCHED; PG8_LDA(At, 1, 0); PG8_STAGE(PG8_SA(0, 1), a2 + hstepA, voffA);
            PG8_WAIT_V(8); PG8_WAIT_L(0); PG8_BAR; PG8_MMA(0, 0, At, B0); PG8_MMA(0, 1, At, B1); PG8_BAR; PG8_SCHED;
            PG8_LDA(At, 1, 1); PG8_STAGE(PG8_SB(1, 0), b3, voffB); PG8_STAGE(PG8_SB(1, 1), b3 + hstepB, voffB); PG8_STAGE(PG8_SA(1, 0), a3, voffA);
            PG8_WAIT_V(8); PG8_WAIT_L(0); PG8_BAR; PG8_MMA(1, 0, At, B0); PG8_MMA(1, 1, At, B1); PG8_BAR; PG8_SCHED;
        }
        if (wr == 0) PG8_BAR;
        E(acc, cur, wr, wc, fr, fq);
        if (!has_next) break;
#pragma unroll
        for (int a = 0; a < 2; ++a)
#pragma unroll
            for (int b = 0; b < 2; ++b)
#pragma unroll
                for (int m = 0; m < 4; ++m)
#pragma unroll
                    for (int n = 0; n < 2; ++n) acc[a][b][m][n] = (f32x4){0.f, 0.f, 0.f, 0.f};
        cur = nxt; cA = nA; cB = nB; ++ui;
        if (wr == 1) PG8_BAR;
    }
    PG8_WAIT_V(0);
    PG8_BAR;
#undef PG8_SA
#undef PG8_SB
#undef PG8_STAGE
#undef PG8_LDA
#undef PG8_LDB
#undef PG8_MMA
#undef PG8_WAIT_V
#undef PG8_WAIT_L
#undef PG8_BAR
#undef PG8_SCHED
}
}
using pg8::Unit;
typedef f32x4 AccT[2][2][4][2];

template <int ACT> struct EpiGated {
    static constexpr bool HAS_MID = false; static constexpr int TMID = -1;
    bf16_t* O; int ldc;
    DI void mid(AccT&, const Unit&, int, int, int, int) const {}
    DI void operator()(const AccT& acc, const Unit& u, int wr, int wc, int fr, int fq) const {
        const int row0 = u.pm * 256 + wr * 64 + fr, col0 = u.pn * 128 + wc * 32 + 8 * fq;
#pragma unroll
        for (int ai = 0; ai < 2; ++ai)
#pragma unroll
            for (int m = 0; m < 4; ++m) {
                f32x4 o[2];
#pragma unroll
                for (int n = 0; n < 2; ++n)
#pragma unroll
                    for (int e = 0; e < 4; ++e) { const float a = acc[ai][0][m][n][e], b = acc[ai][1][m][n][e]; o[n][e] = ACT == 0 ? fsilu(a) * b : a * fsigmoid(b); }
                *(u32x4*)(O + (size_t)(row0 + ai * 128 + m * 16) * ldc + col0) = pack8(o[0], o[1]);
            }
    }
};
struct EpiDown {
    static constexpr bool HAS_MID = false; static constexpr int TMID = -1;
    bf16_t* O; float* ssp;
    DI void mid(AccT&, const Unit&, int, int, int, int) const {}
    DI void operator()(const AccT& acc, const Unit& u, int wr, int wc, int fr, int fq) const {
        const int row0 = u.pm * 256 + wr * 64 + fr, col0 = u.pn * 256 + wc * 32 + 8 * fq;
#pragma unroll
        for (int ai = 0; ai < 2; ++ai)
#pragma unroll
            for (int m = 0; m < 4; ++m) {
                const int row = row0 + ai * 128 + m * 16; float ss = 0.f;
#pragma unroll
                for (int bj = 0; bj < 2; ++bj) {
                    const f32x4 v0 = acc[ai][bj][m][0], v1 = acc[ai][bj][m][1];
                    ss += (v0[0] * v0[0] + v0[1] * v0[1]) + (v0[2] * v0[2] + v0[3] * v0[3]) + (v1[0] * v1[0] + v1[1] * v1[1]) + (v1[2] * v1[2] + v1[3] * v1[3]);
                    *(u32x4*)(O + (size_t)row * 1024 + col0 + bj * 128) = pack8(v0, v1);
                }
                ssp[(size_t)(u.pn * 16 + wc * 4 + fq) * NTOK + row] = ss;
            }
    }
};
struct EpiWin {
    static constexpr bool HAS_MID = false; static constexpr int TMID = -1;
    bf16_t *U, *Q, *K, *VT, *R, *SB;
    DI void mid(AccT&, const Unit&, int, int, int, int) const {}
    DI void operator()(const AccT& acc, const Unit& u, int wr, int wc, int fr, int fq) const {
        const int row0 = u.pm * 256 + wr * 64 + fr, pn = u.pn;
        if (pn < 2) {
#pragma unroll
            for (int ai = 0; ai < 2; ++ai)
#pragma unroll
                for (int m = 0; m < 4; ++m) { const int row = row0 + ai * 128 + m * 16, bc = row >> 6, j = row & 63;
#pragma unroll
                    for (int bj = 0; bj < 2; ++bj) { const int c = pn * 256 + bj * 128 + wc * 32 + 8 * fq, gi = c >> 4, h0 = c & 15;
                        *(u32x4*)(U + ((size_t)gi * 1024 + bc) * 1152 + 128 + j * 16 + h0) = pack8(acc[ai][bj][m][0], acc[ai][bj][m][1]); } }
        } else if (pn < 6) {
            bf16_t* O = pn < 4 ? Q : K; const int cb = (pn & 1) * 256 + wc * 32 + 8 * fq;
#pragma unroll
            for (int ai = 0; ai < 2; ++ai)
#pragma unroll
                for (int m = 0; m < 4; ++m) { const int row = row0 + ai * 128 + m * 16;
#pragma unroll
                    for (int bj = 0; bj < 2; ++bj) *(u32x4*)(O + (size_t)row * 512 + cb + bj * 128) = pack8(acc[ai][bj][m][0], acc[ai][bj][m][1]); }
        } else if (pn < 8) {
#pragma unroll
            for (int ai = 0; ai < 2; ++ai)
#pragma unroll
                for (int m = 0; m < 4; ++m) { const int row = row0 + ai * 128 + m * 16, b = row >> 12, s = row & 4095;
#pragma unroll
                    for (int bj = 0; bj < 2; ++bj) { const int c = (pn - 6) * 256 + bj * 128 + wc * 32 + 8 * fq, hd = c >> 6, d0 = c & 63;
                        bf16_t* o = VT + (((size_t)b * 8 + hd) * 64 + d0) * 4096 + s;
                        const u32x4 w = pack8(acc[ai][bj][m][0], acc[ai][bj][m][1]);
                        o[0 * 4096] = (bf16_t)(w.x & 0xffff); o[1 * 4096] = (bf16_t)(w.x >> 16); o[2 * 4096] = (bf16_t)(w.y & 0xffff); o[3 * 4096] = (bf16_t)(w.y >> 16);
                        o[4 * 4096] = (bf16_t)(w.z & 0xffff); o[5 * 4096] = (bf16_t)(w.z >> 16); o[6 * 4096] = (bf16_t)(w.w & 0xffff); o[7 * 4096] = (bf16_t)(w.w >> 16); } }
        } else {
            const int cb = (pn - 8) * 128 + wc * 32 + 8 * fq;
#pragma unroll
            for (int ai = 0; ai < 2; ++ai)
#pragma unroll
                for (int m = 0; m < 4; ++m) { const int row = row0 + ai * 128 + m * 16; f32x4 r[2], sb[2];
#pragma unroll
                    for (int n = 0; n < 2; ++n)
#pragma unroll
                        for (int e = 0; e < 4; ++e) { const float sa = fsigmoid(acc[ai][0][m][n][e]), sbv = fsigmoid(acc[ai][1][m][n][e]); sb[n][e] = sbv; r[n][e] = sa / sbv; }
                    *(u32x4*)(R + (size_t)row * 1024 + cb) = pack8(r[0], r[1]);
                    *(u32x4*)(SB + (size_t)row * 1024 + cb) = pack8(sb[0], sb[1]); }
        }
    }
};
struct EpiS {
    static constexpr bool HAS_MID = false; static constexpr int TMID = -1;
    float* S;
    DI void mid(AccT&, const Unit&, int, int, int, int) const {}
    DI void operator()(const AccT& acc, const Unit& u, int wr, int wc, int fr, int fq) const {
        const int row0 = u.pm * 256 + wr * 64 + fr, col0 = wc * 32 + 8 * fq;
#pragma unroll
        for (int ai = 0; ai < 2; ++ai)
#pragma unroll
            for (int m = 0; m < 4; ++m) { float* o = S + ((size_t)u.pb * 1024 + row0 + ai * 128 + m * 16) * 128 + col0;
                *(f32x4*)o = acc[ai][0][m][0]; *(f32x4*)(o + 4) = acc[ai][0][m][1]; }
    }
};
struct EpiY {
    static constexpr bool HAS_MID = false; static constexpr int TMID = -1;
    bf16_t* YA;
    DI void mid(AccT&, const Unit&, int, int, int, int) const {}
    DI void operator()(const AccT& acc, const Unit& u, int wr, int wc, int fr, int fq) const {
        const int row0 = u.pm * 256 + wr * 64 + fr;
#pragma unroll
        for (int ai = 0; ai < 2; ++ai)
#pragma unroll
            for (int m = 0; m < 4; ++m) { const int row = row0 + ai * 128 + m * 16;
#pragma unroll
                for (int bj = 0; bj < 2; ++bj) { const int c = u.pn * 256 + bj * 128 + wc * 32 + 8 * fq, t = c >> 4, h0 = c & 15; f32x4 o[2];
#pragma unroll
                    for (int n = 0; n < 2; ++n)
#pragma unroll
                        for (int e = 0; e < 4; ++e) o[n][e] = fgelu_tanh(acc[ai][bj][m][n][e]);
                    *(u32x4*)(YA + ((size_t)row * 64 + t) * 512 + u.pb * 16 + h0) = pack8(o[0], o[1]); } }
    }
};
struct EpiMerge {
    static constexpr bool HAS_MID = true; static constexpr int TMID = 8;
    const bf16_t *R, *SB; bf16_t* O; int wave_s;
    DI void scale(AccT& acc, const Unit& u, int, int, int, int, const bf16_t* P) const {
        const int t_ = opaque_tid(wave_s), wid = __builtin_amdgcn_readfirstlane(t_ >> 6), ln = t_ & 63, wr = wid >> 2, wc = wid & 3, fr = ln & 15, fq = ln >> 4;
        const int row0 = u.pm * 256 + wr * 64 + fr, col0 = u.pn * 256 + wc * 32 + 8 * fq;
#pragma unroll
        for (int ai = 0; ai < 2; ++ai)
#pragma unroll
            for (int m = 0; m < 4; ++m)
#pragma unroll
                for (int bj = 0; bj < 2; ++bj) { const u32x4 w = *(const u32x4*)(P + (size_t)(row0 + ai * 128 + m * 16) * 1024 + col0 + bj * 128); f32x4 a, b; unpack8(w, a, b);
                    acc[ai][bj][m][0] *= a; acc[ai][bj][m][1] *= b; }
    }
    DI void mid(AccT& acc, const Unit& u, int wr, int wc, int fr, int fq) const { scale(acc, u, wr, wc, fr, fq, R); }
    DI void operator()(AccT& acc, const Unit& u, int wr, int wc, int fr, int fq) const {
        scale(acc, u, wr, wc, fr, fq, SB);
        const int row0 = u.pm * 256 + wr * 64 + fr, col0 = u.pn * 256 + wc * 32 + 8 * fq;
#pragma unroll
        for (int ai = 0; ai < 2; ++ai)
#pragma unroll
            for (int m = 0; m < 4; ++m)
#pragma unroll
                for (int bj = 0; bj < 2; ++bj) *(u32x4*)(O + (size_t)(row0 + ai * 128 + m * 16) * 1024 + col0 + bj * 128) = pack8(acc[ai][bj][m][0], acc[ai][bj][m][1]);
    }
};

struct Params { const float* in[20]; float* out; unsigned char* ws; };
enum { I_X = 0, I_GAINS, I_WGATE, I_WUP, I_WDOWN, I_WIN, I_LRE, I_LIM, I_LOGDT, I_BRE, I_BIM, I_CRE, I_CIM, I_DSKIP, I_GLUV, I_GLUG, I_OSSM, I_RELB, I_OATT, I_WO };

DI int map_row(int map, int n) {
    if (map == 0) return n;
    if (map == 1) return 256 * (n >> 7) + (n & 127);
    if (map == 2) return 256 * (n >> 7) + 128 + (n & 127);
    if (n < 2048) return n;
    if (n < 3072) { const int j = n - 2048; return 2048 + 256 * (j >> 7) + (j & 127); }
    const int j = n - 3072; return 2048 + 256 * (j >> 7) + 128 + (j & 127);
}
DI void cvt_item(const float* W, int K, int N, bf16_t* WT, int ldk, int koff, int map, LAS float* scr, int item, int lane) {
    const int nblk = N / 32, kb = item / nblk, nb = item % nblk, k0 = 64 * kb, n0 = 32 * nb;
    const float sc = (map == 3 && n0 >= 512 && n0 < 1024) ? 0.125f : 1.f;
#pragma unroll 8
    for (int i = 0; i < 32; ++i) { const int kk = 2 * i + (lane >> 5); scr[kk * 33 + (lane & 31)] = W[(size_t)(k0 + kk) * N + n0 + (lane & 31)] * sc; }
    asm volatile("s_waitcnt lgkmcnt(0)" ::: "memory");
    const int c = lane & 7;
#pragma unroll
    for (int j = 0; j < 4; ++j) { const int n = (lane >> 3) + 8 * j; const LAS float* s = scr + (8 * c) * 33 + n;
        u32x4 o; o.x = pk2(s[0 * 33], s[1 * 33]); o.y = pk2(s[2 * 33], s[3 * 33]); o.z = pk2(s[4 * 33], s[5 * 33]); o.w = pk2(s[6 * 33], s[7 * 33]);
        *(u32x4*)(WT + (size_t)map_row(map, n0 + n) * ldk + koff + k0 + 8 * c) = o; }
    asm volatile("s_waitcnt lgkmcnt(0)" ::: "memory");
}
DI void cvt_matrix(const float* W, int K, int N, bf16_t* WT, int ldk, int koff, int map, LAS float* scr, int gw, int NGW, int lane) {
    const int nitems = (K / 64) * (N / 32);
    for (int it = gw; it < nitems; it += NGW) cvt_item(W, K, N, WT, ldk, koff, map, scr, it, lane);
}

DI void s5_tables(const Params& P, LAS unsigned char* lds, int lg) {
    LAS float* pw = (LAS float*)lds;
    LAS float* bb = pw + 65 * 64 * 2;
    LAS float* cc = bb + 64 * 16 * 2;
    LAS float* ff = cc + 16 * 64 * 2;
    const int tid = threadIdx.x;
    unsigned char* ws = P.ws;
    float* gPW = (float*)(ws + OFF_PW + (size_t)lg * SZ_PW1);
    float* gBB = (float*)(ws + OFF_BB + (size_t)lg * SZ_BB1);
    float* gKE = (float*)(ws + OFF_KERN + (size_t)lg * SZ_KE1);
    const double dt = exp((double)P.in[I_LOGDT][lg]);
    const float* lre = P.in[I_LRE] + (size_t)lg * 64; const float* lim = P.in[I_LIM] + (size_t)lg * 64;
    for (int idx = tid; idx < 65 * 64; idx += NTHREADS) {
        const int tau = idx >> 6, p = idx & 63;
        const double lr = lre[p], li = lim[p];
        const float mag = __expf((float)(lr * dt * tau));
        double rev = li * dt * tau * 0.15915494309189535; rev -= rint(rev);
        const float cs = __builtin_amdgcn_cosf((float)rev), sn = __builtin_amdgcn_sinf((float)rev);
        const float re = mag * cs, im = mag * sn;
        pw[idx * 2] = re; pw[idx * 2 + 1] = im; gPW[idx * 2] = re; gPW[idx * 2 + 1] = im;
        if (tau == 1) {
            const double nr = (double)re - 1.0, ni = im, den = lr * lr + li * li;
            ff[p * 2] = (float)((nr * lr + ni * li) / den); ff[p * 2 + 1] = (float)((ni * lr - nr * li) / den);
        }
    }
    __syncthreads();
    const float* bre = P.in[I_BRE] + (size_t)lg * 1024; const float* bim = P.in[I_BIM] + (size_t)lg * 1024;
    const float* cre = P.in[I_CRE] + (size_t)lg * 1024; const float* cim = P.in[I_CIM] + (size_t)lg * 1024;
    for (int idx = tid; idx < 1024; idx += NTHREADS) {
        const int p = idx >> 4;
        const float fr_ = ff[p * 2], fi_ = ff[p * 2 + 1], br = bre[idx], bi = bim[idx];
        const float re = fr_ * br - fi_ * bi, im = fr_ * bi + fi_ * br;
        bb[idx * 2] = re; bb[idx * 2 + 1] = im; gBB[idx * 2] = re; gBB[idx * 2 + 1] = im;
        cc[idx * 2] = cre[idx]; cc[idx * 2 + 1] = cim[idx];
    }
    __syncthreads();
    const float* dsk = P.in[I_DSKIP] + (size_t)lg * 16;
    for (int pair = tid; pair < 1024; pair += NTHREADS) {
        const int tau = pair >> 4, h = pair & 15;
        float a[16];
#pragma unroll
        for (int j = 0; j < 16; ++j) a[j] = 0.f;
        for (int p = 0; p < 64; ++p) {
            const float cr = cc[(h * 64 + p) * 2], ci = cc[(h * 64 + p) * 2 + 1], pr = pw[(tau * 64 + p) * 2], pi = pw[(tau * 64 + p) * 2 + 1];
            const float xr = cr * pr - ci * pi, xi = cr * pi + ci * pr;
#pragma unroll
            for (int j = 0; j < 16; ++j) a[j] += xr * bb[(p * 16 + j) * 2] - xi * bb[(p * 16 + j) * 2 + 1];
        }
        const float dv = dsk[h];
#pragma unroll
        for (int j = 0; j < 16; ++j) gKE[(size_t)pair * 16 + j] = a[j] + ((tau == 0 && j == h) ? dv : 0.f);
    }
    __syncthreads();
}

DI void build_w12(const Params& P, int l, int wave_s) {
    unsigned char* ws = P.ws;
    const float* gPW = (const float*)(ws + OFF_PW) + (size_t)l * 32 * (65 * 64 * 2);
    const float* gBB = (const float*)(ws + OFF_BB) + (size_t)l * 32 * (64 * 16 * 2);
    const float* gKE = (const float*)(ws + OFF_KERN) + (size_t)l * 32 * (64 * 256);
    bf16_t* W1 = (bf16_t*)(ws + OFF_W1); bf16_t* W2 = (bf16_t*)(ws + OFF_W2);
    const int gt = blockIdx.x * NTHREADS + opaque_tid(wave_s), NT = gridDim.x * NTHREADS;
    for (int it = gt; it < 32 * 256 * 128; it += NT) {
        const int kk = it & 127, n = (it >> 7) & 255, g = it >> 15;
        float v[8];
        if (n >= 128) {
#pragma unroll
            for (int e = 0; e < 8; ++e) v[e] = 0.f;
        } else {
            const int p = n & 63, im = n >> 6, j = kk >> 1, h0 = (kk & 1) * 8;
            const float* pwp = gPW + ((size_t)g * 65 + (63 - j)) * 128 + p * 2; const float pr = pwp[0], pi = pwp[1];
            const float* bp = gBB + ((size_t)g * 64 + p) * 32 + h0 * 2;
#pragma unroll
            for (int e = 0; e < 8; ++e) { const float br = bp[e * 2], bi = bp[e * 2 + 1]; v[e] = im ? (pr * bi + pi * br) : (pr * br - pi * bi); }
        }
        u32x4 o; o.x = pk2(v[0], v[1]); o.y = pk2(v[2], v[3]); o.z = pk2(v[4], v[5]); o.w = pk2(v[6], v[7]);
        *(u32x4*)(W1 + (size_t)it * 8) = o;
    }
    const float* cre = P.in[I_CRE] + (size_t)l * 32 * 1024; const float* cim = P.in[I_CIM] + (size_t)l * 32 * 1024;
    for (int it = gt; it < 32 * 1024 * 144; it += NT) {
        const int kk = it % 144, n = (it / 144) & 1023, g = it / (144 * 1024), t = n >> 4, h = n & 15;
        float v[8];
        if (kk < 16) {
            const int im = kk >> 3, p0 = (kk & 7) * 8;
            const float* pwp = gPW + ((size_t)g * 65 + (t + 1)) * 128 + p0 * 2;
            const float* crp = cre + ((size_t)g * 16 + h) * 64 + p0; const float* cip = cim + ((size_t)g * 16 + h) * 64 + p0;
#pragma unroll
            for (int e = 0; e < 8; ++e) { const float cr = crp[e], ci = cip[e], pr = pwp[e * 2], pi = pwp[e * 2 + 1]; v[e] = im ? -(cr * pi + ci * pr) : (cr * pr - ci * pi); }
        } else {
            const int j = (kk - 16) >> 1, h0 = ((kk - 16) & 1) * 8;
            if (j <= t) { const float* kp = gKE + (((size_t)g * 64 + (t - j)) * 16 + h) * 16 + h0;
#pragma unroll
                for (int e = 0; e < 8; ++e) v[e] = kp[e];
            } else {
#pragma unroll
                for (int e = 0; e < 8; ++e) v[e] = 0.f;
            }
        }
        u32x4 o; o.x = pk2(v[0], v[1]); o.y = pk2(v[2], v[3]); o.z = pk2(v[4], v[5]); o.w = pk2(v[6], v[7]);
        *(u32x4*)(W2 + (size_t)it * 8) = o;
    }
}

DI void ew_phase(const Params& P, const float* src, bool has_m, float coef, const float* gpost, const float* gpre, int wave_s) {
    const int tid_ = opaque_tid(wave_s), lane = tid_ & 63, wave = __builtin_amdgcn_readfirstlane(tid_ >> 6);
    unsigned char* ws = P.ws; float* xres = P.out;
    const bf16_t* M1 = (const bf16_t*)(ws + OFF_M1); const float* ssp = (const float*)(ws + OFF_SSP); bf16_t* XN = (bf16_t*)(ws + OFF_XN);
    const int gw = blockIdx.x * NWAVES + wave, NGW = gridDim.x * NWAVES;
    for (int row = gw; row < NTOK; row += NGW) {
        f32x4 v[4];
#pragma unroll
        for (int j = 0; j < 4; ++j) v[j] = *(const f32x4*)(src + (size_t)row * 1024 + j * 256 + lane * 4);
        if (has_m) {
            const float sv = ssp[(size_t)lane * NTOK + row];
            const float rstd = __builtin_amdgcn_rsqf(wave_sum(sv, lane) * (1.f / 1024.f) + RMS_EPS) * coef;
#pragma unroll
            for (int j = 0; j < 4; ++j) {
                const u32x2 w = *(const u32x2*)(M1 + (size_t)row * 1024 + j * 256 + lane * 4);
                const f32x4 gp = *(const f32x4*)(gpost + j * 256 + lane * 4);
                const f32x4 mv = {bflo(w.x), bfhi(w.x), bflo(w.y), bfhi(w.y)};
                v[j] += gp * mv * rstd;
            }
        }
#pragma unroll
        for (int j = 0; j < 4; ++j) *(f32x4*)(xres + (size_t)row * 1024 + j * 256 + lane * 4) = v[j];
        if (gpre) {
            float ss = 0.f;
#pragma unroll
            for (int j = 0; j < 4; ++j) ss += (v[j][0] * v[j][0] + v[j][1] * v[j][1]) + (v[j][2] * v[j][2] + v[j][3] * v[j][3]);
            const float rstd2 = __builtin_amdgcn_rsqf(wave_sum(ss, lane) * (1.f / 1024.f) + RMS_EPS);
#pragma unroll
            for (int j = 0; j < 4; ++j) { const f32x4 gq = *(const f32x4*)(gpre + j * 256 + lane * 4); const f32x4 o = v[j] * gq * rstd2;
                u32x2 w; w.x = pk2(o[0], o[1]); w.y = pk2(o[2], o[3]);
                *(u32x2*)(XN + (size_t)row * 1024 + j * 256 + lane * 4) = w; }
        }
    }
}

DI void carry_phase(const Params& P, int l, int wave_s) {
    const int tid_ = opaque_tid(wave_s), lane = tid_ & 63, wave = __builtin_amdgcn_readfirstlane(tid_ >> 6);
    unsigned char* ws = P.ws;
    const float* gPW = (const float*)(ws + OFF_PW) + (size_t)l * 32 * (65 * 64 * 2);
    const float* S = (const float*)(ws + OFF_S); bf16_t* U = (bf16_t*)(ws + OFF_U);
    const int gw = blockIdx.x * NWAVES + wave, NGW = gridDim.x * NWAVES;
    for (int task = gw; task < 512; task += NGW) {
        const int g = task >> 4, b = task & 15, p = lane;
        const float ar = gPW[((size_t)g * 65 + 64) * 128 + p * 2], ai = gPW[((size_t)g * 65 + 64) * 128 + p * 2 + 1];
        float xr = 0.f, xi = 0.f;
        const float* sp = S + ((size_t)g * 1024 + b * 64) * 128; bf16_t* up = U + ((size_t)g * 1024 + b * 64) * 1152;
#pragma unroll 8
        for (int c = 0; c < 64; ++c) {
            up[(size_t)c * 1152 + p] = (bf16_t)(pk2(xr, 0.f) & 0xffff); up[(size_t)c * 1152 + 64 + p] = (bf16_t)(pk2(xi, 0.f) & 0xffff);
            const float sr = sp[c * 128 + p], si = sp[c * 128 + 64 + p];
            const float nr = ar * xr - ai * xi + sr, ni = ar * xi + ai * xr + si;
            xr = nr; xi = ni;
        }
    }
}

DI int crow(int reg, int h) { return (reg & 3) + 8 * (reg >> 2) + 4 * h; }
#define MFMA32(a, b, c) __builtin_amdgcn_mfma_f32_32x32x16_bf16((a), (b), (c), 0, 0, 0)
DI bf16x8 pack_step(const f32x16& x, int s) {
    u32x4 p; p.x = pk2(x[8 * s], x[8 * s + 1]); p.y = pk2(x[8 * s + 2], x[8 * s + 3]); p.z = pk2(x[8 * s + 4], x[8 * s + 5]); p.w = pk2(x[8 * s + 6], x[8 * s + 7]);
    return __builtin_bit_cast(bf16x8, p);
}
DI void attn_phase(const Params& P, int l, LAS unsigned char* lds, int wave_s) {
    const int tid_ = opaque_tid(wave_s), lane = tid_ & 63, wave = __builtin_amdgcn_readfirstlane(tid_ >> 6);
    unsigned char* ws = P.ws;
    const bf16_t* Q = (const bf16_t*)(ws + OFF_Q); const bf16_t* K = (const bf16_t*)(ws + OFF_K); const bf16_t* VT = (const bf16_t*)(ws + OFF_VT);
    bf16_t* ZA = (bf16_t*)(ws + OFF_XN);
    LAS float* bt = (LAS float*)lds;
    LAS unsigned char* kbuf = lds + 8448;
    LAS unsigned char* vbuf = kbuf + 2 * 9216;
    const float* relb = P.in[I_RELB] + (size_t)l * 8 * 257;
    for (int i = tid_; i < 8 * 257; i += NTHREADS) bt[i] = relb[i];
    __syncthreads();
    const int n = lane & 31, gq = lane >> 5;
    const int ci = wave >> 1, qh = wave & 1;
    const int lr = tid_ >> 3, lsg = tid_ & 7;
    for (int it = blockIdx.x; it < 2048; it += gridDim.x) {
        const int y = it >> 4, cg4 = ((it & 15) + (it >> 8)) & 15, hd = y & 7, b = y >> 3;
        const int c0 = cg4 * 4, cc = c0 + ci;
        const int ktlo = c0 > 8 ? c0 - 8 : 0, kthi = c0 + 3;
        const size_t tok0 = (size_t)b * SEQ + cc * 64 + qh * 32;
        bf16x8 Qf[4];
        { const bf16_t* qp = Q + (tok0 + n) * 512 + hd * 64 + gq * 8;
#pragma unroll
          for (int ks = 0; ks < 4; ++ks) Qf[ks] = *(const bf16x8*)(qp + ks * 16); }
        f32x16 O0, O1;
#pragma unroll
        for (int i = 0; i < 16; ++i) { O0[i] = 0.f; O1[i] = 0.f; }
        float mrun = -1e30f, lrun = 0.f;
        const LAS float* bth = bt + hd * 257;
        const bf16_t* kgp = K + ((size_t)b * SEQ + lr) * 512 + hd * 64 + lsg * 8;
        const bf16_t* vgp = VT + (((size_t)b * 8 + hd) * 64 + lr) * SEQ + lsg * 8;
        u32x4 kreg = *(const u32x4*)(kgp + (size_t)ktlo * 64 * 512), vreg = *(const u32x4*)(vgp + ktlo * 64);
        for (int kt = ktlo; kt <= kthi; ++kt) {
            const int buf = (kt - ktlo) & 1;
            LAS unsigned char* kb = kbuf + buf * 9216; LAS unsigned char* vb = vbuf + buf * 8704;
            *(LAS u32x4*)(kb + lr * 144 + lsg * 16) = kreg;
            { u32x2 a; a.x = vreg.x; a.y = vreg.y; u32x2 c; c.x = vreg.z; c.y = vreg.w;
              *(LAS u32x2*)(vb + lr * 136 + lsg * 16) = a; *(LAS u32x2*)(vb + lr * 136 + lsg * 16 + 8) = c; }
            __syncthreads();
            if (kt < kthi) { kreg = *(const u32x4*)(kgp + (size_t)(kt + 1) * 64 * 512); vreg = *(const u32x4*)(vgp + (kt + 1) * 64); }
            if (kt + 8 >= cc && kt <= cc) {
                f32x16 s0, s1;
#pragma unroll
                for (int i = 0; i < 16; ++i) { s0[i] = 0.f; s1[i] = 0.f; }
#pragma unroll
                for (int ks = 0; ks < 4; ++ks) {
                    const bf16x8 k0 = *(const LAS bf16x8*)(kb + n * 144 + ks * 32 + gq * 16), k1 = *(const LAS bf16x8*)(kb + (32 + n) * 144 + ks * 32 + gq * 16);
                    s0 = MFMA32(k0, Qf[ks], s0); s1 = MFMA32(k1, Qf[ks], s1);
                }
                const int delta = cc - kt;
                if (delta >= 3) { const float cb = bth[256];
#pragma unroll
                    for (int i = 0; i < 16; ++i) { s0[i] += cb; s1[i] += cb; }
                } else { const int base = 64 * delta + qh * 32 + n + 128;
#pragma unroll
                    for (int i = 0; i < 16; ++i) { const int key = crow(i, gq); int i0 = base - key, i1 = base - key - 32;
                        i0 = i0 > 256 ? 256 : i0; i1 = i1 > 256 ? 256 : i1; i0 = i0 < 0 ? 0 : i0; i1 = i1 < 0 ? 0 : i1;
                        s0[i] += bth[i0]; s1[i] += bth[i1]; }
                }
                float mx = s0[0];
#pragma unroll
                for (int i = 1; i < 16; ++i) mx = fmaxf(mx, s0[i]);
#pragma unroll
                for (int i = 0; i < 16; ++i) mx = fmaxf(mx, s1[i]);
                mx = fmaxf(mx, shx(mx, lane, 32));
                const float mnew = fmaxf(mrun, mx), alpha = __expf(mrun - mnew); mrun = mnew;
                float ps = 0.f;
#pragma unroll
                for (int i = 0; i < 16; ++i) { s0[i] = __expf(s0[i] - mnew); s1[i] = __expf(s1[i] - mnew); ps += s0[i] + s1[i]; }
                lrun = lrun * alpha + ps;
#pragma unroll
                for (int i = 0; i < 16; ++i) { O0[i] *= alpha; O1[i] *= alpha; }
#pragma unroll
                for (int kg = 0; kg < 2; ++kg)
#pragma unroll
                    for (int s = 0; s < 2; ++s) {
                        const bf16x8 Pf = pack_step(kg == 0 ? s0 : s1, s);
                        const LAS unsigned char* v0 = vb + n * 136 + 64 * kg + 32 * s + 8 * gq;
                        const s16x4 lo0 = *(const LAS s16x4*)(v0), hi0 = *(const LAS s16x4*)(v0 + 16);
                        const s16x4 lo1 = *(const LAS s16x4*)(v0 + 32 * 136), hi1 = *(const LAS s16x4*)(v0 + 32 * 136 + 16);
                        const bf16x8 V0 = __builtin_shufflevector(lo0, hi0, 0, 1, 2, 3, 4, 5, 6, 7), V1 = __builtin_shufflevector(lo1, hi1, 0, 1, 2, 3, 4, 5, 6, 7);
                        O0 = MFMA32(V0, Pf, O0); O1 = MFMA32(V1, Pf, O1);
                    }
            }
        }
        lrun += shx(lrun, lane, 32);
        const float inv = 1.f / lrun;
        bf16_t* op = ZA + (tok0 + n) * 1024 + 512 + hd * 64 + gq * 4;
#pragma unroll
        for (int g4 = 0; g4 < 4; ++g4) {
            u32x2 w0, w1;
            w0.x = pk2(O0[4 * g4] * inv, O0[4 * g4 + 1] * inv); w0.y = pk2(O0[4 * g4 + 2] * inv, O0[4 * g4 + 3] * inv);
            w1.x = pk2(O1[4 * g4] * inv, O1[4 * g4 + 1] * inv); w1.y = pk2(O1[4 * g4 + 2] * inv, O1[4 * g4 + 3] * inv);
            *(u32x2*)(op + 8 * g4) = w0; *(u32x2*)(op + 32 + 8 * g4) = w1;
        }
        __syncthreads();
    }
}

__global__ void __launch_bounds__(NTHREADS, 2) mk_fwd(Params P) {
    extern __shared__ __attribute__((aligned(16))) unsigned char lds_raw[];
    LAS unsigned char* lds = (LAS unsigned char*)lds_raw;
    cg::grid_group grid = cg::this_grid();
    const int tid = threadIdx.x, lane = tid & 63, wave = __builtin_amdgcn_readfirstlane(tid >> 6);
    const int G = gridDim.x, bx = blockIdx.x;
    unsigned char* ws = P.ws;
    const int gw = bx * NWAVES + wave, NGW = G * NWAVES;
    volatile LAS unsigned* xst = (volatile LAS unsigned*)(lds + LDS_MAIN);
    if (tid == 0) { xst[0] = 0u; xst[1] = 0u; }
    __syncthreads();
    XcdBarrier xbar; xbar.bar = (unsigned*)(ws + OFF_BAR); xbar.x = xb_xcc_id(); xbar.st = xst;
    if (tid == 0) (void)xb_add(&xbar.bar[XB_XCNT(xbar.x)], 1u);

    {
        _Pragma("unroll 1") for (int rp_ = 0; rp_ < REP_PRO; ++rp_) {
        for (int lg = bx; lg < 128; lg += G) s5_tables(P, lds, lg);
        __syncthreads();
        LAS float* scr = (LAS float*)(lds + wave * 8704);
        for (int l = 0; l < NL; ++l) {
            for (int f = 0; f < 2; ++f) {
                bf16_t* wgu = (bf16_t*)(ws + OFF_WGU + (size_t)(l * 2 + f) * SZ_WGU);
                cvt_matrix(P.in[I_WGATE] + (size_t)(l * 2 + f) * 1024 * 2816, 1024, 2816, wgu, 1024, 0, 1, scr, gw, NGW, lane);
                cvt_matrix(P.in[I_WUP] + (size_t)(l * 2 + f) * 1024 * 2816, 1024, 2816, wgu, 1024, 0, 2, scr, gw, NGW, lane);
                cvt_matrix(P.in[I_WDOWN] + (size_t)(l * 2 + f) * 2816 * 1024, 2816, 1024, (bf16_t*)(ws + OFF_WD + (size_t)(l * 2 + f) * SZ_WD), 2816, 0, 0, scr, gw, NGW, lane);
            }
            cvt_matrix(P.in[I_WIN] + (size_t)l * 1024 * 4096, 1024, 4096, (bf16_t*)(ws + OFF_WIN + (size_t)l * SZ_WIN), 1024, 0, 3, scr, gw, NGW, lane);
            bf16_t* wgl = (bf16_t*)(ws + OFF_WGL + (size_t)l * SZ_WGL);
            cvt_matrix(P.in[I_GLUV] + (size_t)l * 512 * 512, 512, 512, wgl, 512, 0, 1, scr, gw, NGW, lane);
            cvt_matrix(P.in[I_GLUG] + (size_t)l * 512 * 512, 512, 512, wgl, 512, 0, 2, scr, gw, NGW, lane);
            bf16_t* wout = (bf16_t*)(ws + OFF_WOUT + (size_t)l * SZ_WOUT);
            cvt_matrix(P.in[I_OSSM] + (size_t)l * 512 * 1024, 512, 1024, wout, 1024, 0, 0, scr, gw, NGW, lane);
            cvt_matrix(P.in[I_OATT] + (size_t)l * 512 * 1024, 512, 1024, wout, 1024, 512, 0, scr, gw, NGW, lane);
            cvt_matrix(P.in[I_WO] + (size_t)l * 1024 * 1024, 1024, 1024, (bf16_t*)(ws + OFF_WO + (size_t)l * SZ_WO), 1024, 0, 0, scr, gw, NGW, lane);
        }
        }
        ew_phase(P, P.in[I_X], false, 0.f, nullptr, P.in[I_GAINS], wave);
        __syncthreads();
    }
    grid.sync();

    for (int step = 0; step < 12; ++step) {
        const int l = step / 3, s = step % 3;
        unsigned char* ws = P.ws; asm volatile("" : "+s"(ws));
        pg8::Gemm gfin;
        if (s != 1) {
            const int f = s >> 1;
            pg8::Gemm g{(const char*)(ws + OFF_XN), (const char*)(ws + OFF_WGU + (size_t)(l * 2 + f) * SZ_WGU), 1024, 1024, (size_t)256 * 1024 * 2, 0, (size_t)256 * 1024 * 2, 0, 16, 0};
            pg8::Order S; S.init(256, 22, 1, 0, G, bx);
            EpiGated<0> E{(bf16_t*)(ws + OFF_H), 2816};
            _Pragma("unroll 1") for (int rep_ = 0; rep_ < REP_GEMM; ++rep_) pg8::gemm_phase(lds, g, S, E, wave);
            GSYNC();
            gfin = pg8::Gemm{(const char*)(ws + OFF_H), (const char*)(ws + OFF_WD + (size_t)(l * 2 + f) * SZ_WD), 2816, 2816, (size_t)256 * 2816 * 2, 0, (size_t)256 * 2816 * 2, 0, 44, 0};
        } else {
            {
                pg8::Gemm g{(const char*)(ws + OFF_XN), (const char*)(ws + OFF_WIN + (size_t)l * SZ_WIN), 1024, 1024, (size_t)256 * 1024 * 2, 0, (size_t)256 * 1024 * 2, 0, 16, 0};
                pg8::Order S; S.init(256, 16, 1, 0, G, bx);
                EpiWin E{(bf16_t*)(ws + OFF_U), (bf16_t*)(ws + OFF_Q), (bf16_t*)(ws + OFF_K), (bf16_t*)(ws + OFF_VT), (bf16_t*)(ws + OFF_M1), (bf16_t*)(ws + OFF_SB)};
                _Pragma("unroll 1") for (int rep_ = 0; rep_ < REP_GEMM; ++rep_) pg8::gemm_phase(lds, g, S, E, wave);
            }
            GSYNC();
            {
                pg8::Gemm g{(const char*)(ws + OFF_U) + 256, (const char*)(ws + OFF_W1), 1152, 1024, (size_t)256 * 1152 * 2, (size_t)1024 * 1152 * 2, 0, (size_t)256 * 1024 * 2, 16, 0};
                pg8::Order S; S.init(4, 1, 32, 1, G, bx);
                EpiS E{(float*)(ws + OFF_S)};
                _Pragma("unroll 1") for (int rep_ = 0; rep_ < REP_GEMM; ++rep_) pg8::gemm_phase(lds, g, S, E, wave);
                __syncthreads();
                _Pragma("unroll 1") for (int rep_ = 0; rep_ < REP_ATTN; ++rep_) attn_phase(P, l, lds, wave);
            }
            GSYNC();
            _Pragma("unroll 1") for (int rc_ = 0; rc_ < REP_CARRY; ++rc_) carry_phase(P, l, wave);
            GSYNC();
            {
                pg8::Gemm g{(const char*)(ws + OFF_U), (const char*)(ws + OFF_W2), 1152, 1152, (size_t)256 * 1152 * 2, (size_t)1024 * 1152 * 2, (size_t)256 * 1152 * 2, (size_t)1024 * 1152 * 2, 6, 4};
                pg8::Order S; S.init(4, 4, 32, 2, G, bx);
                EpiY E{(bf16_t*)(ws + OFF_Q)};
                _Pragma("unroll 1") for (int rep_ = 0; rep_ < REP_GEMM; ++rep_) pg8::gemm_phase(lds, g, S, E, wave);
            }
            GSYNC();
            {
                pg8::Gemm g{(const char*)(ws + OFF_Q), (const char*)(ws + OFF_WGL + (size_t)l * SZ_WGL), 512, 512, (size_t)256 * 512 * 2, 0, (size_t)256 * 512 * 2, 0, 8, 0};
                pg8::Order S; S.init(256, 4, 1, 0, G, bx);
                EpiGated<1> E{(bf16_t*)(ws + OFF_XN), 1024};
                _Pragma("unroll 1") for (int rep_ = 0; rep_ < REP_GEMM; ++rep_) pg8::gemm_phase(lds, g, S, E, wave);
            }
            GSYNC();
            {
                pg8::Gemm g{(const char*)(ws + OFF_XN), (const char*)(ws + OFF_WOUT + (size_t)l * SZ_WOUT), 1024, 1024, (size_t)256 * 1024 * 2, 0, (size_t)256 * 1024 * 2, 0, 16, 0};
                pg8::Order S; S.init(256, 4, 1, 0, G, bx);
                EpiMerge E{(const bf16_t*)(ws + OFF_M1), (const bf16_t*)(ws + OFF_SB), (bf16_t*)(ws + OFF_K), wave};
                _Pragma("unroll 1") for (int rep_ = 0; rep_ < REP_GEMM; ++rep_) pg8::gemm_phase(lds, g, S, E, wave);
            }
            GSYNC();
            gfin = pg8::Gemm{(const char*)(ws + OFF_K), (const char*)(ws + OFF_WO + (size_t)l * SZ_WO), 1024, 1024, (size_t)256 * 1024 * 2, 0, (size_t)256 * 1024 * 2, 0, 16, 0};
        }
        {
            pg8::Order S; S.init(256, 4, 1, 0, G, bx);
            EpiDown E{(bf16_t*)(ws + OFF_M1), (float*)(ws + OFF_SSP)};
            _Pragma("unroll 1") for (int rep_ = 0; rep_ < REP_GEMM; ++rep_) pg8::gemm_phase(lds, gfin, S, E, wave);
        }
        GSYNC();
        {
            const float* gains = P.in[I_GAINS];
            ew_phase(P, P.out, true, s == 1 ? 1.f : 0.5f, gains + (size_t)(2 * step + 1) * 1024, step == 11 ? nullptr : gains + (size_t)(2 * step + 2) * 1024, wave);
            _Pragma("unroll 1") for (int re_ = 0; re_ < REP_EW; ++re_) ew_phase(P, P.out, false, 0.f, nullptr, step == 11 ? nullptr : gains + (size_t)(2 * step + 2) * 1024, wave);
            if (s == 0) { _Pragma("unroll 1") for (int rb_ = 0; rb_ < REP_BUILD; ++rb_) build_w12(P, l, wave); }
        }
        if (step != 11) GSYNC();
    }
}

extern "C" void kernel_launch(void* const* d_in, const int* in_sizes, int n_in, void* d_out, int out_size, void* d_ws, size_t ws_size, hipStream_t stream) {
    static int grid = 0;
    if (grid == 0) {
        if (n_in != 20 || out_size != NTOK * DM || ws_size < WS_END) { fprintf(stderr, "kernel_launch: unexpected shapes: n_in %d out %d ws %zu (need %zu)\n", n_in, out_size, ws_size, (size_t)WS_END); grid = -1; return; }
        int dev = 0, cus = 0, per_cu = 0;
        hipGetDevice(&dev);
        hipDeviceGetAttribute(&cus, hipDeviceAttributeMultiprocessorCount, dev);
        if (hipFuncSetAttribute((const void*)mk_fwd, hipFuncAttributeMaxDynamicSharedMemorySize, LDS_BYTES) != hipSuccess) { fprintf(stderr, "kernel_launch: hipFuncSetAttribute failed\n"); grid = -1; return; }
        if (hipOccupancyMaxActiveBlocksPerMultiprocessor(&per_cu, (const void*)mk_fwd, NTHREADS, LDS_BYTES) != hipSuccess || per_cu < 1) { fprintf(stderr, "kernel_launch: occupancy query failed (%d)\n", per_cu); per_cu = 1; }
        (void)hipGetLastError();
        grid = cus * per_cu;
    }
    if (grid < 0) return;
    if (hipMemsetAsync((char*)d_ws + OFF_BAR, 0, BAR_BYTES, stream) != hipSuccess) { fprintf(stderr, "kernel_launch: memset failed\n"); return; }
    Params p{};
    for (int i = 0; i < 20; ++i) p.in[i] = (const float*)d_in[i];
    p.out = (float*)d_out; p.ws = (unsigned char*)d_ws;
    void* args[] = {&p};
    hipError_t e = hipLaunchCooperativeKernel((const void*)mk_fwd, dim3(grid), dim3(NTHREADS), args, LDS_BYTES, stream);
    if (e != hipSuccess) fprintf(stderr, "cooperative launch failed: %s (grid %d)\n", hipGetErrorString(e), grid);
}
```

```cpp
#include <hip/hip_runtime.h>
#include <hip/hip_cooperative_groups.h>
#include <cstdio>
#include <cstdint>
namespace cg = cooperative_groups;

#define LAS __attribute__((address_space(3)))
typedef unsigned short bf16_t;
typedef short bf16x8 __attribute__((ext_vector_type(8)));
typedef short s16x4 __attribute__((ext_vector_type(4)));
typedef float f32x4 __attribute__((ext_vector_type(4)));
typedef float f32x2 __attribute__((ext_vector_type(2)));
typedef float f32x16 __attribute__((ext_vector_type(16)));
typedef unsigned u32x4 __attribute__((ext_vector_type(4)));
typedef unsigned u32x2 __attribute__((ext_vector_type(2)));
typedef __bf16 bf2_t __attribute__((ext_vector_type(2)));
#define DI __device__ __forceinline__

constexpr int NTOK = 65536, DM = 1024, FF = 2816, NL = 4, NGRP = 32, SEQ = 4096;
constexpr float RMS_EPS = 1e-6f;
constexpr int NTHREADS = 512, NWAVES = 8;
constexpr int LDS_MAIN = 131072, LDS_BYTES = LDS_MAIN + 16;
#ifndef REP_GEMM
#define REP_GEMM 1
#endif
#ifndef REP_SYNC
#define REP_SYNC 1
#endif
#ifndef REP_EW
#define REP_EW 0
#endif
#ifndef REP_PRO
#define REP_PRO 1
#endif
#ifndef REP_CARRY
#define REP_CARRY 1
#endif
#ifndef REP_BUILD
#define REP_BUILD 1
#endif
#define GSYNC() do { _Pragma("unroll 1") for (int rs_ = 0; rs_ < REP_SYNC; ++rs_) xcd_barrier(xbar, wave); } while (0)
#ifndef REP_ATTN
#define REP_ATTN 1
#endif

constexpr size_t SZ_WGU = (size_t)5632 * 1024 * 2, SZ_WD = (size_t)1024 * 2816 * 2, SZ_WIN = (size_t)4096 * 1024 * 2;
constexpr size_t SZ_WGL = (size_t)1024 * 512 * 2, SZ_WOUT = (size_t)1024 * 1024 * 2, SZ_WO = (size_t)1024 * 1024 * 2;
constexpr size_t OFF_WGU = 0;
constexpr size_t OFF_WD = OFF_WGU + 8 * SZ_WGU;
constexpr size_t OFF_WIN = OFF_WD + 8 * SZ_WD;
constexpr size_t OFF_WGL = OFF_WIN + 4 * SZ_WIN;
constexpr size_t OFF_WOUT = OFF_WGL + 4 * SZ_WGL;
constexpr size_t OFF_WO = OFF_WOUT + 4 * SZ_WOUT;
constexpr size_t SZ_PW1 = (size_t)65 * 64 * 2 * 4;
constexpr size_t SZ_BB1 = (size_t)64 * 16 * 2 * 4;
constexpr size_t SZ_KE1 = (size_t)64 * 256 * 4;
constexpr size_t OFF_PW = OFF_WO + 4 * SZ_WO;
constexpr size_t OFF_BB = OFF_PW + 128 * SZ_PW1;
constexpr size_t OFF_KERN = OFF_BB + 128 * SZ_BB1;
constexpr size_t OFF_W1 = OFF_KERN + 128 * SZ_KE1;
constexpr size_t OFF_W2 = OFF_W1 + (size_t)32 * 256 * 1024 * 2;
constexpr size_t OFF_XN = OFF_W2 + (size_t)32 * 1024 * 1152 * 2;
constexpr size_t OFF_M1 = OFF_XN + (size_t)NTOK * 1024 * 2;
constexpr size_t OFF_SSP = OFF_M1 + (size_t)NTOK * 1024 * 2;
constexpr size_t OFF_RS = OFF_SSP + (size_t)64 * NTOK * 4;
constexpr size_t OFF_OV = OFF_RS + (size_t)NTOK * 4;
constexpr size_t OFF_H = OFF_OV;
constexpr size_t OFF_U = OFF_OV;
constexpr size_t OFF_Q = OFF_U + (size_t)32 * 1024 * 1152 * 2;
constexpr size_t OFF_K = OFF_Q + (size_t)NTOK * 512 * 2;
constexpr size_t OFF_VT = OFF_K + (size_t)NTOK * 512 * 2;
constexpr size_t OFF_SB = OFF_VT + (size_t)NTOK * 512 * 2;
constexpr size_t OFF_S = OFF_SB + (size_t)NTOK * 1024 * 2;
constexpr size_t OV_MIX = OFF_S + (size_t)32 * 1024 * 128 * 4 - OFF_OV;
constexpr size_t OV_FFN = (size_t)NTOK * 2816 * 2;
constexpr size_t OFF_BAR = OFF_OV + (OV_MIX > OV_FFN ? OV_MIX : OV_FFN);
constexpr size_t BAR_BYTES = 16384;
constexpr size_t WS_END = OFF_BAR + BAR_BYTES;

DI const char* uni_ptr(const char* p) { const unsigned long long v = (unsigned long long)p; const unsigned lo = __builtin_amdgcn_readfirstlane((unsigned)v), hi = __builtin_amdgcn_readfirstlane((unsigned)(v >> 32)); return (const char*)(((unsigned long long)hi << 32) | lo); }
DI int opaque_tid(int wave_s) { int t = wave_s * 64 + (int)__builtin_amdgcn_mbcnt_hi(~0u, __builtin_amdgcn_mbcnt_lo(~0u, 0u)); asm volatile("" : "+v"(t)); return t; }
DI unsigned pk2(float a, float b) { f32x2 v = {a, b}; bf2_t r = __builtin_convertvector(v, bf2_t); return __builtin_bit_cast(unsigned, r); }
DI float bflo(unsigned u) { return __uint_as_float(u << 16); }
DI float bfhi(unsigned u) { return __uint_as_float(u & 0xffff0000u); }
DI float shx(float v, int lane, int o) { return __int_as_float(__builtin_amdgcn_ds_bpermute((lane ^ o) << 2, __float_as_int(v))); }
DI float wave_sum(float v, int lane) {
#pragma unroll
    for (int o = 1; o < 64; o <<= 1) v += shx(v, lane, o);
    return v;
}
DI float fsigmoid(float x) { return __builtin_amdgcn_rcpf(1.f + __expf(-x)); }
DI float fsilu(float x) { return x * fsigmoid(x); }
DI float fgelu_tanh(float x) { return x * fsigmoid(1.5957691216f * (x + 0.044715f * x * x * x)); }
DI u32x4 pack8(const f32x4 a, const f32x4 b) { u32x4 w; w.x = pk2(a[0], a[1]); w.y = pk2(a[2], a[3]); w.z = pk2(b[0], b[1]); w.w = pk2(b[2], b[3]); return w; }
DI void unpack8(const u32x4 w, f32x4& a, f32x4& b) { a = (f32x4){bflo(w.x), bfhi(w.x), bflo(w.y), bfhi(w.y)}; b = (f32x4){bflo(w.z), bfhi(w.z), bflo(w.w), bfhi(w.w)}; }


#define XB_TMO      128
#define XB_XCNT(j)  (256  + 64 * (j))
#define XB_XSUB(j)  (1280 + 64 * (j))
#define XB_XGEN(j)  (2304 + 64 * (j))
#define XB_TOP      3328
#define XB_TOPGEN   3392
#define XCD_BAR_WORDS 3456
#define XB_SPIN_CAP (1u << 20)
DI unsigned xb_ld(unsigned* p)              { return __hip_atomic_load(p, __ATOMIC_RELAXED, __HIP_MEMORY_SCOPE_AGENT); }
DI unsigned xb_add(unsigned* p, unsigned v) { return __hip_atomic_fetch_add(p, v, __ATOMIC_RELAXED, __HIP_MEMORY_SCOPE_AGENT); }
DI unsigned xb_xcc_id() { return (unsigned)__builtin_amdgcn_s_getreg((3 << 11) | 20) & 0xFu; }
#define XB_SPIN(cond, bar) do { unsigned _sp = 0; while (cond) { __builtin_amdgcn_s_sleep(1); \
    if ((++_sp & 255u) == 0u) { if (xb_ld(&(bar)[XB_TMO])) break; if (_sp > XB_SPIN_CAP) { atomicAdd(&(bar)[XB_TMO], 1u); break; } } } } while (0)
struct XcdBarrier { unsigned* bar; unsigned x; volatile LAS unsigned* st; };
DI void xcd_barrier_complete(unsigned* bar, unsigned x, unsigned& nloc, unsigned& nx) {
    const unsigned G = gridDim.x;
    unsigned sum, cnt, mine, sp = 0u;
    for (;;) {
        sum = 0u; cnt = 0u; mine = 0u;
#pragma unroll
        for (unsigned j = 0; j < 16; ++j) { const unsigned c = xb_ld(&bar[XB_XCNT(j)]); sum += c; cnt += (c > 0u) ? 1u : 0u; mine = (j == x) ? c : mine; }
        if (sum == G) break;
        __builtin_amdgcn_s_sleep(1);
        if ((++sp & 255u) == 0u) { if (xb_ld(&bar[XB_TMO])) break; if (sp > XB_SPIN_CAP) { atomicAdd(&bar[XB_TMO], 1u); break; } }
    }
    nloc = mine > 0u ? mine : 1u; nx = cnt > 0u ? cnt : 1u;
}
DI void xcd_barrier(const XcdBarrier& b, int wave_s) {
    asm volatile("s_waitcnt vmcnt(0)" ::: "memory");
    __syncthreads();
    if (opaque_tid(wave_s) == 0) {
        unsigned* bar = b.bar;
        __builtin_amdgcn_s_waitcnt(0);
        unsigned nloc = b.st[0], nx = b.st[1];
        if (nloc == 0u) { xcd_barrier_complete(bar, b.x, nloc, nx); b.st[0] = nloc; b.st[1] = nx; }
        const unsigned old = xb_add(&bar[XB_XSUB(b.x)], 1u);
        const unsigned gen = old / nloc;
        if (old + 1u == (gen + 1u) * nloc) {
            __builtin_amdgcn_fence(__ATOMIC_RELEASE, "agent");
            asm volatile("s_waitcnt vmcnt(0)" ::: "memory");
            const unsigned og = xb_add(&bar[XB_TOP], 1u);
            const unsigned tg = og / nx;
            if (og + 1u == (tg + 1u) * nx) xb_add(&bar[XB_TOPGEN], 1u);
            else XB_SPIN(xb_ld(&bar[XB_TOPGEN]) == tg, bar);
            __builtin_amdgcn_fence(__ATOMIC_ACQUIRE, "agent");
            xb_add(&bar[XB_XGEN(b.x)], 1u);
            asm volatile("s_waitcnt vmcnt(0)" ::: "memory");
        } else {
            XB_SPIN(xb_ld(&bar[XB_XGEN(b.x)]) == gen, bar);
            __builtin_amdgcn_fence(__ATOMIC_ACQUIRE, "agent");
            asm volatile("s_waitcnt vmcnt(0)" ::: "memory");
        }
    }
    __syncthreads();
}

namespace pg8 {
constexpr int BM = 256, BK = 64, HALF = 128, HTB = HALF * BK * 2, STAGE_BYTES = 8 * HTB, NXCD = 8, WGM = 8;
DI int lds_byte(int r, int c) { const int st = (r >> 4) * 2 + (c >> 5), rr = r & 15, cc = c & 31, ob = rr * 64 + cc * 2; return st * 1024 + (ob ^ (((ob >> 9) & 1) << 5)); }
DI void stage_rc(int b, int& R, int& C) { const int st = b / 1024, sb = b % 1024, swz = sb ^ (((sb >> 9) & 1) << 5); R = (st >> 1) * 16 + swz / 64; C = (st & 1) * 32 + (swz % 64) / 2; }
DI int perm32(int rho) { const int n = rho >> 4, i = rho & 15; return 8 * (i >> 2) + 4 * n + (i & 3); }

struct Unit { int pm, pn, pb; };
struct Gemm { const char* A; const char* B; int lda, ldb; size_t a_pm, a_pb, b_pn, b_pb; int nt0, ntstep; };
struct Order {
    int nM, nN, nB, nwg, G, c, mode;
    DI void init(int nM_, int nN_, int nB_, int mode_, int G_, int c_) { nM = nM_; nN = nN_; nB = nB_; mode = mode_; nwg = nM * nN * nB; G = G_; c = c_; }
    DI bool next(int i, Unit& u) const {
        const long L = (long)i * G + c; if (L >= nwg) return false;
        if (mode == 0) {
            int wgid = (int)L; { const int q = nwg / NXCD, r = nwg % NXCD, xcd = wgid % NXCD, off = wgid / NXCD; wgid = (xcd < r ? xcd * (q + 1) : r * (q + 1) + (xcd - r) * q) + off; }
            const int nig = WGM * nN, gid = wgid / nig, fm = gid * WGM, gsz = (nM - fm) < WGM ? (nM - fm) : WGM;
            u.pm = fm + ((wgid % nig) % gsz); u.pn = (wgid % nig) / gsz; u.pb = 0;
        } else {
            const int per = nM * nN, l = (int)L; u.pb = l / per; const int rem = l % per; u.pm = rem / nN; int pn = rem % nN;
            if (mode == 2 && (i & 1)) pn = nN - 1 - pn;
            u.pn = pn;
        }
        u.pm = __builtin_amdgcn_readfirstlane(u.pm); u.pn = __builtin_amdgcn_readfirstlane(u.pn); u.pb = __builtin_amdgcn_readfirstlane(u.pb);
        return true;
    }
};

template <class Epi>
DI void gemm_phase(LAS unsigned char* lds, const Gemm g, const Order& S, const Epi& E, int wave_s) {
    const int tid = opaque_tid(wave_s);
    const int wid = __builtin_amdgcn_readfirstlane(tid >> 6), lane = tid & 63, wr = wid >> 2, wc = wid & 3, fr = lane & 15, fq = lane >> 4;
    unsigned voffA[2], voffB[2];
#pragma unroll
    for (int i = 0; i < 2; ++i) { int R, C; stage_rc(tid * 16 + i * 8192, R, C); const int Rb = (R & ~31) + perm32(R & 31);
        voffA[i] = (unsigned)(R * g.lda + C) * 2u; voffB[i] = (unsigned)(Rb * g.ldb + C) * 2u; }
    const size_t kstep = (size_t)(BK * 2);
    const size_t hstepA = (size_t)HALF * g.lda * 2, hstepB = (size_t)HALF * g.ldb * 2;
    const unsigned ldsw = (unsigned)wid * 1024u;
    const int aoff = lds_byte(wr * 64 + fr, fq * 8), boff = lds_byte(wc * 32 + fr, fq * 8);
#define PG8_SA(b, h) (((b) * 2 + (h)) * HTB)
#define PG8_SB(b, h) ((4 + (b) * 2 + (h)) * HTB)
#define PG8_STAGE(bufoff, gbase, voff) do { _Pragma("unroll") for (int _i = 0; _i < 2; ++_i) \
        __builtin_amdgcn_global_load_lds((const unsigned*)((const char*)(gbase) + (voff)[_i]), (LAS unsigned*)(lds + (bufoff) + ldsw + _i * 8192), 16, 0, 0); } while (0)
#define PG8_LDA(dst, b, h) do { _Pragma("unroll") for (int m = 0; m < 4; ++m) _Pragma("unroll") for (int k = 0; k < 2; ++k) dst[m][k] = *(const LAS bf16x8*)(lds + PG8_SA(b, h) + aoff + m * 2048 + k * 1024); } while (0)
#define PG8_LDB(dst, b, h) do { _Pragma("unroll") for (int n = 0; n < 2; ++n) _Pragma("unroll") for (int k = 0; k < 2; ++k) dst[n][k] = *(const LAS bf16x8*)(lds + PG8_SB(b, h) + boff + n * 2048 + k * 1024); } while (0)
#define PG8_MMA(ai, bj, At, Bt) do { __builtin_amdgcn_s_setprio(1); _Pragma("unroll") for (int m = 0; m < 4; ++m) _Pragma("unroll") for (int n = 0; n < 2; ++n) _Pragma("unroll") for (int k = 0; k < 2; ++k) \
        acc[ai][bj][m][n] = __builtin_amdgcn_mfma_f32_16x16x32_bf16(Bt[n][k], At[m][k], acc[ai][bj][m][n], 0, 0, 0); __builtin_amdgcn_s_setprio(0); } while (0)
#define PG8_WAIT_V(n) asm volatile("s_waitcnt vmcnt(" #n ")" ::: "memory")
#define PG8_WAIT_L(n) asm volatile("s_waitcnt lgkmcnt(" #n ")" ::: "memory")
#define PG8_BAR __builtin_amdgcn_s_barrier()
#define PG8_SCHED __builtin_amdgcn_sched_barrier(0)
    Unit cur, nxt; int ui = 0;
    if (!S.next(0, cur)) return;
    f32x4 acc[2][2][4][2];
#pragma unroll
    for (int a = 0; a < 2; ++a)
#pragma unroll
        for (int b = 0; b < 2; ++b)
#pragma unroll
            for (int m = 0; m < 4; ++m)
#pragma unroll
                for (int n = 0; n < 2; ++n) acc[a][b][m][n] = (f32x4){0.f, 0.f, 0.f, 0.f};
    bf16x8 At[4][2], B0[2][2], B1[2][2];
    const char* cA = uni_ptr(g.A + (size_t)cur.pb * g.a_pb + (size_t)cur.pm * g.a_pm);
    const char* cB = uni_ptr(g.B + (size_t)cur.pb * g.b_pb + (size_t)cur.pn * g.b_pn);
    PG8_STAGE(PG8_SB(0, 0), cB, voffB); PG8_STAGE(PG8_SB(0, 1), cB + hstepB, voffB); PG8_STAGE(PG8_SA(0, 0), cA, voffA); PG8_STAGE(PG8_SA(0, 1), cA + hstepA, voffA);
    if (wr == 1) PG8_BAR;
    PG8_WAIT_V(2); PG8_BAR;
    PG8_STAGE(PG8_SB(1, 0), cB + kstep, voffB); PG8_STAGE(PG8_SA(1, 0), cA + kstep, voffA); PG8_STAGE(PG8_SB(1, 1), cB + hstepB + kstep, voffB);
    PG8_WAIT_V(6); PG8_BAR;
    for (;;) {
        const bool has_next = S.next(ui + 1, nxt);
        const char* nA = uni_ptr(has_next ? g.A + (size_t)nxt.pb * g.a_pb + (size_t)nxt.pm * g.a_pm : cA);
        const char* nB = uni_ptr(has_next ? g.B + (size_t)nxt.pb * g.b_pb + (size_t)nxt.pn * g.b_pn : cB);
        const int nt = g.nt0 + g.ntstep * cur.pn;
        for (int t = 0; t < nt; t += 2) {
            const bool last = (t == nt - 2);
            if constexpr (Epi::HAS_MID) { if (t == Epi::TMID) E.mid(acc, cur, wr, wc, fr, fq); }
            const char* a1 = cA + (size_t)(t + 1) * kstep;
            const char* a2 = last ? nA : cA + (size_t)(t + 2) * kstep; const char* b2 = last ? nB : cB + (size_t)(t + 2) * kstep;
            const char* a3 = a2 + kstep; const char* b3 = b2 + kstep;
            PG8_LDB(B0, 0, 0); PG8_LDB(B1, 0, 1); PG8_SCHED; PG8_LDA(At, 0, 0); PG8_STAGE(PG8_SA(1, 1), a1 + hstepA, voffA);
            PG8_WAIT_V(8); PG8_WAIT_L(0); PG8_BAR; PG8_MMA(0, 0, At, B0); PG8_MMA(0, 1, At, B1); PG8_BAR; PG8_SCHED;
            PG8_LDA(At, 0, 1); PG8_STAGE(PG8_SB(0, 0), b2, voffB); PG8_STAGE(PG8_SB(0, 1), b2 + hstepB, voffB); PG8_STAGE(PG8_SA(0, 0), a2, voffA);
            PG8_WAIT_V(8); PG8_WAIT_L(0); PG8_BAR; PG8_MMA(1, 0, At, B0); PG8_MMA(1, 1, At, B1); PG8_BAR; PG8_SCHED;
            PG8_LDB(B0, 1, 0); PG8_LDB(B1, 1, 1); PG8_SCHED; PG8_LDA(At, 1, 0); PG8_STAGE(PG8_SA(0, 1), a2 + hstepA, voffA);
            PG8_WAIT_V(8); PG8_WAIT_L(0); PG8_BAR; PG8_MMA(0, 0, At, B0); PG8_MMA(0, 1, At, B1); PG8_BAR; PG8_SCHED;
            PG8_LDA(At, 1, 1); PG8_STAGE(PG8_SB(1, 0), b3, voffB); PG8_STAGE(PG8_SB(1, 1), b3 + hstepB, voffB); PG8_STAGE(PG8_SA(1, 0), a3, voffA);
            PG8_WAIT_V(8); PG8_WAIT_L(0); PG8_BAR; PG8_MMA(1, 0, At, B0); PG8_MMA(1, 1, At, B1); PG8_BAR; PG8_SCHED;
        }
        if (wr == 0) PG8_BAR;
        E(acc, cur, wr, wc, fr, fq);
        if (!has_next) break;
#pragma unroll
        for (int a = 0; a < 2; ++a)
#pragma unroll
            for (int b = 0; b < 2; ++b)
#pragma unroll
                for (int m = 0; m < 4; ++m)
#pragma unroll
                    for (int n = 0; n < 2; ++n) acc[a][b][m][n] = (f32x4){0.f, 0.f, 0.f, 0.f};
        cur = nxt; cA = nA; cB = nB; ++ui;
        if (wr == 1) PG8_BAR;
    }
    PG8_WAIT_V(0);
    PG8_BAR;
#undef PG8_SA
#undef PG8_SB
#undef PG8_STAGE
#undef PG8_LDA
#undef PG8_LDB
#undef PG8_MMA
#undef PG8_WAIT_V
#undef PG8_WAIT_L
#undef PG8_BAR
#undef PG8_SCHED
}
}
using pg8::Unit;
typedef f32x4 AccT[2][2][4][2];

template <int ACT> struct EpiGated {
    static constexpr bool HAS_MID = false; static constexpr int TMID = -1;
    bf16_t* O; int ldc; const float* rs;
    DI void mid(AccT&, const Unit&, int, int, int, int) const {}
    DI void operator()(const AccT& acc, const Unit& u, int wr, int wc, int fr, int fq) const {
        const int row0 = u.pm * 256 + wr * 64 + fr, col0 = u.pn * 128 + wc * 32 + 8 * fq;
#pragma unroll
        for (int ai = 0; ai < 2; ++ai)
#pragma unroll
            for (int m = 0; m < 4; ++m) {
                f32x4 o[2]; const float rv = rs ? rs[row0 + ai * 128 + m * 16] : 1.f;
#pragma unroll
                for (int n = 0; n < 2; ++n)
#pragma unroll
                    for (int e = 0; e < 4; ++e) { const float a = acc[ai][0][m][n][e] * rv, b = acc[ai][1][m][n][e] * rv; o[n][e] = ACT == 0 ? fsilu(a) * b : a * fsigmoid(b); }
                *(u32x4*)(O + (size_t)(row0 + ai * 128 + m * 16) * ldc + col0) = pack8(o[0], o[1]);
            }
    }
};
struct EpiDown {
    static constexpr bool HAS_MID = false; static constexpr int TMID = -1;
    bf16_t* O; float* ssp;
    DI void mid(AccT&, const Unit&, int, int, int, int) const {}
    DI void operator()(const AccT& acc, const Unit& u, int wr, int wc, int fr, int fq) const {
        const int row0 = u.pm * 256 + wr * 64 + fr, col0 = u.pn * 256 + wc * 32 + 8 * fq;
#pragma unroll
        for (int ai = 0; ai < 2; ++ai)
#pragma unroll
            for (int m = 0; m < 4; ++m) {
                const int row = row0 + ai * 128 + m * 16; float ss = 0.f;
#pragma unroll
                for (int bj = 0; bj < 2; ++bj) {
                    const f32x4 v0 = acc[ai][bj][m][0], v1 = acc[ai][bj][m][1];
                    ss += (v0[0] * v0[0] + v0[1] * v0[1]) + (v0[2] * v0[2] + v0[3] * v0[3]) + (v1[0] * v1[0] + v1[1] * v1[1]) + (v1[2] * v1[2] + v1[3] * v1[3]);
                    *(u32x4*)(O + (size_t)row * 1024 + col0 + bj * 128) = pack8(v0, v1);
                }
                ssp[(size_t)(u.pn * 16 + wc * 4 + fq) * NTOK + row] = ss;
            }
    }
};
struct EpiWin {
    static constexpr bool HAS_MID = false; static constexpr int TMID = -1;
    bf16_t *U, *Q, *K, *VT, *R, *SB; const float* rs;
    DI void mid(AccT&, const Unit&, int, int, int, int) const {}
    DI void operator()(AccT& acc, const Unit& u, int wr, int wc, int fr, int fq) const {
        const int row0 = u.pm * 256 + wr * 64 + fr, pn = u.pn;
#pragma unroll
        for (int ai = 0; ai < 2; ++ai)
#pragma unroll
            for (int m = 0; m < 4; ++m) { const float rv = rs[row0 + ai * 128 + m * 16];
#pragma unroll
                for (int bj = 0; bj < 2; ++bj) { acc[ai][bj][m][0] *= rv; acc[ai][bj][m][1] *= rv; } }
        if (pn < 2) {
#pragma unroll
            for (int ai = 0; ai < 2; ++ai)
#pragma unroll
                for (int m = 0; m < 4; ++m) { const int row = row0 + ai * 128 + m * 16, bc = row >> 6, j = row & 63;
#pragma unroll
                    for (int bj = 0; bj < 2; ++bj) { const int c = pn * 256 + bj * 128 + wc * 32 + 8 * fq, gi = c >> 4, h0 = c & 15;
                        *(u32x4*)(U + ((size_t)gi * 1024 + bc) * 1152 + 128 + j * 16 + h0) = pack8(acc[ai][bj][m][0], acc[ai][bj][m][1]); } }
        } else if (pn < 6) {
            bf16_t* O = pn < 4 ? Q : K; const int cb = (pn & 1) * 256 + wc * 32 + 8 * fq;
#pragma unroll
            for (int ai = 0; ai < 2; ++ai)
#pragma unroll
                for (int m = 0; m < 4; ++m) { const int row = row0 + ai * 128 + m * 16;
#pragma unroll
                    for (int bj = 0; bj < 2; ++bj) *(u32x4*)(O + (size_t)row * 512 + cb + bj * 128) = pack8(acc[ai][bj][m][0], acc[ai][bj][m][1]); }
        } else if (pn < 8) {
#pragma unroll
            for (int ai = 0; ai < 2; ++ai)
#pragma unroll
                for (int m = 0; m < 4; ++m) { const int row = row0 + ai * 128 + m * 16, b = row >> 12, s = row & 4095;
#pragma unroll
                    for (int bj = 0; bj < 2; ++bj) { const int c = (pn - 6) * 256 + bj * 128 + wc * 32 + 8 * fq, hd = c >> 6, d0 = c & 63;
                        bf16_t* o = VT + (((size_t)b * 8 + hd) * 64 + d0) * 4096 + s;
                        const u32x4 w = pack8(acc[ai][bj][m][0], acc[ai][bj][m][1]);
                        o[0 * 4096] = (bf16_t)(w.x & 0xffff); o[1 * 4096] = (bf16_t)(w.x >> 16); o[2 * 4096] = (bf16_t)(w.y & 0xffff); o[3 * 4096] = (bf16_t)(w.y >> 16);
                        o[4 * 4096] = (bf16_t)(w.z & 0xffff); o[5 * 4096] = (bf16_t)(w.z >> 16); o[6 * 4096] = (bf16_t)(w.w & 0xffff); o[7 * 4096] = (bf16_t)(w.w >> 16); } }
        } else {
            const int cb = (pn - 8) * 128 + wc * 32 + 8 * fq;
#pragma unroll
            for (int ai = 0; ai < 2; ++ai)
#pragma unroll
                for (int m = 0; m < 4; ++m) { const int row = row0 + ai * 128 + m * 16; f32x4 r[2], sb[2];
#pragma unroll
                    for (int n = 0; n < 2; ++n)
#pragma unroll
                        for (int e = 0; e < 4; ++e) { const float sa = fsigmoid(acc[ai][0][m][n][e]), sbv = fsigmoid(acc[ai][1][m][n][e]); sb[n][e] = sbv; r[n][e] = sa / sbv; }
                    *(u32x4*)(R + (size_t)row * 1024 + cb) = pack8(r[0], r[1]);
                    *(u32x4*)(SB + (size_t)row * 1024 + cb) = pack8(sb[0], sb[1]); }
        }
    }
};
struct EpiS {
    static constexpr bool HAS_MID = false; static constexpr int TMID = -1;
    float* S;
    DI void mid(AccT&, const Unit&, int, int, int, int) const {}
    DI void operator()(const AccT& acc, const Unit& u, int wr, int wc, int fr, int fq) const {
        const int row0 = u.pm * 256 + wr * 64 + fr, col0 = wc * 32 + 8 * fq;
#pragma unroll
        for (int ai = 0; ai < 2; ++ai)
#pragma unroll
            for (int m = 0; m < 4; ++m) { float* o = S + ((size_t)u.pb * 1024 + row0 + ai * 128 + m * 16) * 128 + col0;
                *(f32x4*)o = acc[ai][0][m][0]; *(f32x4*)(o + 4) = acc[ai][0][m][1]; }
    }
};
struct EpiY {
    static constexpr bool HAS_MID = false; static constexpr int TMID = -1;
    bf16_t* YA;
    DI void mid(AccT&, const Unit&, int, int, int, int) const {}
    DI void operator()(const AccT& acc, const Unit& u, int wr, int wc, int fr, int fq) const {
        const int row0 = u.pm * 256 + wr * 64 + fr;
#pragma unroll
        for (int ai = 0; ai < 2; ++ai)
#pragma unroll
            for (int m = 0; m < 4; ++m) { const int row = row0 + ai * 128 + m * 16;
#pragma unroll
                for (int bj = 0; bj < 2; ++bj) { const int c = u.pn * 256 + bj * 128 + wc * 32 + 8 * fq, t = c >> 4, h0 = c & 15; f32x4 o[2];
#pragma unroll
                    for (int n = 0; n < 2; ++n)
#pragma unroll
                        for (int e = 0; e < 4; ++e) o[n][e] = fgelu_tanh(acc[ai][bj][m][n][e]);
                    *(u32x4*)(YA + ((size_t)row * 64 + t) * 512 + u.pb * 16 + h0) = pack8(o[0], o[1]); } }
    }
};
struct EpiMerge {
    static constexpr bool HAS_MID = true; static constexpr int TMID = 8;
    const bf16_t *R, *SB; bf16_t* O; int wave_s;
    DI void scale(AccT& acc, const Unit& u, int, int, int, int, const bf16_t* P) const {
        const int t_ = opaque_tid(wave_s), wid = __builtin_amdgcn_readfirstlane(t_ >> 6), ln = t_ & 63, wr = wid >> 2, wc = wid & 3, fr = ln & 15, fq = ln >> 4;
        const int row0 = u.pm * 256 + wr * 64 + fr, col0 = u.pn * 256 + wc * 32 + 8 * fq;
#pragma unroll
        for (int ai = 0; ai < 2; ++ai)
#pragma unroll
            for (int m = 0; m < 4; ++m)
#pragma unroll
                for (int bj = 0; bj < 2; ++bj) { const u32x4 w = *(const u32x4*)(P + (size_t)(row0 + ai * 128 + m * 16) * 1024 + col0 + bj * 128); f32x4 a, b; unpack8(w, a, b);
                    acc[ai][bj][m][0] *= a; acc[ai][bj][m][1] *= b; }
    }
    DI void mid(AccT& acc, const Unit& u, int wr, int wc, int fr, int fq) const { scale(acc, u, wr, wc, fr, fq, R); }
    DI void operator()(AccT& acc, const Unit& u, int wr, int wc, int fr, int fq) const {
        scale(acc, u, wr, wc, fr, fq, SB);
        const int row0 = u.pm * 256 + wr * 64 + fr, col0 = u.pn * 256 + wc * 32 + 8 * fq;
#pragma unroll
        for (int ai = 0; ai < 2; ++ai)
#pragma unroll
            for (int m = 0; m < 4; ++m)
#pragma unroll
                for (int bj = 0; bj < 2; ++bj) *(u32x4*)(O + (size_t)(row0 + ai * 128 + m * 16) * 1024 + col0 + bj * 128) = pack8(acc[ai][bj][m][0], acc[ai][bj][m][1]);
    }
};

struct Params { const float* in[20]; float* out; unsigned char* ws; };
enum { I_X = 0, I_GAINS, I_WGATE, I_WUP, I_WDOWN, I_WIN, I_LRE, I_LIM, I_LOGDT, I_BRE, I_BIM, I_CRE, I_CIM, I_DSKIP, I_GLUV, I_GLUG, I_OSSM, I_RELB, I_OATT, I_WO };

DI int map_row(int map, int n) {
    if (map == 0) return n;
    if (map == 1) return 256 * (n >> 7) + (n & 127);
    if (map == 2) return 256 * (n >> 7) + 128 + (n & 127);
    if (n < 2048) return n;
    if (n < 3072) { const int j = n - 2048; return 2048 + 256 * (j >> 7) + (j & 127); }
    const int j = n - 3072; return 2048 + 256 * (j >> 7) + 128 + (j & 127);
}
DI void cvt_item(const float* W, int K, int N, bf16_t* WT, int ldk, int koff, int map, LAS float* scr, int item, int lane, const float* gk = nullptr) {
    const int nblk = N / 32, kb = item / nblk, nb = item % nblk, k0 = 64 * kb, n0 = 32 * nb;
    const float sc = (map == 3 && n0 >= 512 && n0 < 1024) ? 0.125f : 1.f;
#pragma unroll
    for (int i = 0; i < 32; ++i) { const int kk = 2 * i + (lane >> 5); scr[kk * 33 + (lane & 31)] = W[(size_t)(k0 + kk) * N + n0 + (lane & 31)] * (gk ? sc * gk[k0 + kk] : sc); }
    asm volatile("s_waitcnt lgkmcnt(0)" ::: "memory");
    const int c = lane & 7;
#pragma unroll
    for (int j = 0; j < 4; ++j) { const int n = (lane >> 3) + 8 * j; const LAS float* s = scr + (8 * c) * 33 + n;
        u32x4 o; o.x = pk2(s[0 * 33], s[1 * 33]); o.y = pk2(s[2 * 33], s[3 * 33]); o.z = pk2(s[4 * 33], s[5 * 33]); o.w = pk2(s[6 * 33], s[7 * 33]);
        *(u32x4*)(WT + (size_t)map_row(map, n0 + n) * ldk + koff + k0 + 8 * c) = o; }
    asm volatile("s_waitcnt lgkmcnt(0)" ::: "memory");
}
DI void cvt_matrix(const float* W, int K, int N, bf16_t* WT, int ldk, int koff, int map, LAS float* scr, int gw, int NGW, int lane) {
    const int nitems = (K / 64) * (N / 32);
    for (int it = gw; it < nitems; it += NGW) cvt_item(W, K, N, WT, ldk, koff, map, scr, it, lane);
}

DI void s5_tables(const Params& P, LAS unsigned char* lds, int lg) {
    LAS float* pw = (LAS float*)lds;
    LAS float* bb = pw + 65 * 64 * 2;
    LAS float* cc = bb + 64 * 16 * 2;
    LAS float* ff = cc + 16 * 64 * 2;
    const int tid = threadIdx.x;
    unsigned char* ws = P.ws;
    float* gPW = (float*)(ws + OFF_PW + (size_t)lg * SZ_PW1);
    float* gBB = (float*)(ws + OFF_BB + (size_t)lg * SZ_BB1);
    float* gKE = (float*)(ws + OFF_KERN + (size_t)lg * SZ_KE1);
    const double dt = exp((double)P.in[I_LOGDT][lg]);
    const float* lre = P.in[I_LRE] + (size_t)lg * 64; const float* lim = P.in[I_LIM] + (size_t)lg * 64;
    for (int idx = tid; idx < 65 * 64; idx += NTHREADS) {
        const int tau = idx >> 6, p = idx & 63;
        const double lr = lre[p], li = lim[p];
        const float mag = __expf((float)(lr * dt * tau));
        double rev = li * dt * tau * 0.15915494309189535; rev -= rint(rev);
        const float cs = __builtin_amdgcn_cosf((float)rev), sn = __builtin_amdgcn_sinf((float)rev);
        const float re = mag * cs, im = mag * sn;
        pw[idx * 2] = re; pw[idx * 2 + 1] = im; gPW[idx * 2] = re; gPW[idx * 2 + 1] = im;
        if (tau == 1) {
            const double nr = (double)re - 1.0, ni = im, den = lr * lr + li * li;
            ff[p * 2] = (float)((nr * lr + ni * li) / den); ff[p * 2 + 1] = (float)((ni * lr - nr * li) / den);
        }
    }
    __syncthreads();
    const float* bre = P.in[I_BRE] + (size_t)lg * 1024; const float* bim = P.in[I_BIM] + (size_t)lg * 1024;
    const float* cre = P.in[I_CRE] + (size_t)lg * 1024; const float* cim = P.in[I_CIM] + (size_t)lg * 1024;
    for (int idx = tid; idx < 1024; idx += NTHREADS) {
        const int p = idx >> 4;
        const float fr_ = ff[p * 2], fi_ = ff[p * 2 + 1], br = bre[idx], bi = bim[idx];
        const float re = fr_ * br - fi_ * bi, im = fr_ * bi + fi_ * br;
        bb[idx * 2] = re; bb[idx * 2 + 1] = im; gBB[idx * 2] = re; gBB[idx * 2 + 1] = im;
        cc[idx * 2] = cre[idx]; cc[idx * 2 + 1] = cim[idx];
    }
    __syncthreads();
    const float* dsk = P.in[I_DSKIP] + (size_t)lg * 16;
    for (int pair = tid; pair < 1024; pair += NTHREADS) {
        const int tau = pair >> 4, h = pair & 15;
        float a[16];
#pragma unroll
        for (int j = 0; j < 16; ++j) a[j] = 0.f;
        for (int p = 0; p < 64; ++p) {
            const float cr = cc[(h * 64 + p) * 2], ci = cc[(h * 64 + p) * 2 + 1], pr = pw[(tau * 64 + p) * 2], pi = pw[(tau * 64 + p) * 2 + 1];
            const float xr = cr * pr - ci * pi, xi = cr * pi + ci * pr;
#pragma unroll
            for (int j = 0; j < 16; ++j) a[j] += xr * bb[(p * 16 + j) * 2] - xi * bb[(p * 16 + j) * 2 + 1];
        }
        const float dv = dsk[h];
#pragma unroll
        for (int j = 0; j < 16; ++j) gKE[(size_t)pair * 16 + j] = a[j] + ((tau == 0 && j == h) ? dv : 0.f);
    }
    __syncthreads();
}

DI void build_w12(const Params& P, int l, int wave_s) {
    unsigned char* ws = P.ws;
    const float* gPW = (const float*)(ws + OFF_PW) + (size_t)l * 32 * (65 * 64 * 2);
    const float* gBB = (const float*)(ws + OFF_BB) + (size_t)l * 32 * (64 * 16 * 2);
    const float* gKE = (const float*)(ws + OFF_KERN) + (size_t)l * 32 * (64 * 256);
    bf16_t* W1 = (bf16_t*)(ws + OFF_W1); bf16_t* W2 = (bf16_t*)(ws + OFF_W2);
    const int gt = blockIdx.x * NTHREADS + opaque_tid(wave_s), NT = gridDim.x * NTHREADS;
    for (int it = gt; it < 32 * 256 * 128; it += NT) {
        const int kk = it & 127, n = (it >> 7) & 255, g = it >> 15;
        float v[8];
        if (n >= 128) {
#pragma unroll
            for (int e = 0; e < 8; ++e) v[e] = 0.f;
        } else {
            const int p = n & 63, im = n >> 6, j = kk >> 1, h0 = (kk & 1) * 8;
            const float* pwp = gPW + ((size_t)g * 65 + (63 - j)) * 128 + p * 2; const float pr = pwp[0], pi = pwp[1];
            const float* bp = gBB + ((size_t)g * 64 + p) * 32 + h0 * 2;
#pragma unroll
            for (int e = 0; e < 8; ++e) { const float br = bp[e * 2], bi = bp[e * 2 + 1]; v[e] = im ? (pr * bi + pi * br) : (pr * br - pi * bi); }
        }
        u32x4 o; o.x = pk2(v[0], v[1]); o.y = pk2(v[2], v[3]); o.z = pk2(v[4], v[5]); o.w = pk2(v[6], v[7]);
        *(u32x4*)(W1 + (size_t)it * 8) = o;
    }
    const float* cre = P.in[I_CRE] + (size_t)l * 32 * 1024; const float* cim = P.in[I_CIM] + (size_t)l * 32 * 1024;
    for (int it = gt; it < 32 * 1024 * 144; it += NT) {
        const int kk = it % 144, n = (it / 144) & 1023, g = it / (144 * 1024), t = n >> 4, h = n & 15;
        float v[8];
        if (kk < 16) {
            const int im = kk >> 3, p0 = (kk & 7) * 8;
            const float* pwp = gPW + ((size_t)g * 65 + (t + 1)) * 128 + p0 * 2;
            const float* crp = cre + ((size_t)g * 16 + h) * 64 + p0; const float* cip = cim + ((size_t)g * 16 + h) * 64 + p0;
#pragma unroll
            for (int e = 0; e < 8; ++e) { const float cr = crp[e], ci = cip[e], pr = pwp[e * 2], pi = pwp[e * 2 + 1]; v[e] = im ? -(cr * pi + ci * pr) : (cr * pr - ci * pi); }
        } else {
            const int j = (kk - 16) >> 1, h0 = ((kk - 16) & 1) * 8;
            if (j <= t) { const float* kp = gKE + (((size_t)g * 64 + (t - j)) * 16 + h) * 16 + h0;
#pragma unroll
                for (int e = 0; e < 8; ++e) v[e] = kp[e];
            } else {
#pragma unroll
                for (int e = 0; e < 8; ++e) v[e] = 0.f;
            }
        }
        u32x4 o; o.x = pk2(v[0], v[1]); o.y = pk2(v[2], v[3]); o.z = pk2(v[4], v[5]); o.w = pk2(v[6], v[7]);
        *(u32x4*)(W2 + (size_t)it * 8) = o;
    }
}

DI void ew_phase(const Params& P, bool first, bool last, float coef, const float* gpost, int wave_s) {
    const int tid_ = opaque_tid(wave_s), lane = tid_ & 63, wave = __builtin_amdgcn_readfirstlane(tid_ >> 6);
    unsigned char* ws = P.ws;
    const bf16_t* M1 = (const bf16_t*)(ws + OFF_M1); const float* ssp = (const float*)(ws + OFF_SSP); bf16_t* XB = (bf16_t*)(ws + OFF_XN); float* RS = (float*)(ws + OFF_RS);
    const float* xin = P.in[I_X];
    const int gw = blockIdx.x * NWAVES + wave, NGW = gridDim.x * NWAVES;
    const int rpw = (NTOK / 4 + NGW - 1) / NGW * 4;
    const int rbeg = gw * rpw, rend = (rbeg + rpw) < NTOK ? (rbeg + rpw) : NTOK;
    for (int r0 = rbeg; r0 < rend; r0 += 4) {
        f32x4 ssv = {0.f, 0.f, 0.f, 0.f};
        if (!first) ssv = *(const f32x4*)(ssp + (size_t)lane * NTOK + r0);
#pragma unroll
        for (int q = 0; q < 4; ++q) {
            const int row = r0 + q;
            f32x4 v[4];
            if (first) {
#pragma unroll
                for (int j = 0; j < 4; ++j) v[j] = *(const f32x4*)(xin + (size_t)row * 1024 + j * 256 + lane * 4);
            } else {
                const float rstd = __builtin_amdgcn_rsqf(wave_sum(ssv[q], lane) * (1.f / 1024.f) + RMS_EPS) * coef;
#pragma unroll
                for (int j = 0; j < 4; ++j) {
                    const u32x2 xw = *(const u32x2*)(XB + (size_t)row * 1024 + j * 256 + lane * 4);
                    const u32x2 w = *(const u32x2*)(M1 + (size_t)row * 1024 + j * 256 + lane * 4);
                    const f32x4 gp = *(const f32x4*)(gpost + j * 256 + lane * 4);
                    const f32x4 xv = {bflo(xw.x), bfhi(xw.x), bflo(xw.y), bfhi(xw.y)};
                    const f32x4 mv = {bflo(w.x), bfhi(w.x), bflo(w.y), bfhi(w.y)};
                    v[j] = xv + gp * mv * rstd;
                }
            }
            if (last) {
#pragma unroll
                for (int j = 0; j < 4; ++j) *(f32x4*)(P.out + (size_t)row * 1024 + j * 256 + lane * 4) = v[j];
            } else {
                float ss = 0.f;
#pragma unroll
                for (int j = 0; j < 4; ++j) ss += (v[j][0] * v[j][0] + v[j][1] * v[j][1]) + (v[j][2] * v[j][2] + v[j][3] * v[j][3]);
                const float rstd2 = __builtin_amdgcn_rsqf(wave_sum(ss, lane) * (1.f / 1024.f) + RMS_EPS);
                if (lane == 0) RS[row] = rstd2;
#pragma unroll
                for (int j = 0; j < 4; ++j) { u32x2 w; w.x = pk2(v[j][0], v[j][1]); w.y = pk2(v[j][2], v[j][3]);
                    *(u32x2*)(XB + (size_t)row * 1024 + j * 256 + lane * 4) = w; }
            }
        }
    }
}

DI void carry_phase(const Params& P, int l, int wave_s) {
    const int tid_ = opaque_tid(wave_s), lane = tid_ & 63, wave = __builtin_amdgcn_readfirstlane(tid_ >> 6);
    unsigned char* ws = P.ws;
    const float* gPW = (const float*)(ws + OFF_PW) + (size_t)l * 32 * (65 * 64 * 2);
    const float* S = (const float*)(ws + OFF_S); bf16_t* U = (bf16_t*)(ws + OFF_U);
    const int gw = blockIdx.x * NWAVES + wave, NGW = gridDim.x * NWAVES;
    for (int task = gw; task < 512; task += NGW) {
        const int g = task >> 4, b = task & 15, p = lane;
        const float ar = gPW[((size_t)g * 65 + 64) * 128 + p * 2], ai = gPW[((size_t)g * 65 + 64) * 128 + p * 2 + 1];
        float xr = 0.f, xi = 0.f;
        const float* sp = S + ((size_t)g * 1024 + b * 64) * 128; bf16_t* up = U + ((size_t)g * 1024 + b * 64) * 1152;
#pragma unroll 8
        for (int c = 0; c < 64; ++c) {
            up[(size_t)c * 1152 + p] = (bf16_t)(pk2(xr, 0.f) & 0xffff); up[(size_t)c * 1152 + 64 + p] = (bf16_t)(pk2(xi, 0.f) & 0xffff);
            const float sr = sp[c * 128 + p], si = sp[c * 128 + 64 + p];
            const float nr = ar * xr - ai * xi + sr, ni = ar * xi + ai * xr + si;
            xr = nr; xi = ni;
        }
    }
}

DI int crow(int reg, int h) { return (reg & 3) + 8 * (reg >> 2) + 4 * h; }
#define MFMA32(a, b, c) __builtin_amdgcn_mfma_f32_32x32x16_bf16((a), (b), (c), 0, 0, 0)
DI bf16x8 pack_step(const f32x16& x, int s) {
    u32x4 p; p.x = pk2(x[8 * s], x[8 * s + 1]); p.y = pk2(x[8 * s + 2], x[8 * s + 3]); p.z = pk2(x[8 * s + 4], x[8 * s + 5]); p.w = pk2(x[8 * s + 6], x[8 * s + 7]);
    return __builtin_bit_cast(bf16x8, p);
}
#define ATTN_STEP(KT, BUF, KREG, VREG) \
            { LAS unsigned char* kb = kbuf + BUF * 9216; LAS unsigned char* vb = vbuf + BUF * 8704; \
            *(LAS u32x4*)(kb + lr * 144 + lsg * 16) = KREG; \
            { u32x2 a; a.x = VREG.x; a.y = VREG.y; u32x2 c; c.x = VREG.z; c.y = VREG.w; \
              *(LAS u32x2*)(vb + lr * 136 + lsg * 16) = a; *(LAS u32x2*)(vb + lr * 136 + lsg * 16 + 8) = c; } \
            __syncthreads(); \
            if (KT + 2 <= kthi) { KREG = *(const u32x4*)(kgp + (size_t)(KT + 2) * 64 * 512); VREG = *(const u32x4*)(vgp + (KT + 2) * 64); } \
            if (KT + 8 >= cc && KT <= cc) { \
                f32x16 s0, s1; \
_Pragma("unroll") \
                for (int i = 0; i < 16; ++i) { s0[i] = 0.f; s1[i] = 0.f; } \
_Pragma("unroll") \
                for (int ks = 0; ks < 4; ++ks) { \
                    const bf16x8 k0 = *(const LAS bf16x8*)(kb + n * 144 + ks * 32 + gq * 16), k1 = *(const LAS bf16x8*)(kb + (32 + n) * 144 + ks * 32 + gq * 16); \
                    s0 = MFMA32(k0, Qf[ks], s0); s1 = MFMA32(k1, Qf[ks], s1); \
                } \
                const int delta = cc - (KT); \
                if (delta >= 3) { const float cb = bth[256]; \
_Pragma("unroll") \
                    for (int i = 0; i < 16; ++i) { s0[i] += cb; s1[i] += cb; } \
                } else { const int base = 64 * delta + qh * 32 + n + 128; \
_Pragma("unroll") \
                    for (int i = 0; i < 16; ++i) { const int key = crow(i, gq); int i0 = base - key, i1 = base - key - 32; \
                        i0 = i0 > 256 ? 256 : i0; i1 = i1 > 256 ? 256 : i1; i0 = i0 < 0 ? 0 : i0; i1 = i1 < 0 ? 0 : i1; \
                        s0[i] += bth[i0]; s1[i] += bth[i1]; } \
                } \
                float mx = s0[0]; \
_Pragma("unroll") \
                for (int i = 1; i < 16; ++i) mx = fmaxf(mx, s0[i]); \
_Pragma("unroll") \
                for (int i = 0; i < 16; ++i) mx = fmaxf(mx, s1[i]); \
                mx = fmaxf(mx, shx(mx, lane, 32)); \
                const float mnew = fmaxf(mrun, mx), alpha = __expf(mrun - mnew); mrun = mnew; \
                float ps = 0.f; \
_Pragma("unroll") \
                for (int i = 0; i < 16; ++i) { s0[i] = __expf(s0[i] - mnew); s1[i] = __expf(s1[i] - mnew); ps += s0[i] + s1[i]; } \
                lrun = lrun * alpha + ps; \
_Pragma("unroll") \
                for (int i = 0; i < 16; ++i) { O0[i] *= alpha; O1[i] *= alpha; } \
_Pragma("unroll") \
                for (int kg = 0; kg < 2; ++kg) \
_Pragma("unroll") \
                    for (int s = 0; s < 2; ++s) { \
                        const bf16x8 Pf = pack_step(kg == 0 ? s0 : s1, s); \
                        const LAS unsigned char* v0 = vb + n * 136 + 64 * kg + 32 * s + 8 * gq; \
                        const s16x4 lo0 = *(const LAS s16x4*)(v0), hi0 = *(const LAS s16x4*)(v0 + 16); \
                        const s16x4 lo1 = *(const LAS s16x4*)(v0 + 32 * 136), hi1 = *(const LAS s16x4*)(v0 + 32 * 136 + 16); \
                        const bf16x8 V0 = __builtin_shufflevector(lo0, hi0, 0, 1, 2, 3, 4, 5, 6, 7), V1 = __builtin_shufflevector(lo1, hi1, 0, 1, 2, 3, 4, 5, 6, 7); \
                        O0 = MFMA32(V0, Pf, O0); O1 = MFMA32(V1, Pf, O1); \
                    } \
            } }
DI void attn_phase(const Params& P, int l, LAS unsigned char* lds, int wave_s) {
    const int tid_ = opaque_tid(wave_s), lane = tid_ & 63, wave = __builtin_amdgcn_readfirstlane(tid_ >> 6);
    unsigned char* ws = P.ws;
    const bf16_t* Q = (const bf16_t*)(ws + OFF_Q); const bf16_t* K = (const bf16_t*)(ws + OFF_K); const bf16_t* VT = (const bf16_t*)(ws + OFF_VT);
    bf16_t* ZA = (bf16_t*)P.out;
    LAS float* bt = (LAS float*)lds;
    LAS unsigned char* kbuf = lds + 8448;
    LAS unsigned char* vbuf = kbuf + 2 * 9216;
    const float* relb = P.in[I_RELB] + (size_t)l * 8 * 257;
    for (int i = tid_; i < 8 * 257; i += NTHREADS) bt[i] = relb[i];
    __syncthreads();
    const int n = lane & 31, gq = lane >> 5;
    const int ci = wave >> 1, qh = wave & 1;
    const int lr = tid_ >> 3, lsg = tid_ & 7;
    for (int it = blockIdx.x; it < 2048; it += gridDim.x) {
        const int y = it >> 4, cg4 = ((it & 15) + (it >> 8)) & 15, hd = y & 7, b = y >> 3;
        const int c0 = cg4 * 4, cc = c0 + ci;
        const int ktlo = c0 > 8 ? c0 - 8 : 0, kthi = c0 + 3;
        const size_t tok0 = (size_t)b * SEQ + cc * 64 + qh * 32;
        bf16x8 Qf[4];
        { const bf16_t* qp = Q + (tok0 + n) * 512 + hd * 64 + gq * 8;
#pragma unroll
          for (int ks = 0; ks < 4; ++ks) Qf[ks] = *(const bf16x8*)(qp + ks * 16); }
        f32x16 O0, O1;
#pragma unroll
        for (int i = 0; i < 16; ++i) { O0[i] = 0.f; O1[i] = 0.f; }
        float mrun = -1e30f, lrun = 0.f;
        const LAS float* bth = bt + hd * 257;
        const bf16_t* kgp = K + ((size_t)b * SEQ + lr) * 512 + hd * 64 + lsg * 8;
        const bf16_t* vgp = VT + (((size_t)b * 8 + hd) * 64 + lr) * SEQ + lsg * 8;
        u32x4 kregA = *(const u32x4*)(kgp + (size_t)ktlo * 64 * 512), vregA = *(const u32x4*)(vgp + ktlo * 64);
        u32x4 kregB = *(const u32x4*)(kgp + (size_t)(ktlo + 1) * 64 * 512), vregB = *(const u32x4*)(vgp + (ktlo + 1) * 64);
        for (int kt = ktlo; kt <= kthi; kt += 2) {
            ATTN_STEP(kt, 0, kregA, vregA)
            ATTN_STEP(kt + 1, 1, kregB, vregB)
        }
        lrun += shx(lrun, lane, 32);
        const float inv = 1.f / lrun;
        bf16_t* op = ZA + (tok0 + n) * 1024 + 512 + hd * 64 + gq * 4;
#pragma unroll
        for (int g4 = 0; g4 < 4; ++g4) {
            u32x2 w0, w1;
            w0.x = pk2(O0[4 * g4] * inv, O0[4 * g4 + 1] * inv); w0.y = pk2(O0[4 * g4 + 2] * inv, O0[4 * g4 + 3] * inv);
            w1.x = pk2(O1[4 * g4] * inv, O1[4 * g4 + 1] * inv); w1.y = pk2(O1[4 * g4 + 2] * inv, O1[4 * g4 + 3] * inv);
            *(u32x2*)(op + 8 * g4) = w0; *(u32x2*)(op + 32 + 8 * g4) = w1;
        }
        __syncthreads();
    }
}

__global__ void __launch_bounds__(NTHREADS, 2) mk_fwd(Params P) {
    extern __shared__ __attribute__((aligned(16))) unsigned char lds_raw[];
    LAS unsigned char* lds = (LAS unsigned char*)lds_raw;
    cg::grid_group grid = cg::this_grid();
    const int tid = threadIdx.x, lane = tid & 63, wave = __builtin_amdgcn_readfirstlane(tid >> 6);
    const int G = gridDim.x, bx = blockIdx.x;
    unsigned char* ws = P.ws;
    const int gw = bx * NWAVES + wave, NGW = G * NWAVES;
    volatile LAS unsigned* xst = (volatile LAS unsigned*)(lds + LDS_MAIN);
    if (tid == 0) { xst[0] = 0u; xst[1] = 0u; }
    __syncthreads();
    XcdBarrier xbar; xbar.bar = (unsigned*)(ws + OFF_BAR); xbar.x = xb_xcc_id(); xbar.st = xst;
    if (tid == 0) (void)xb_add(&xbar.bar[XB_XCNT(xbar.x)], 1u);

    {
        _Pragma("unroll 1") for (int rp_ = 0; rp_ < REP_PRO; ++rp_) {
        for (int lg = bx; lg < 128; lg += G) s5_tables(P, lds, lg);
        __syncthreads();
        LAS float* scr = (LAS float*)(lds + wave * 8704);
        for (int it = gw; it < 4 * 11776; it += NGW) {
            const int l = it / 11776; int r = it - l * 11776;
            if (r < 6 * 1408) {
                const int which = r / 1408, f = which & 1, kind = which >> 1; r -= which * 1408;
                bf16_t* wgu = (bf16_t*)(ws + OFF_WGU + (size_t)(l * 2 + f) * SZ_WGU);
                const float* gk = P.in[I_GAINS] + (size_t)(l * 6 + 4 * f) * 1024;
                if (kind == 0) cvt_item(P.in[I_WGATE] + (size_t)(l * 2 + f) * 1024 * 2816, 1024, 2816, wgu, 1024, 0, 1, scr, r, lane, gk);
                else if (kind == 1) cvt_item(P.in[I_WUP] + (size_t)(l * 2 + f) * 1024 * 2816, 1024, 2816, wgu, 1024, 0, 2, scr, r, lane, gk);
                else cvt_item(P.in[I_WDOWN] + (size_t)(l * 2 + f) * 2816 * 1024, 2816, 1024, (bf16_t*)(ws + OFF_WD + (size_t)(l * 2 + f) * SZ_WD), 2816, 0, 0, scr, r, lane);
                continue;
            }
            r -= 6 * 1408;
            if (r < 2048) { cvt_item(P.in[I_WIN] + (size_t)l * 1024 * 4096, 1024, 4096, (bf16_t*)(ws + OFF_WIN + (size_t)l * SZ_WIN), 1024, 0, 3, scr, r, lane, P.in[I_GAINS] + (size_t)(l * 6 + 2) * 1024); continue; }
            r -= 2048;
            if (r < 256) { const int gsel = r >> 7; r &= 127;
                cvt_item(P.in[gsel ? I_GLUG : I_GLUV] + (size_t)l * 512 * 512, 512, 512, (bf16_t*)(ws + OFF_WGL + (size_t)l * SZ_WGL), 512, 0, 1 + gsel, scr, r, lane); continue; }
            r -= 256;
            if (r < 512) { const int osel = r >> 8; r &= 255;
                cvt_item(P.in[osel ? I_OATT : I_OSSM] + (size_t)l * 512 * 1024, 512, 1024, (bf16_t*)(ws + OFF_WOUT + (size_t)l * SZ_WOUT), 1024, osel * 512, 0, scr, r, lane); continue; }
            r -= 512;
            cvt_item(P.in[I_WO] + (size_t)l * 1024 * 1024, 1024, 1024, (bf16_t*)(ws + OFF_WO + (size_t)l * SZ_WO), 1024, 0, 0, scr, r, lane);
        }
        __syncthreads();
        }
        ew_phase(P, true, false, 0.f, nullptr, wave);
        __syncthreads();
    }
    grid.sync();

    for (int step = 0; step < 12; ++step) {
        const int l = step / 3, s = step % 3;
        unsigned char* ws = P.ws; asm volatile("" : "+s"(ws));
        pg8::Gemm gfin;
        if (s != 1) {
            const int f = s >> 1;
            pg8::Gemm g{(const char*)(ws + OFF_XN), (const char*)(ws + OFF_WGU + (size_t)(l * 2 + f) * SZ_WGU), 1024, 1024, (size_t)256 * 1024 * 2, 0, (size_t)256 * 1024 * 2, 0, 16, 0};
            pg8::Order S; S.init(256, 22, 1, 0, G, bx);
            EpiGated<0> E{(bf16_t*)(ws + OFF_H), 2816, (const float*)(ws + OFF_RS)};
            _Pragma("unroll 1") for (int rep_ = 0; rep_ < REP_GEMM; ++rep_) pg8::gemm_phase(lds, g, S, E, wave);
            GSYNC();
            gfin = pg8::Gemm{(const char*)(ws + OFF_H), (const char*)(ws + OFF_WD + (size_t)(l * 2 + f) * SZ_WD), 2816, 2816, (size_t)256 * 2816 * 2, 0, (size_t)256 * 2816 * 2, 0, 44, 0};
        } else {
            {
                pg8::Gemm g{(const char*)(ws + OFF_XN), (const char*)(ws + OFF_WIN + (size_t)l * SZ_WIN), 1024, 1024, (size_t)256 * 1024 * 2, 0, (size_t)256 * 1024 * 2, 0, 16, 0};
                pg8::Order S; S.init(256, 16, 1, 0, G, bx);
                EpiWin E{(bf16_t*)(ws + OFF_U), (bf16_t*)(ws + OFF_Q), (bf16_t*)(ws + OFF_K), (bf16_t*)(ws + OFF_VT), (bf16_t*)(ws + OFF_M1), (bf16_t*)(ws + OFF_SB), (const float*)(ws + OFF_RS)};
                _Pragma("unroll 1") for (int rep_ = 0; rep_ < REP_GEMM; ++rep_) pg8::gemm_phase(lds, g, S, E, wave);
            }
            GSYNC();
            {
                pg8::Gemm g{(const char*)(ws + OFF_U) + 256, (const char*)(ws + OFF_W1), 1152, 1024, (size_t)256 * 1152 * 2, (size_t)1024 * 1152 * 2, 0, (size_t)256 * 1024 * 2, 16, 0};
                pg8::Order S; S.init(4, 1, 32, 1, G, bx);
                EpiS E{(float*)(ws + OFF_S)};
                _Pragma("unroll 1") for (int rep_ = 0; rep_ < REP_GEMM; ++rep_) pg8::gemm_phase(lds, g, S, E, wave);
                __syncthreads();
                _Pragma("unroll 1") for (int rep_ = 0; rep_ < REP_ATTN; ++rep_) attn_phase(P, l, lds, wave);
            }
            GSYNC();
            _Pragma("unroll 1") for (int rc_ = 0; rc_ < REP_CARRY; ++rc_) carry_phase(P, l, wave);
            GSYNC();
            {
                pg8::Gemm g{(const char*)(ws + OFF_U), (const char*)(ws + OFF_W2), 1152, 1152, (size_t)256 * 1152 * 2, (size_t)1024 * 1152 * 2, (size_t)256 * 1152 * 2, (size_t)1024 * 1152 * 2, 6, 4};
                pg8::Order S; S.init(4, 4, 32, 2, G, bx);
                EpiY E{(bf16_t*)(ws + OFF_Q)};
                _Pragma("unroll 1") for (int rep_ = 0; rep_ < REP_GEMM; ++rep_) pg8::gemm_phase(lds, g, S, E, wave);
            }
            GSYNC();
            {
                pg8::Gemm g{(const char*)(ws + OFF_Q), (const char*)(ws + OFF_WGL + (size_t)l * SZ_WGL), 512, 512, (size_t)256 * 512 * 2, 0, (size_t)256 * 512 * 2, 0, 8, 0};
                pg8::Order S; S.init(256, 4, 1, 0, G, bx);
                EpiGated<1> E{(bf16_t*)P.out, 1024, nullptr};
                _Pragma("unroll 1") for (int rep_ = 0; rep_ < REP_GEMM; ++rep_) pg8::gemm_phase(lds, g, S, E, wave);
            }
            GSYNC();
            {
                pg8::Gemm g{(const char*)P.out, (const char*)(ws + OFF_WOUT + (size_t)l * SZ_WOUT), 1024, 1024, (size_t)256 * 1024 * 2, 0, (size_t)256 * 1024 * 2, 0, 16, 0};
                pg8::Order S; S.init(256, 4, 1, 0, G, bx);
                EpiMerge E{(const bf16_t*)(ws + OFF_M1), (const bf16_t*)(ws + OFF_SB), (bf16_t*)(ws + OFF_K), wave};
                _Pragma("unroll 1") for (int rep_ = 0; rep_ < REP_GEMM; ++rep_) pg8::gemm_phase(lds, g, S, E, wave);
            }
            GSYNC();
            gfin = pg8::Gemm{(const char*)(ws + OFF_K), (const char*)(ws + OFF_WO + (size_t)l * SZ_WO), 1024, 1024, (size_t)256 * 1024 * 2, 0, (size_t)256 * 1024 * 2, 0, 16, 0};
        }
        {
            pg8::Order S; S.init(256, 4, 1, 0, G, bx);
            EpiDown E{(bf16_t*)(ws + OFF_M1), (float*)(ws + OFF_SSP)};
            _Pragma("unroll 1") for (int rep_ = 0; rep_ < REP_GEMM; ++rep_) pg8::gemm_phase(lds, gfin, S, E, wave);
        }
        GSYNC();
        {
            const float* gains = P.in[I_GAINS];
            ew_phase(P, false, step == 11, s == 1 ? 1.f : 0.5f, gains + (size_t)(2 * step + 1) * 1024, wave);
            if (s == 0) { _Pragma("unroll 1") for (int rb_ = 0; rb_ < REP_BUILD; ++rb_) build_w12(P, l, wave); }
        }
        if (step != 11) GSYNC();
    }
}

extern "C" void kernel_launch(void* const* d_in, const int* in_sizes, int n_in, void* d_out, int out_size, void* d_ws, size_t ws_size, hipStream_t stream) {
    static int grid = 0;
    if (grid == 0) {
        if (n_in != 20 || out_size != NTOK * DM || ws_size < WS_END) { fprintf(stderr, "kernel_launch: unexpected shapes: n_in %d out %d ws %zu (need %zu)\n", n_in, out_size, ws_size, (size_t)WS_END); grid = -1; return; }
        int dev = 0, cus = 0, per_cu = 0;
        hipGetDevice(&dev);
        hipDeviceGetAttribute(&cus, hipDeviceAttributeMultiprocessorCount, dev);
        if (hipFuncSetAttribute((const void*)mk_fwd, hipFuncAttributeMaxDynamicSharedMemorySize, LDS_BYTES) != hipSuccess) { fprintf(stderr, "kernel_launch: hipFuncSetAttribute failed\n"); grid = -1; return; }
        if (hipOccupancyMaxActiveBlocksPerMultiprocessor(&per_cu, (const void*)mk_fwd, NTHREADS, LDS_BYTES) != hipSuccess || per_cu < 1) { fprintf(stderr, "kernel_launch: occupancy query failed (%d)\n", per_cu); per_cu = 1; }
        (void)hipGetLastError();
        grid = cus * per_cu;
    }
    if (grid < 0) return;
    if (hipMemsetAsync((char*)d_ws + OFF_BAR, 0, BAR_BYTES, stream) != hipSuccess) { fprintf(stderr, "kernel_launch: memset failed\n"); return; }
    Params p{};
    for (int i = 0; i < 20; ++i) p.in[i] = (const float*)d_in[i];
    p.out = (float*)d_out; p.ws = (unsigned char*)d_ws;
    void* args[] = {&p};
    hipError_t e = hipLaunchCooperativeKernel((const void*)mk_fwd, dim3(grid), dim3(NTHREADS), args, LDS_BYTES, stream);
    if (e != hipSuccess) fprintf(stderr, "cooperative launch failed: %s (grid %d)\n", hipGetErrorString(e), grid);
}
```

```cpp
#include <hip/hip_runtime.h>
#include <hip/hip_cooperative_groups.h>
#include <cstdio>
#include <cstdint>
namespace cg = cooperative_groups;

#define LAS __attribute__((address_space(3)))
typedef unsigned short bf16_t;
typedef short bf16x8 __attribute__((ext_vector_type(8)));
typedef short s16x4 __attribute__((ext_vector_type(4)));
typedef float f32x4 __attribute__((ext_vector_type(4)));
typedef float f32x2 __attribute__((ext_vector_type(2)));
typedef float f32x16 __attribute__((ext_vector_type(16)));
typedef unsigned u32x4 __attribute__((ext_vector_type(4)));
typedef unsigned u32x2 __attribute__((ext_vector_type(2)));
typedef __bf16 bf2_t __attribute__((ext_vector_type(2)));
#define DI __device__ __forceinline__

constexpr int NTOK = 65536, DM = 1024, FF = 2816, NL = 4, NGRP = 32, SEQ = 4096;
constexpr float RMS_EPS = 1e-6f;
constexpr int NTHREADS = 512, NWAVES = 8;
constexpr int LDS_MAIN = 131072, LDS_BYTES = LDS_MAIN + 16;
#ifndef REP_GEMM
#define REP_GEMM 1
#endif
#ifndef REP_SYNC
#define REP_SYNC 1
#endif
#ifndef REP_EW
#define REP_EW 0
#endif
#ifndef REP_PRO
#define REP_PRO 1
#endif
#ifndef REP_CARRY
#define REP_CARRY 1
#endif
#ifndef REP_BUILD
#define REP_BUILD 1
#endif
#define GSYNC() do { _Pragma("unroll 1") for (int rs_ = 0; rs_ < REP_SYNC; ++rs_) xcd_barrier(xbar, wave); } while (0)
#ifndef REP_ATTN
#define REP_ATTN 1
#endif

constexpr size_t SZ_WGU = (size_t)5632 * 1024 * 2, SZ_WD = (size_t)1024 * 2816 * 2, SZ_WIN = (size_t)4096 * 1024 * 2;
constexpr size_t SZ_WGL = (size_t)1024 * 512 * 2, SZ_WOUT = (size_t)1024 * 1024 * 2, SZ_WO = (size_t)1024 * 1024 * 2;
constexpr size_t OFF_WGU = 0;
constexpr size_t OFF_WD = OFF_WGU + 8 * SZ_WGU;
constexpr size_t OFF_WIN = OFF_WD + 8 * SZ_WD;
constexpr size_t OFF_WGL = OFF_WIN + 4 * SZ_WIN;
constexpr size_t OFF_WOUT = OFF_WGL + 4 * SZ_WGL;
constexpr size_t OFF_WO = OFF_WOUT + 4 * SZ_WOUT;
constexpr size_t SZ_PW1 = (size_t)65 * 64 * 2 * 4;
constexpr size_t SZ_BB1 = (size_t)64 * 16 * 2 * 4;
constexpr size_t SZ_KE1 = (size_t)64 * 256 * 4;
constexpr size_t OFF_PW = OFF_WO + 4 * SZ_WO;
constexpr size_t OFF_BB = OFF_PW + 128 * SZ_PW1;
constexpr size_t OFF_KERN = OFF_BB + 128 * SZ_BB1;
constexpr size_t OFF_W1 = OFF_KERN + 128 * SZ_KE1;
constexpr size_t OFF_W2 = OFF_W1 + (size_t)32 * 256 * 1024 * 2;
constexpr size_t OFF_XN = OFF_W2 + (size_t)32 * 1024 * 1152 * 2;
constexpr size_t OFF_M1 = OFF_XN + (size_t)NTOK * 1024 * 2;
constexpr size_t OFF_SSP = OFF_M1 + (size_t)NTOK * 1024 * 2;
constexpr size_t OFF_RS = OFF_SSP + (size_t)64 * NTOK * 4;
constexpr size_t OFF_OV = OFF_RS + (size_t)NTOK * 4;
constexpr size_t OFF_H = OFF_OV;
constexpr size_t OFF_U = OFF_OV;
constexpr size_t OFF_Q = OFF_U + (size_t)32 * 1024 * 1152 * 2;
constexpr size_t OFF_K = OFF_Q + (size_t)NTOK * 512 * 2;
constexpr size_t OFF_VT = OFF_K + (size_t)NTOK * 512 * 2;
constexpr size_t OFF_SB = OFF_VT + (size_t)NTOK * 512 * 2;
constexpr size_t OFF_S = OFF_SB + (size_t)NTOK * 1024 * 2;
constexpr size_t OV_MIX = OFF_S + (size_t)32 * 1024 * 128 * 4 - OFF_OV;
constexpr size_t OV_FFN = (size_t)NTOK * 2816 * 2;
constexpr size_t OFF_BAR = OFF_OV + (OV_MIX > OV_FFN ? OV_MIX : OV_FFN);
constexpr size_t BAR_BYTES = 16384;
constexpr size_t WS_END = OFF_BAR + BAR_BYTES;

DI const char* uni_ptr(const char* p) { const unsigned long long v = (unsigned long long)p; const unsigned lo = __builtin_amdgcn_readfirstlane((unsigned)v), hi = __builtin_amdgcn_readfirstlane((unsigned)(v >> 32)); return (const char*)(((unsigned long long)hi << 32) | lo); }
DI int opaque_tid(int wave_s) { int t = wave_s * 64 + (int)__builtin_amdgcn_mbcnt_hi(~0u, __builtin_amdgcn_mbcnt_lo(~0u, 0u)); asm volatile("" : "+v"(t)); return t; }
DI unsigned pk2(float a, float b) { f32x2 v = {a, b}; bf2_t r = __builtin_convertvector(v, bf2_t); return __builtin_bit_cast(unsigned, r); }
DI float bflo(unsigned u) { return __uint_as_float(u << 16); }
DI float bfhi(unsigned u) { return __uint_as_float(u & 0xffff0000u); }
DI float shx(float v, int lane, int o) { return __int_as_float(__builtin_amdgcn_ds_bpermute((lane ^ o) << 2, __float_as_int(v))); }
DI float wave_sum(float v, int lane) {
#pragma unroll
    for (int o = 1; o < 64; o <<= 1) v += shx(v, lane, o);
    return v;
}
DI float fsigmoid(float x) { return __builtin_amdgcn_rcpf(1.f + __expf(-x)); }
DI float fsilu(float x) { return x * fsigmoid(x); }
DI float fgelu_tanh(float x) { return x * fsigmoid(1.5957691216f * (x + 0.044715f * x * x * x)); }
DI u32x4 pack8(const f32x4 a, const f32x4 b) { u32x4 w; w.x = pk2(a[0], a[1]); w.y = pk2(a[2], a[3]); w.z = pk2(b[0], b[1]); w.w = pk2(b[2], b[3]); return w; }
DI void unpack8(const u32x4 w, f32x4& a, f32x4& b) { a = (f32x4){bflo(w.x), bfhi(w.x), bflo(w.y), bfhi(w.y)}; b = (f32x4){bflo(w.z), bfhi(w.z), bflo(w.w), bfhi(w.w)}; }


#define XB_TMO      128
#define XB_XCNT(j)  (256  + 64 * (j))
#define XB_XSUB(j)  (1280 + 64 * (j))
#define XB_XGEN(j)  (2304 + 64 * (j))
#define XB_TOP      3328
#define XB_TOPGEN   3392
#define XCD_BAR_WORDS 3456
#define XB_SPIN_CAP (1u << 20)
DI unsigned xb_ld(unsigned* p)              { return __hip_atomic_load(p, __ATOMIC_RELAXED, __HIP_MEMORY_SCOPE_AGENT); }
DI unsigned xb_add(unsigned* p, unsigned v) { return __hip_atomic_fetch_add(p, v, __ATOMIC_RELAXED, __HIP_MEMORY_SCOPE_AGENT); }
DI unsigned xb_xcc_id() { return (unsigned)__builtin_amdgcn_s_getreg((3 << 11) | 20) & 0xFu; }
#define XB_SPIN(cond, bar) do { unsigned _sp = 0; while (cond) { __builtin_amdgcn_s_sleep(1); \
    if ((++_sp & 255u) == 0u) { if (xb_ld(&(bar)[XB_TMO])) break; if (_sp > XB_SPIN_CAP) { atomicAdd(&(bar)[XB_TMO], 1u); break; } } } } while (0)
struct XcdBarrier { unsigned* bar; unsigned x; volatile LAS unsigned* st; };
DI void xcd_barrier_complete(unsigned* bar, unsigned x, unsigned& nloc, unsigned& nx) {
    const unsigned G = gridDim.x;
    unsigned sum, cnt, mine, sp = 0u;
    for (;;) {
        sum = 0u; cnt = 0u; mine = 0u;
#pragma unroll
        for (unsigned j = 0; j < 16; ++j) { const unsigned c = xb_ld(&bar[XB_XCNT(j)]); sum += c; cnt += (c > 0u) ? 1u : 0u; mine = (j == x) ? c : mine; }
        if (sum == G) break;
        __builtin_amdgcn_s_sleep(1);
        if ((++sp & 255u) == 0u) { if (xb_ld(&bar[XB_TMO])) break; if (sp > XB_SPIN_CAP) { atomicAdd(&bar[XB_TMO], 1u); break; } }
    }
    nloc = mine > 0u ? mine : 1u; nx = cnt > 0u ? cnt : 1u;
}
DI void xcd_barrier(const XcdBarrier& b, int wave_s) {
    asm volatile("s_waitcnt vmcnt(0)" ::: "memory");
    __syncthreads();
    if (opaque_tid(wave_s) == 0) {
        unsigned* bar = b.bar;
        __builtin_amdgcn_s_waitcnt(0);
        unsigned nloc = b.st[0], nx = b.st[1];
        if (nloc == 0u) { xcd_barrier_complete(bar, b.x, nloc, nx); b.st[0] = nloc; b.st[1] = nx; }
        const unsigned old = xb_add(&bar[XB_XSUB(b.x)], 1u);
        const unsigned gen = old / nloc;
        if (old + 1u == (gen + 1u) * nloc) {
            __builtin_amdgcn_fence(__ATOMIC_RELEASE, "agent");
            asm volatile("s_waitcnt vmcnt(0)" ::: "memory");
            const unsigned og = xb_add(&bar[XB_TOP], 1u);
            const unsigned tg = og / nx;
            if (og + 1u == (tg + 1u) * nx) xb_add(&bar[XB_TOPGEN], 1u);
            else XB_SPIN(xb_ld(&bar[XB_TOPGEN]) == tg, bar);
            __builtin_amdgcn_fence(__ATOMIC_ACQUIRE, "agent");
            xb_add(&bar[XB_XGEN(b.x)], 1u);
            asm volatile("s_waitcnt vmcnt(0)" ::: "memory");
        } else {
            XB_SPIN(xb_ld(&bar[XB_XGEN(b.x)]) == gen, bar);
            __builtin_amdgcn_fence(__ATOMIC_ACQUIRE, "agent");
            asm volatile("s_waitcnt vmcnt(0)" ::: "memory");
        }
    }
    __syncthreads();
}

namespace pg8 {
constexpr int BM = 256, BK = 64, HALF = 128, HTB = HALF * BK * 2, STAGE_BYTES = 8 * HTB, NXCD = 8, WGM = 8;
DI int lds_byte(int r, int c) { const int st = (r >> 4) * 2 + (c >> 5), rr = r & 15, cc = c & 31, ob = rr * 64 + cc * 2; return st * 1024 + (ob ^ (((ob >> 9) & 1) << 5)); }
DI void stage_rc(int b, int& R, int& C) { const int st = b / 1024, sb = b % 1024, swz = sb ^ (((sb >> 9) & 1) << 5); R = (st >> 1) * 16 + swz / 64; C = (st & 1) * 32 + (swz % 64) / 2; }
DI int perm32(int rho) { const int n = rho >> 4, i = rho & 15; return 8 * (i >> 2) + 4 * n + (i & 3); }

struct Unit { int pm, pn, pb; };
struct Gemm { const char* A; const char* B; int lda, ldb; size_t a_pm, a_pb, b_pn, b_pb; int nt0, ntstep; };
struct Order {
    int nM, nN, nB, nwg, G, c, mode;
    DI void init(int nM_, int nN_, int nB_, int mode_, int G_, int c_) { nM = nM_; nN = nN_; nB = nB_; mode = mode_; nwg = nM * nN * nB; G = G_; c = c_; }
    DI bool next(int i, Unit& u) const {
        const long L = (long)i * G + c; if (L >= nwg) return false;
        if (mode == 0) {
            int wgid = (int)L; { const int q = nwg / NXCD, r = nwg % NXCD, xcd = wgid % NXCD, off = wgid / NXCD; wgid = (xcd < r ? xcd * (q + 1) : r * (q + 1) + (xcd - r) * q) + off; }
            const int nig = WGM * nN, gid = wgid / nig, fm = gid * WGM, gsz = (nM - fm) < WGM ? (nM - fm) : WGM;
            u.pm = fm + ((wgid % nig) % gsz); u.pn = (wgid % nig) / gsz; u.pb = 0;
        } else {
            const int per = nM * nN, l = (int)L; u.pb = l / per; const int rem = l % per; u.pm = rem / nN; int pn = rem % nN;
            if (mode == 2 && (i & 1)) pn = nN - 1 - pn;
            u.pn = pn;
        }
        u.pm = __builtin_amdgcn_readfirstlane(u.pm); u.pn = __builtin_amdgcn_readfirstlane(u.pn); u.pb = __builtin_amdgcn_readfirstlane(u.pb);
        return true;
    }
};

template <class Epi>
DI void gemm_phase(LAS unsigned char* lds, const Gemm g, const Order& S, const Epi& E, int wave_s) {
    const int tid = opaque_tid(wave_s);
    const int wid = __builtin_amdgcn_readfirstlane(tid >> 6), lane = tid & 63, wr = wid >> 2, wc = wid & 3, fr = lane & 15, fq = lane >> 4;
    unsigned voffA[2], voffB[2];
#pragma unroll
    for (int i = 0; i < 2; ++i) { int R, C; stage_rc(tid * 16 + i * 8192, R, C); const int Rb = (R & ~31) + perm32(R & 31);
        voffA[i] = (unsigned)(R * g.lda + C) * 2u; voffB[i] = (unsigned)(Rb * g.ldb + C) * 2u; }
    const size_t kstep = (size_t)(BK * 2);
    const size_t hstepA = (size_t)HALF * g.lda * 2, hstepB = (size_t)HALF * g.ldb * 2;
    const unsigned ldsw = (unsigned)wid * 1024u;
    const int aoff = lds_byte(wr * 64 + fr, fq * 8), boff = lds_byte(wc * 32 + fr, fq * 8);
#define PG8_SA(b, h) (((b) * 2 + (h)) * HTB)
#define PG8_SB(b, h) ((4 + (b) * 2 + (h)) * HTB)
#define PG8_STAGE(bufoff, gbase, voff) do { _Pragma("unroll") for (int _i = 0; _i < 2; ++_i) \
        __builtin_amdgcn_global_load_lds((const unsigned*)((const char*)(gbase) + (voff)[_i]), (LAS unsigned*)(lds + (bufoff) + ldsw + _i * 8192), 16, 0, 0); } while (0)
#define PG8_LDA(dst, b, h) do { _Pragma("unroll") for (int m = 0; m < 4; ++m) _Pragma("unroll") for (int k = 0; k < 2; ++k) dst[m][k] = *(const LAS bf16x8*)(lds + PG8_SA(b, h) + aoff + m * 2048 + k * 1024); } while (0)
#define PG8_LDB(dst, b, h) do { _Pragma("unroll") for (int n = 0; n < 2; ++n) _Pragma("unroll") for (int k = 0; k < 2; ++k) dst[n][k] = *(const LAS bf16x8*)(lds + PG8_SB(b, h) + boff + n * 2048 + k * 1024); } while (0)
#define PG8_MMA(ai, bj, At, Bt) do { __builtin_amdgcn_s_setprio(1); _Pragma("unroll") for (int m = 0; m < 4; ++m) _Pragma("unroll") for (int n = 0; n < 2; ++n) _Pragma("unroll") for (int k = 0; k < 2; ++k) \
        acc[ai][bj][m][n] = __builtin_amdgcn_mfma_f32_16x16x32_bf16(Bt[n][k], At[m][k], acc[ai][bj][m][n], 0, 0, 0); __builtin_amdgcn_s_setprio(0); } while (0)
#define PG8_WAIT_V(n) asm volatile("s_waitcnt vmcnt(" #n ")" ::: "memory")
#define PG8_WAIT_L(n) asm volatile("s_waitcnt lgkmcnt(" #n ")" ::: "memory")
#define PG8_BAR __builtin_amdgcn_s_barrier()
#define PG8_SCHED __builtin_amdgcn_sched_barrier(0)
    Unit cur, nxt; int ui = 0;
    if (!S.next(0, cur)) return;
    f32x4 acc[2][2][4][2];
#pragma unroll
    for (int a = 0; a < 2; ++a)
#pragma unroll
        for (int b = 0; b < 2; ++b)
#pragma unroll
            for (int m = 0; m < 4; ++m)
#pragma unroll
                for (int n = 0; n < 2; ++n) acc[a][b][m][n] = (f32x4){0.f, 0.f, 0.f, 0.f};
    bf16x8 At[4][2], B0[2][2], B1[2][2];
    const char* cA = uni_ptr(g.A + (size_t)cur.pb * g.a_pb + (size_t)cur.pm * g.a_pm);
    const char* cB = uni_ptr(g.B + (size_t)cur.pb * g.b_pb + (size_t)cur.pn * g.b_pn);
    PG8_STAGE(PG8_SB(0, 0), cB, voffB); PG8_STAGE(PG8_SB(0, 1), cB + hstepB, voffB); PG8_STAGE(PG8_SA(0, 0), cA, voffA); PG8_STAGE(PG8_SA(0, 1), cA + hstepA, voffA);
    if (wr == 1) PG8_BAR;
    PG8_WAIT_V(2); PG8_BAR;
    PG8_STAGE(PG8_SB(1, 0), cB + kstep, voffB); PG8_STAGE(PG8_SA(1, 0), cA + kstep, voffA); PG8_STAGE(PG8_SB(1, 1), cB + hstepB + kstep, voffB);
    PG8_WAIT_V(6); PG8_BAR;
    for (;;) {
        const bool has_next = S.next(ui + 1, nxt);
        const char* nA = uni_ptr(has_next ? g.A + (size_t)nxt.pb * g.a_pb + (size_t)nxt.pm * g.a_pm : cA);
        const char* nB = uni_ptr(has_next ? g.B + (size_t)nxt.pb * g.b_pb + (size_t)nxt.pn * g.b_pn : cB);
        const int nt = g.nt0 + g.ntstep * cur.pn;
        for (int t = 0; t < nt; t += 2) {
            const bool last = (t == nt - 2);
            if constexpr (Epi::HAS_MID) { if (t == Epi::TMID) E.mid(acc, cur, wr, wc, fr, fq); }
            const char* a1 = cA + (size_t)(t + 1) * kstep;
            const char* a2 = last ? nA : cA + (size_t)(t + 2) * kstep; const char* b2 = last ? nB : cB + (size_t)(t + 2) * kstep;
            const char* a3 = a2 + kstep; const char* b3 = b2 + kstep;
            PG8_LDB(B0, 0, 0); PG8_LDB(B1, 0, 1); PG8_SCHED; PG8_LDA(At, 0, 0); PG8_STAGE(PG8_SA(1, 1), a1 + hstepA, voffA);
            PG8_WAIT_V(8); PG8_WAIT_L(0); PG8_BAR; PG8_MMA(0, 0, At, B0); PG8_MMA(0, 1, At, B1); PG8_BAR; PG8_SCHED;
            PG8_LDA(At, 0, 1); PG8_STAGE(PG8_SB(0, 0), b2, voffB); PG8_STAGE(PG8_SB(0, 1), b2 + hstepB, voffB); PG8_STAGE(PG8_SA(0, 0), a2, voffA);
            PG8_WAIT_V(8); PG8_WAIT_L(0); PG8_BAR; PG8_MMA(1, 0, At, B0); PG8_MMA(1, 1, At, B1); PG8_BAR; PG8_SCHED;
            PG8_LDB(B0, 1, 0); PG8_LDB(B1, 1, 1); PG8_SCHED; PG8_LDA(At, 1, 0); PG8_STAGE(PG8_SA(0, 1), a2 + hstepA, voffA);
            PG8_WAIT_V(8); PG8_WAIT_L(0); PG8_BAR; PG8_MMA(0, 0, At, B0); PG8_MMA(0, 1, At, B1); PG8_BAR; PG8_SCHED;
            PG8_LDA(At, 1, 1); PG8_STAGE(PG8_SB(1, 0), b3, voffB); PG8_STAGE(PG8_SB(1, 1), b3 + hstepB, voffB); PG8_STAGE(PG8_SA(1, 0), a3, voffA);
            PG8_WAIT_V(8); PG8_WAIT_L(0); PG8_BAR; PG8_MMA(1, 0, At, B0); PG8_MMA(1, 1, At, B1); PG8_BAR; PG8_SCHED;
        }
        if (wr == 0) PG8_BAR;
        E(acc, cur, wr, wc, fr, fq);
        if (!has_next) break;
#pragma unroll
        for (int a = 0; a < 2; ++a)
#pragma unroll
            for (int b = 0; b < 2; ++b)
#pragma unroll
                for (int m = 0; m < 4; ++m)
#pragma unroll
                    for (int n = 0; n < 2; ++n) acc[a][b][m][n] = (f32x4){0.f, 0.f, 0.f, 0.f};
        cur = nxt; cA = nA; cB = nB; ++ui;
        if (wr == 1) PG8_BAR;
    }
    PG8_WAIT_V(0);
    PG8_BAR;
#undef PG8_SA
#undef PG8_SB
#undef PG8_STAGE
#undef PG8_LDA
#undef PG8_LDB
#undef PG8_MMA
#undef PG8_WAIT_V
#undef PG8_WAIT_L
#undef PG8_BAR
#undef PG8_SCHED
}
}
using pg8::Unit;
typedef f32x4 AccT[2][2][4][2];

template <int ACT> struct EpiGated {
    static constexpr bool HAS_MID = false; static constexpr int TMID = -1;
    bf16_t* O; int ldc; const float* rs;
    DI void mid(AccT&, const Unit&, int, int, int, int) const {}
    DI void operator()(const AccT& acc, const Unit& u, int wr, int wc, int fr, int fq) const {
        const int row0 = u.pm * 256 + wr * 64 + fr, col0 = u.pn * 128 + wc * 32 + 8 * fq;
#pragma unroll
        for (int ai = 0; ai < 2; ++ai)
#pragma unroll
            for (int m = 0; m < 4; ++m) {
                f32x4 o[2]; const float rv = rs ? rs[row0 + ai * 128 + m * 16] : 1.f;
#pragma unroll
                for (int n = 0; n < 2; ++n)
#pragma unroll
                    for (int e = 0; e < 4; ++e) { const float a = acc[ai][0][m][n][e] * rv, b = acc[ai][1][m][n][e] * rv; o[n][e] = ACT == 0 ? fsilu(a) * b : a * fsigmoid(b); }
                *(u32x4*)(O + (size_t)(row0 + ai * 128 + m * 16) * ldc + col0) = pack8(o[0], o[1]);
            }
    }
};
struct EpiDown {
    static constexpr bool HAS_MID = false; static constexpr int TMID = -1;
    bf16_t* O; float* ssp;
    DI void mid(AccT&, const Unit&, int, int, int, int) const {}
    DI void operator()(const AccT& acc, const Unit& u, int wr, int wc, int fr, int fq) const {
        const int row0 = u.pm * 256 + wr * 64 + fr, col0 = u.pn * 256 + wc * 32 + 8 * fq;
#pragma unroll
        for (int ai = 0; ai < 2; ++ai)
#pragma unroll
            for (int m = 0; m < 4; ++m) {
                const int row = row0 + ai * 128 + m * 16; float ss = 0.f;
#pragma unroll
                for (int bj = 0; bj < 2; ++bj) {
                    const f32x4 v0 = acc[ai][bj][m][0], v1 = acc[ai][bj][m][1];
                    ss += (v0[0] * v0[0] + v0[1] * v0[1]) + (v0[2] * v0[2] + v0[3] * v0[3]) + (v1[0] * v1[0] + v1[1] * v1[1]) + (v1[2] * v1[2] + v1[3] * v1[3]);
                    *(u32x4*)(O + (size_t)row * 1024 + col0 + bj * 128) = pack8(v0, v1);
                }
                ssp[(size_t)(u.pn * 16 + wc * 4 + fq) * NTOK + row] = ss;
            }
    }
};
struct EpiWin {
    static constexpr bool HAS_MID = false; static constexpr int TMID = -1;
    bf16_t *U, *Q, *K, *VT, *R, *SB; const float* rs;
    DI void mid(AccT&, const Unit&, int, int, int, int) const {}
    DI void operator()(AccT& acc, const Unit& u, int wr, int wc, int fr, int fq) const {
        const int row0 = u.pm * 256 + wr * 64 + fr, pn = u.pn;
#pragma unroll
        for (int ai = 0; ai < 2; ++ai)
#pragma unroll
            for (int m = 0; m < 4; ++m) { const float rv = rs[row0 + ai * 128 + m * 16];
#pragma unroll
                for (int bj = 0; bj < 2; ++bj) { acc[ai][bj][m][0] *= rv; acc[ai][bj][m][1] *= rv; } }
        if (pn < 2) {
#pragma unroll
            for (int ai = 0; ai < 2; ++ai)
#pragma unroll
                for (int m = 0; m < 4; ++m) { const int row = row0 + ai * 128 + m * 16, bc = row >> 6, j = row & 63;
#pragma unroll
                    for (int bj = 0; bj < 2; ++bj) { const int c = pn * 256 + bj * 128 + wc * 32 + 8 * fq, gi = c >> 4, h0 = c & 15;
                        *(u32x4*)(U + ((size_t)gi * 1024 + bc) * 1152 + 128 + j * 16 + h0) = pack8(acc[ai][bj][m][0], acc[ai][bj][m][1]); } }
        } else if (pn < 6) {
            bf16_t* O = pn < 4 ? Q : K; const int cb = (pn & 1) * 256 + wc * 32 + 8 * fq;
#pragma unroll
            for (int ai = 0; ai < 2; ++ai)
#pragma unroll
                for (int m = 0; m < 4; ++m) { const int row = row0 + ai * 128 + m * 16;
#pragma unroll
                    for (int bj = 0; bj < 2; ++bj) *(u32x4*)(O + (size_t)row * 512 + cb + bj * 128) = pack8(acc[ai][bj][m][0], acc[ai][bj][m][1]); }
        } else if (pn < 8) {
#pragma unroll
            for (int ai = 0; ai < 2; ++ai)
#pragma unroll
                for (int m = 0; m < 4; ++m) { const int row = row0 + ai * 128 + m * 16, b = row >> 12, s = row & 4095;
#pragma unroll
                    for (int bj = 0; bj < 2; ++bj) { const int c = (pn - 6) * 256 + bj * 128 + wc * 32 + 8 * fq, hd = c >> 6, d0 = c & 63;
                        bf16_t* o = VT + (((size_t)b * 8 + hd) * 64 + d0) * 4096 + s;
                        const u32x4 w = pack8(acc[ai][bj][m][0], acc[ai][bj][m][1]);
                        o[0 * 4096] = (bf16_t)(w.x & 0xffff); o[1 * 4096] = (bf16_t)(w.x >> 16); o[2 * 4096] = (bf16_t)(w.y & 0xffff); o[3 * 4096] = (bf16_t)(w.y >> 16);
                        o[4 * 4096] = (bf16_t)(w.z & 0xffff); o[5 * 4096] = (bf16_t)(w.z >> 16); o[6 * 4096] = (bf16_t)(w.w & 0xffff); o[7 * 4096] = (bf16_t)(w.w >> 16); } }
        } else {
            const int cb = (pn - 8) * 128 + wc * 32 + 8 * fq;
#pragma unroll
            for (int ai = 0; ai < 2; ++ai)
#pragma unroll
                for (int m = 0; m < 4; ++m) { const int row = row0 + ai * 128 + m * 16; f32x4 r[2], sb[2];
#pragma unroll
                    for (int n = 0; n < 2; ++n)
#pragma unroll
                        for (int e = 0; e < 4; ++e) { const float sa = fsigmoid(acc[ai][0][m][n][e]), sbv = fsigmoid(acc[ai][1][m][n][e]); sb[n][e] = sbv; r[n][e] = sa / sbv; }
                    *(u32x4*)(R + (size_t)row * 1024 + cb) = pack8(r[0], r[1]);
                    *(u32x4*)(SB + (size_t)row * 1024 + cb) = pack8(sb[0], sb[1]); }
        }
    }
};
struct EpiS {
    static constexpr bool HAS_MID = false; static constexpr int TMID = -1;
    float* S;
    DI void mid(AccT&, const Unit&, int, int, int, int) const {}
    DI void operator()(const AccT& acc, const Unit& u, int wr, int wc, int fr, int fq) const {
        const int row0 = u.pm * 256 + wr * 64 + fr, col0 = wc * 32 + 8 * fq;
#pragma unroll
        for (int ai = 0; ai < 2; ++ai)
#pragma unroll
            for (int m = 0; m < 4; ++m) { float* o = S + ((size_t)u.pb * 1024 + row0 + ai * 128 + m * 16) * 128 + col0;
                *(f32x4*)o = acc[ai][0][m][0]; *(f32x4*)(o + 4) = acc[ai][0][m][1]; }
    }
};
struct EpiY {
    static constexpr bool HAS_MID = false; static constexpr int TMID = -1;
    bf16_t* YA;
    DI void mid(AccT&, const Unit&, int, int, int, int) const {}
    DI void operator()(const AccT& acc, const Unit& u, int wr, int wc, int fr, int fq) const {
        const int row0 = u.pm * 256 + wr * 64 + fr;
#pragma unroll
        for (int ai = 0; ai < 2; ++ai)
#pragma unroll
            for (int m = 0; m < 4; ++m) { const int row = row0 + ai * 128 + m * 16;
#pragma unroll
                for (int bj = 0; bj < 2; ++bj) { const int c = u.pn * 256 + bj * 128 + wc * 32 + 8 * fq, t = c >> 4, h0 = c & 15; f32x4 o[2];
#pragma unroll
                    for (int n = 0; n < 2; ++n)
#pragma unroll
                        for (int e = 0; e < 4; ++e) o[n][e] = fgelu_tanh(acc[ai][bj][m][n][e]);
                    *(u32x4*)(YA + ((size_t)row * 64 + t) * 512 + u.pb * 16 + h0) = pack8(o[0], o[1]); } }
    }
};
struct EpiMerge {
    static constexpr bool HAS_MID = true; static constexpr int TMID = 8;
    const bf16_t *R, *SB; bf16_t* O; int wave_s;
    DI void scale(AccT& acc, const Unit& u, int, int, int, int, const bf16_t* P) const {
        const int t_ = opaque_tid(wave_s), wid = __builtin_amdgcn_readfirstlane(t_ >> 6), ln = t_ & 63, wr = wid >> 2, wc = wid & 3, fr = ln & 15, fq = ln >> 4;
        const int row0 = u.pm * 256 + wr * 64 + fr, col0 = u.pn * 256 + wc * 32 + 8 * fq;
#pragma unroll
        for (int ai = 0; ai < 2; ++ai)
#pragma unroll
            for (int m = 0; m < 4; ++m)
#pragma unroll
                for (int bj = 0; bj < 2; ++bj) { const u32x4 w = *(const u32x4*)(P + (size_t)(row0 + ai * 128 + m * 16) * 1024 + col0 + bj * 128); f32x4 a, b; unpack8(w, a, b);
                    acc[ai][bj][m][0] *= a; acc[ai][bj][m][1] *= b; }
    }
    DI void mid(AccT& acc, const Unit& u, int wr, int wc, int fr, int fq) const { scale(acc, u, wr, wc, fr, fq, R); }
    DI void operator()(AccT& acc, const Unit& u, int wr, int wc, int fr, int fq) const {
        scale(acc, u, wr, wc, fr, fq, SB);
        const int row0 = u.pm * 256 + wr * 64 + fr, col0 = u.pn * 256 + wc * 32 + 8 * fq;
#pragma unroll
        for (int ai = 0; ai < 2; ++ai)
#pragma unroll
            for (int m = 0; m < 4; ++m)
#pragma unroll
                for (int bj = 0; bj < 2; ++bj) *(u32x4*)(O + (size_t)(row0 + ai * 128 + m * 16) * 1024 + col0 + bj * 128) = pack8(acc[ai][bj][m][0], acc[ai][bj][m][1]);
    }
};

struct Params { const float* in[20]; float* out; unsigned char* ws; };
enum { I_X = 0, I_GAINS, I_WGATE, I_WUP, I_WDOWN, I_WIN, I_LRE, I_LIM, I_LOGDT, I_BRE, I_BIM, I_CRE, I_CIM, I_DSKIP, I_GLUV, I_GLUG, I_OSSM, I_RELB, I_OATT, I_WO };

DI int map_row(int map, int n) {
    if (map == 0) return n;
    if (map == 1) return 256 * (n >> 7) + (n & 127);
    if (map == 2) return 256 * (n >> 7) + 128 + (n & 127);
    if (n < 2048) return n;
    if (n < 3072) { const int j = n - 2048; return 2048 + 256 * (j >> 7) + (j & 127); }
    const int j = n - 3072; return 2048 + 256 * (j >> 7) + 128 + (j & 127);
}
DI void cvt_item(const float* W, int K, int N, bf16_t* WT, int ldk, int koff, int map, LAS float* scr, int item, int lane, const float* gk = nullptr) {
    const int nblk = N / 32, kb = item / nblk, nb = item % nblk, k0 = 64 * kb, n0 = 32 * nb;
    const float sc = (map == 3 && n0 >= 512 && n0 < 1024) ? 0.125f : 1.f;
#pragma unroll
    for (int i = 0; i < 32; ++i) { const int kk = 2 * i + (lane >> 5); scr[kk * 33 + (lane & 31)] = W[(size_t)(k0 + kk) * N + n0 + (lane & 31)] * (gk ? sc * gk[k0 + kk] : sc); }
    asm volatile("s_waitcnt lgkmcnt(0)" ::: "memory");
    const int c = lane & 7;
#pragma unroll
    for (int j = 0; j < 4; ++j) { const int n = (lane >> 3) + 8 * j; const LAS float* s = scr + (8 * c) * 33 + n;
        u32x4 o; o.x = pk2(s[0 * 33], s[1 * 33]); o.y = pk2(s[2 * 33], s[3 * 33]); o.z = pk2(s[4 * 33], s[5 * 33]); o.w = pk2(s[6 * 33], s[7 * 33]);
        *(u32x4*)(WT + (size_t)map_row(map, n0 + n) * ldk + koff + k0 + 8 * c) = o; }
    asm volatile("s_waitcnt lgkmcnt(0)" ::: "memory");
}
DI void cvt_matrix(const float* W, int K, int N, bf16_t* WT, int ldk, int koff, int map, LAS float* scr, int gw, int NGW, int lane) {
    const int nitems = (K / 64) * (N / 32);
    for (int it = gw; it < nitems; it += NGW) cvt_item(W, K, N, WT, ldk, koff, map, scr, it, lane);
}

DI void s5_tables(const Params& P, LAS unsigned char* lds, int lg) {
    LAS float* pw = (LAS float*)lds;
    LAS float* bb = pw + 65 * 64 * 2;
    LAS float* cc = bb + 64 * 16 * 2;
    LAS float* ff = cc + 16 * 64 * 2;
    const int tid = threadIdx.x;
    unsigned char* ws = P.ws;
    float* gPW = (float*)(ws + OFF_PW + (size_t)lg * SZ_PW1);
    float* gBB = (float*)(ws + OFF_BB + (size_t)lg * SZ_BB1);
    float* gKE = (float*)(ws + OFF_KERN + (size_t)lg * SZ_KE1);
    const double dt = exp((double)P.in[I_LOGDT][lg]);
    const float* lre = P.in[I_LRE] + (size_t)lg * 64; const float* lim = P.in[I_LIM] + (size_t)lg * 64;
    for (int idx = tid; idx < 65 * 64; idx += NTHREADS) {
        const int tau = idx >> 6, p = idx & 63;
        const double lr = lre[p], li = lim[p];
        const float mag = __expf((float)(lr * dt * tau));
        double rev = li * dt * tau * 0.15915494309189535; rev -= rint(rev);
        const float cs = __builtin_amdgcn_cosf((float)rev), sn = __builtin_amdgcn_sinf((float)rev);
        const float re = mag * cs, im = mag * sn;
        pw[idx * 2] = re; pw[idx * 2 + 1] = im; gPW[idx * 2] = re; gPW[idx * 2 + 1] = im;
        if (tau == 1) {
            const double nr = (double)re - 1.0, ni = im, den = lr * lr + li * li;
            ff[p * 2] = (float)((nr * lr + ni * li) / den); ff[p * 2 + 1] = (float)((ni * lr - nr * li) / den);
        }
    }
    __syncthreads();
    const float* bre = P.in[I_BRE] + (size_t)lg * 1024; const float* bim = P.in[I_BIM] + (size_t)lg * 1024;
    const float* cre = P.in[I_CRE] + (size_t)lg * 1024; const float* cim = P.in[I_CIM] + (size_t)lg * 1024;
    for (int idx = tid; idx < 1024; idx += NTHREADS) {
        const int p = idx >> 4;
        const float fr_ = ff[p * 2], fi_ = ff[p * 2 + 1], br = bre[idx], bi = bim[idx];
        const float re = fr_ * br - fi_ * bi, im = fr_ * bi + fi_ * br;
        bb[idx * 2] = re; bb[idx * 2 + 1] = im; gBB[idx * 2] = re; gBB[idx * 2 + 1] = im;
        cc[idx * 2] = cre[idx]; cc[idx * 2 + 1] = cim[idx];
    }
    __syncthreads();
    const float* dsk = P.in[I_DSKIP] + (size_t)lg * 16;
    for (int pair = tid; pair < 1024; pair += NTHREADS) {
        const int tau = pair >> 4, h = pair & 15;
        float a[16];
#pragma unroll
        for (int j = 0; j < 16; ++j) a[j] = 0.f;
        for (int p = 0; p < 64; ++p) {
            const float cr = cc[(h * 64 + p) * 2], ci = cc[(h * 64 + p) * 2 + 1], pr = pw[(tau * 64 + p) * 2], pi = pw[(tau * 64 + p) * 2 + 1];
            const float xr = cr * pr - ci * pi, xi = cr * pi + ci * pr;
#pragma unroll
            for (int j = 0; j < 16; ++j) a[j] += xr * bb[(p * 16 + j) * 2] - xi * bb[(p * 16 + j) * 2 + 1];
        }
        const float dv = dsk[h];
#pragma unroll
        for (int j = 0; j < 16; ++j) gKE[(size_t)pair * 16 + j] = a[j] + ((tau == 0 && j == h) ? dv : 0.f);
    }
    __syncthreads();
}

DI void build_w12(const Params& P, int l, int wave_s) {
    unsigned char* ws = P.ws;
    const float* gPW = (const float*)(ws + OFF_PW) + (size_t)l * 32 * (65 * 64 * 2);
    const float* gBB = (const float*)(ws + OFF_BB) + (size_t)l * 32 * (64 * 16 * 2);
    const float* gKE = (const float*)(ws + OFF_KERN) + (size_t)l * 32 * (64 * 256);
    bf16_t* W1 = (bf16_t*)(ws + OFF_W1); bf16_t* W2 = (bf16_t*)(ws + OFF_W2);
    const int gt = blockIdx.x * NTHREADS + opaque_tid(wave_s), NT = gridDim.x * NTHREADS;
    for (int it = gt; it < 32 * 256 * 128; it += NT) {
        const int kk = it & 127, n = (it >> 7) & 255, g = it >> 15;
        float v[8];
        if (n >= 128) {
#pragma unroll
            for (int e = 0; e < 8; ++e) v[e] = 0.f;
        } else {
            const int p = n & 63, im = n >> 6, j = kk >> 1, h0 = (kk & 1) * 8;
            const float* pwp = gPW + ((size_t)g * 65 + (63 - j)) * 128 + p * 2; const float pr = pwp[0], pi = pwp[1];
            const float* bp = gBB + ((size_t)g * 64 + p) * 32 + h0 * 2;
#pragma unroll
            for (int e = 0; e < 8; ++e) { const float br = bp[e * 2], bi = bp[e * 2 + 1]; v[e] = im ? (pr * bi + pi * br) : (pr * br - pi * bi); }
        }
        u32x4 o; o.x = pk2(v[0], v[1]); o.y = pk2(v[2], v[3]); o.z = pk2(v[4], v[5]); o.w = pk2(v[6], v[7]);
        *(u32x4*)(W1 + (size_t)it * 8) = o;
    }
    const float* cre = P.in[I_CRE] + (size_t)l * 32 * 1024; const float* cim = P.in[I_CIM] + (size_t)l * 32 * 1024;
    for (int it = gt; it < 32 * 1024 * 144; it += NT) {
        const int kk = it % 144, n = (it / 144) & 1023, g = it / (144 * 1024), t = n >> 4, h = n & 15;
        float v[8];
        if (kk < 16) {
            const int im = kk >> 3, p0 = (kk & 7) * 8;
            const float* pwp = gPW + ((size_t)g * 65 + (t + 1)) * 128 + p0 * 2;
            const float* crp = cre + ((size_t)g * 16 + h) * 64 + p0; const float* cip = cim + ((size_t)g * 16 + h) * 64 + p0;
#pragma unroll
            for (int e = 0; e < 8; ++e) { const float cr = crp[e], ci = cip[e], pr = pwp[e * 2], pi = pwp[e * 2 + 1]; v[e] = im ? -(cr * pi + ci * pr) : (cr * pr - ci * pi); }
        } else {
            const int j = (kk - 16) >> 1, h0 = ((kk - 16) & 1) * 8;
            if (j <= t) { const float* kp = gKE + (((size_t)g * 64 + (t - j)) * 16 + h) * 16 + h0;
#pragma unroll
                for (int e = 0; e < 8; ++e) v[e] = kp[e];
            } else {
#pragma unroll
                for (int e = 0; e < 8; ++e) v[e] = 0.f;
            }
        }
        u32x4 o; o.x = pk2(v[0], v[1]); o.y = pk2(v[2], v[3]); o.z = pk2(v[4], v[5]); o.w = pk2(v[6], v[7]);
        *(u32x4*)(W2 + (size_t)it * 8) = o;
    }
}

DI void ew_rows(unsigned char* ws, float* outp, const float* xin, bool first, bool last, float coef, const float* gpost, int rbeg, int rend, int lane) {
    const bf16_t* M1 = (const bf16_t*)(ws + OFF_M1); const float* ssp = (const float*)(ws + OFF_SSP); bf16_t* XB = (bf16_t*)(ws + OFF_XN); float* RS = (float*)(ws + OFF_RS);
    for (int r0 = rbeg; r0 < rend; r0 += 4) {
        f32x4 ssv = {0.f, 0.f, 0.f, 0.f};
        u32x2 xr[4][4], mr[4][4]; f32x4 xf[4][4];
        if (first) {
#pragma unroll
            for (int q = 0; q < 4; ++q)
#pragma unroll
                for (int j = 0; j < 4; ++j) xf[q][j] = *(const f32x4*)(xin + (size_t)(r0 + q) * 1024 + j * 256 + lane * 4);
        } else {
            ssv = *(const f32x4*)(ssp + (size_t)lane * NTOK + r0);
#pragma unroll
            for (int q = 0; q < 4; ++q)
#pragma unroll
                for (int j = 0; j < 4; ++j) { xr[q][j] = *(const u32x2*)(XB + (size_t)(r0 + q) * 1024 + j * 256 + lane * 4); mr[q][j] = *(const u32x2*)(M1 + (size_t)(r0 + q) * 1024 + j * 256 + lane * 4); }
        }
#pragma unroll
        for (int q = 0; q < 4; ++q) {
            const int row = r0 + q;
            f32x4 v[4];
            if (first) {
#pragma unroll
                for (int j = 0; j < 4; ++j) v[j] = xf[q][j];
            } else {
                const float rstd = __builtin_amdgcn_rsqf(wave_sum(ssv[q], lane) * (1.f / 1024.f) + RMS_EPS) * coef;
#pragma unroll
                for (int j = 0; j < 4; ++j) {
                    const u32x2 xw = xr[q][j], w = mr[q][j];
                    const f32x4 gp = *(const f32x4*)(gpost + j * 256 + lane * 4);
                    const f32x4 xv = {bflo(xw.x), bfhi(xw.x), bflo(xw.y), bfhi(xw.y)};
                    const f32x4 mv = {bflo(w.x), bfhi(w.x), bflo(w.y), bfhi(w.y)};
                    v[j] = xv + gp * mv * rstd;
                }
            }
            if (last) {
#pragma unroll
                for (int j = 0; j < 4; ++j) *(f32x4*)(outp + (size_t)row * 1024 + j * 256 + lane * 4) = v[j];
            } else {
                float ss = 0.f;
#pragma unroll
                for (int j = 0; j < 4; ++j) ss += (v[j][0] * v[j][0] + v[j][1] * v[j][1]) + (v[j][2] * v[j][2] + v[j][3] * v[j][3]);
                const float rstd2 = __builtin_amdgcn_rsqf(wave_sum(ss, lane) * (1.f / 1024.f) + RMS_EPS);
                if (lane == 0) RS[row] = rstd2;
#pragma unroll
                for (int j = 0; j < 4; ++j) { u32x2 w; w.x = pk2(v[j][0], v[j][1]); w.y = pk2(v[j][2], v[j][3]);
                    *(u32x2*)(XB + (size_t)row * 1024 + j * 256 + lane * 4) = w; }
            }
        }
    }
}
DI void ew_phase(const Params& P, bool first, bool last, float coef, const float* gpost, int wave_s) {
    const int tid_ = opaque_tid(wave_s), lane = tid_ & 63, wave = __builtin_amdgcn_readfirstlane(tid_ >> 6);
    const int gw = blockIdx.x * NWAVES + wave, NGW = gridDim.x * NWAVES;
    const int rpw = (NTOK / 4 + NGW - 1) / NGW * 4;
    const int rbeg = gw * rpw, rend = (rbeg + rpw) < NTOK ? (rbeg + rpw) : NTOK;
    ew_rows(P.ws, P.out, P.in[I_X], first, last, coef, gpost, rbeg, rend, lane);
}

DI void carry_phase(const Params& P, int l, int wave_s) {
    const int tid_ = opaque_tid(wave_s), lane = tid_ & 63, wave = __builtin_amdgcn_readfirstlane(tid_ >> 6);
    unsigned char* ws = P.ws;
    const float* gPW = (const float*)(ws + OFF_PW) + (size_t)l * 32 * (65 * 64 * 2);
    const float* S = (const float*)(ws + OFF_S); bf16_t* U = (bf16_t*)(ws + OFF_U);
    const int gw = blockIdx.x * NWAVES + wave, NGW = gridDim.x * NWAVES;
    for (int task = gw; task < 512; task += NGW) {
        const int g = task >> 4, b = task & 15, p = lane;
        const float ar = gPW[((size_t)g * 65 + 64) * 128 + p * 2], ai = gPW[((size_t)g * 65 + 64) * 128 + p * 2 + 1];
        float xr = 0.f, xi = 0.f;
        const float* sp = S + ((size_t)g * 1024 + b * 64) * 128; bf16_t* up = U + ((size_t)g * 1024 + b * 64) * 1152;
#pragma unroll 8
        for (int c = 0; c < 64; ++c) {
            up[(size_t)c * 1152 + p] = (bf16_t)(pk2(xr, 0.f) & 0xffff); up[(size_t)c * 1152 + 64 + p] = (bf16_t)(pk2(xi, 0.f) & 0xffff);
            const float sr = sp[c * 128 + p], si = sp[c * 128 + 64 + p];
            const float nr = ar * xr - ai * xi + sr, ni = ar * xi + ai * xr + si;
            xr = nr; xi = ni;
        }
    }
}

DI int crow(int reg, int h) { return (reg & 3) + 8 * (reg >> 2) + 4 * h; }
#define MFMA32(a, b, c) __builtin_amdgcn_mfma_f32_32x32x16_bf16((a), (b), (c), 0, 0, 0)
DI bf16x8 pack_step(const f32x16& x, int s) {
    u32x4 p; p.x = pk2(x[8 * s], x[8 * s + 1]); p.y = pk2(x[8 * s + 2], x[8 * s + 3]); p.z = pk2(x[8 * s + 4], x[8 * s + 5]); p.w = pk2(x[8 * s + 6], x[8 * s + 7]);
    return __builtin_bit_cast(bf16x8, p);
}
#define ATTN_STEP(KT, BUF, KREG, VREG) \
            { LAS unsigned char* kb = kbuf + BUF * 9216; LAS unsigned char* vb = vbuf + BUF * 8704; \
            *(LAS u32x4*)(kb + lr * 144 + lsg * 16) = KREG; \
            { u32x2 a; a.x = VREG.x; a.y = VREG.y; u32x2 c; c.x = VREG.z; c.y = VREG.w; \
              *(LAS u32x2*)(vb + lr * 136 + lsg * 16) = a; *(LAS u32x2*)(vb + lr * 136 + lsg * 16 + 8) = c; } \
            __syncthreads(); \
            if (KT + 2 <= kthi) { KREG = *(const u32x4*)(kgp + (size_t)(KT + 2) * 64 * 512); VREG = *(const u32x4*)(vgp + (KT + 2) * 64); } \
            if (KT + 8 >= cc && KT <= cc) { \
                f32x16 s0, s1; \
_Pragma("unroll") \
                for (int i = 0; i < 16; ++i) { s0[i] = 0.f; s1[i] = 0.f; } \
_Pragma("unroll") \
                for (int ks = 0; ks < 4; ++ks) { \
                    const bf16x8 k0 = *(const LAS bf16x8*)(kb + n * 144 + ks * 32 + gq * 16), k1 = *(const LAS bf16x8*)(kb + (32 + n) * 144 + ks * 32 + gq * 16); \
                    s0 = MFMA32(k0, Qf[ks], s0); s1 = MFMA32(k1, Qf[ks], s1); \
                } \
                const int delta = cc - (KT); \
                if (delta >= 3) { const float cb = bth[256]; \
_Pragma("unroll") \
                    for (int i = 0; i < 16; ++i) { s0[i] += cb; s1[i] += cb; } \
                } else { const int base = 64 * delta + qh * 32 + n + 128; \
_Pragma("unroll") \
                    for (int i = 0; i < 16; ++i) { const int key = crow(i, gq); int i0 = base - key, i1 = base - key - 32; \
                        i0 = i0 > 256 ? 256 : i0; i1 = i1 > 256 ? 256 : i1; i0 = i0 < 0 ? 0 : i0; i1 = i1 < 0 ? 0 : i1; \
                        s0[i] += bth[i0]; s1[i] += bth[i1]; } \
                } \
                float mx = s0[0]; \
_Pragma("unroll") \
                for (int i = 1; i < 16; ++i) mx = fmaxf(mx, s0[i]); \
_Pragma("unroll") \
                for (int i = 0; i < 16; ++i) mx = fmaxf(mx, s1[i]); \
                mx = fmaxf(mx, shx(mx, lane, 32)); \
                const float mnew = fmaxf(mrun, mx), alpha = __expf(mrun - mnew); mrun = mnew; \
                float ps = 0.f; \
_Pragma("unroll") \
                for (int i = 0; i < 16; ++i) { s0[i] = __expf(s0[i] - mnew); s1[i] = __expf(s1[i] - mnew); ps += s0[i] + s1[i]; } \
                lrun = lrun * alpha + ps; \
_Pragma("unroll") \
                for (int i = 0; i < 16; ++i) { O0[i] *= alpha; O1[i] *= alpha; } \
_Pragma("unroll") \
                for (int kg = 0; kg < 2; ++kg) \
_Pragma("unroll") \
                    for (int s = 0; s < 2; ++s) { \
                        const bf16x8 Pf = pack_step(kg == 0 ? s0 : s1, s); \
                        const LAS unsigned char* v0 = vb + n * 136 + 64 * kg + 32 * s + 8 * gq; \
                        const s16x4 lo0 = *(const LAS s16x4*)(v0), hi0 = *(const LAS s16x4*)(v0 + 16); \
                        const s16x4 lo1 = *(const LAS s16x4*)(v0 + 32 * 136), hi1 = *(const LAS s16x4*)(v0 + 32 * 136 + 16); \
                        const bf16x8 V0 = __builtin_shufflevector(lo0, hi0, 0, 1, 2, 3, 4, 5, 6, 7), V1 = __builtin_shufflevector(lo1, hi1, 0, 1, 2, 3, 4, 5, 6, 7); \
                        O0 = MFMA32(V0, Pf, O0); O1 = MFMA32(V1, Pf, O1); \
                    } \
            } }
DI void attn_phase(const Params& P, int l, LAS unsigned char* lds, int wave_s) {
    const int tid_ = opaque_tid(wave_s), lane = tid_ & 63, wave = __builtin_amdgcn_readfirstlane(tid_ >> 6);
    unsigned char* ws = P.ws;
    const bf16_t* Q = (const bf16_t*)(ws + OFF_Q); const bf16_t* K = (const bf16_t*)(ws + OFF_K); const bf16_t* VT = (const bf16_t*)(ws + OFF_VT);
    bf16_t* ZA = (bf16_t*)P.out;
    LAS float* bt = (LAS float*)lds;
    LAS unsigned char* kbuf = lds + 8448;
    LAS unsigned char* vbuf = kbuf + 2 * 9216;
    const float* relb = P.in[I_RELB] + (size_t)l * 8 * 257;
    for (int i = tid_; i < 8 * 257; i += NTHREADS) bt[i] = relb[i];
    __syncthreads();
    const int n = lane & 31, gq = lane >> 5;
    const int ci = wave >> 1, qh = wave & 1;
    const int lr = tid_ >> 3, lsg = tid_ & 7;
    for (int it = blockIdx.x; it < 2048; it += gridDim.x) {
        const int y = it >> 4, cg4 = ((it & 15) + (it >> 8)) & 15, hd = y & 7, b = y >> 3;
        const int c0 = cg4 * 4, cc = c0 + ci;
        const int ktlo = c0 > 8 ? c0 - 8 : 0, kthi = c0 + 3;
        const size_t tok0 = (size_t)b * SEQ + cc * 64 + qh * 32;
        bf16x8 Qf[4];
        { const bf16_t* qp = Q + (tok0 + n) * 512 + hd * 64 + gq * 8;
#pragma unroll
          for (int ks = 0; ks < 4; ++ks) Qf[ks] = *(const bf16x8*)(qp + ks * 16); }
        f32x16 O0, O1;
#pragma unroll
        for (int i = 0; i < 16; ++i) { O0[i] = 0.f; O1[i] = 0.f; }
        float mrun = -1e30f, lrun = 0.f;
        const LAS float* bth = bt + hd * 257;
        const bf16_t* kgp = K + ((size_t)b * SEQ + lr) * 512 + hd * 64 + lsg * 8;
        const bf16_t* vgp = VT + (((size_t)b * 8 + hd) * 64 + lr) * SEQ + lsg * 8;
        u32x4 kregA = *(const u32x4*)(kgp + (size_t)ktlo * 64 * 512), vregA = *(const u32x4*)(vgp + ktlo * 64);
        u32x4 kregB = *(const u32x4*)(kgp + (size_t)(ktlo + 1) * 64 * 512), vregB = *(const u32x4*)(vgp + (ktlo + 1) * 64);
        for (int kt = ktlo; kt <= kthi; kt += 2) {
            ATTN_STEP(kt, 0, kregA, vregA)
            ATTN_STEP(kt + 1, 1, kregB, vregB)
        }
        lrun += shx(lrun, lane, 32);
        const float inv = 1.f / lrun;
        bf16_t* op = ZA + (tok0 + n) * 1024 + 512 + hd * 64 + gq * 4;
#pragma unroll
        for (int g4 = 0; g4 < 4; ++g4) {
            u32x2 w0, w1;
            w0.x = pk2(O0[4 * g4] * inv, O0[4 * g4 + 1] * inv); w0.y = pk2(O0[4 * g4 + 2] * inv, O0[4 * g4 + 3] * inv);
            w1.x = pk2(O1[4 * g4] * inv, O1[4 * g4 + 1] * inv); w1.y = pk2(O1[4 * g4 + 2] * inv, O1[4 * g4 + 3] * inv);
            *(u32x2*)(op + 8 * g4) = w0; *(u32x2*)(op + 32 + 8 * g4) = w1;
        }
        __syncthreads();
    }
}

__global__ void __launch_bounds__(NTHREADS, 2) mk_fwd(Params P) {
    extern __shared__ __attribute__((aligned(16))) unsigned char lds_raw[];
    LAS unsigned char* lds = (LAS unsigned char*)lds_raw;
    cg::grid_group grid = cg::this_grid();
    const int tid = threadIdx.x, lane = tid & 63, wave = __builtin_amdgcn_readfirstlane(tid >> 6);
    const int G = gridDim.x, bx = blockIdx.x;
    unsigned char* ws = P.ws;
    const int gw = bx * NWAVES + wave, NGW = G * NWAVES;
    volatile LAS unsigned* xst = (volatile LAS unsigned*)(lds + LDS_MAIN);
    if (tid == 0) { xst[0] = 0u; xst[1] = 0u; }
    __syncthreads();
    XcdBarrier xbar; xbar.bar = (unsigned*)(ws + OFF_BAR); xbar.x = xb_xcc_id(); xbar.st = xst;
    if (tid == 0) (void)xb_add(&xbar.bar[XB_XCNT(xbar.x)], 1u);

    {
        _Pragma("unroll 1") for (int rp_ = 0; rp_ < REP_PRO; ++rp_) {
        for (int lg = bx; lg < 128; lg += G) s5_tables(P, lds, lg);
        __syncthreads();
        LAS float* scr = (LAS float*)(lds + wave * 8704);
        for (int it = gw; it < 4 * 11776; it += NGW) {
            const int l = it / 11776; int r = it - l * 11776;
            if (r < 6 * 1408) {
                const int which = r / 1408, f = which & 1, kind = which >> 1; r -= which * 1408;
                bf16_t* wgu = (bf16_t*)(ws + OFF_WGU + (size_t)(l * 2 + f) * SZ_WGU);
                const float* gk = P.in[I_GAINS] + (size_t)(l * 6 + 4 * f) * 1024;
                if (kind == 0) cvt_item(P.in[I_WGATE] + (size_t)(l * 2 + f) * 1024 * 2816, 1024, 2816, wgu, 1024, 0, 1, scr, r, lane, gk);
                else if (kind == 1) cvt_item(P.in[I_WUP] + (size_t)(l * 2 + f) * 1024 * 2816, 1024, 2816, wgu, 1024, 0, 2, scr, r, lane, gk);
                else cvt_item(P.in[I_WDOWN] + (size_t)(l * 2 + f) * 2816 * 1024, 2816, 1024, (bf16_t*)(ws + OFF_WD + (size_t)(l * 2 + f) * SZ_WD), 2816, 0, 0, scr, r, lane);
                continue;
            }
            r -= 6 * 1408;
            if (r < 2048) { cvt_item(P.in[I_WIN] + (size_t)l * 1024 * 4096, 1024, 4096, (bf16_t*)(ws + OFF_WIN + (size_t)l * SZ_WIN), 1024, 0, 3, scr, r, lane, P.in[I_GAINS] + (size_t)(l * 6 + 2) * 1024); continue; }
            r -= 2048;
            if (r < 256) { const int gsel = r >> 7; r &= 127;
                cvt_item(P.in[gsel ? I_GLUG : I_GLUV] + (size_t)l * 512 * 512, 512, 512, (bf16_t*)(ws + OFF_WGL + (size_t)l * SZ_WGL), 512, 0, 1 + gsel, scr, r, lane); continue; }
            r -= 256;
            if (r < 512) { const int osel = r >> 8; r &= 255;
                cvt_item(P.in[osel ? I_OATT : I_OSSM] + (size_t)l * 512 * 1024, 512, 1024, (bf16_t*)(ws + OFF_WOUT + (size_t)l * SZ_WOUT), 1024, osel * 512, 0, scr, r, lane); continue; }
            r -= 512;
            cvt_item(P.in[I_WO] + (size_t)l * 1024 * 1024, 1024, 1024, (bf16_t*)(ws + OFF_WO + (size_t)l * SZ_WO), 1024, 0, 0, scr, r, lane);
        }
        __syncthreads();
        }
        ew_phase(P, true, false, 0.f, nullptr, wave);
        __syncthreads();
    }
    grid.sync();

    for (int step = 0; step < 12; ++step) {
        const int l = step / 3, s = step % 3;
        unsigned char* ws = P.ws; asm volatile("" : "+s"(ws));
        pg8::Gemm gfin;
        if (s != 1) {
            const int f = s >> 1;
            pg8::Gemm g{(const char*)(ws + OFF_XN), (const char*)(ws + OFF_WGU + (size_t)(l * 2 + f) * SZ_WGU), 1024, 1024, (size_t)256 * 1024 * 2, 0, (size_t)256 * 1024 * 2, 0, 16, 0};
            pg8::Order S; S.init(256, 22, 1, 0, G, bx);
            EpiGated<0> E{(bf16_t*)(ws + OFF_H), 2816, (const float*)(ws + OFF_RS)};
            _Pragma("unroll 1") for (int rep_ = 0; rep_ < REP_GEMM; ++rep_) pg8::gemm_phase(lds, g, S, E, wave);
            GSYNC();
            gfin = pg8::Gemm{(const char*)(ws + OFF_H), (const char*)(ws + OFF_WD + (size_t)(l * 2 + f) * SZ_WD), 2816, 2816, (size_t)256 * 2816 * 2, 0, (size_t)256 * 2816 * 2, 0, 44, 0};
        } else {
            {
                pg8::Gemm g{(const char*)(ws + OFF_XN), (const char*)(ws + OFF_WIN + (size_t)l * SZ_WIN), 1024, 1024, (size_t)256 * 1024 * 2, 0, (size_t)256 * 1024 * 2, 0, 16, 0};
                pg8::Order S; S.init(256, 16, 1, 0, G, bx);
                EpiWin E{(bf16_t*)(ws + OFF_U), (bf16_t*)(ws + OFF_Q), (bf16_t*)(ws + OFF_K), (bf16_t*)(ws + OFF_VT), (bf16_t*)(ws + OFF_M1), (bf16_t*)(ws + OFF_SB), (const float*)(ws + OFF_RS)};
                _Pragma("unroll 1") for (int rep_ = 0; rep_ < REP_GEMM; ++rep_) pg8::gemm_phase(lds, g, S, E, wave);
            }
            GSYNC();
            {
                pg8::Gemm g{(const char*)(ws + OFF_U) + 256, (const char*)(ws + OFF_W1), 1152, 1024, (size_t)256 * 1152 * 2, (size_t)1024 * 1152 * 2, 0, (size_t)256 * 1024 * 2, 16, 0};
                pg8::Order S; S.init(4, 1, 32, 1, G, bx);
                EpiS E{(float*)(ws + OFF_S)};
                _Pragma("unroll 1") for (int rep_ = 0; rep_ < REP_GEMM; ++rep_) pg8::gemm_phase(lds, g, S, E, wave);
                __syncthreads();
                _Pragma("unroll 1") for (int rep_ = 0; rep_ < REP_ATTN; ++rep_) attn_phase(P, l, lds, wave);
            }
            GSYNC();
            _Pragma("unroll 1") for (int rc_ = 0; rc_ < REP_CARRY; ++rc_) carry_phase(P, l, wave);
            GSYNC();
            {
                pg8::Gemm g{(const char*)(ws + OFF_U), (const char*)(ws + OFF_W2), 1152, 1152, (size_t)256 * 1152 * 2, (size_t)1024 * 1152 * 2, (size_t)256 * 1152 * 2, (size_t)1024 * 1152 * 2, 6, 4};
                pg8::Order S; S.init(4, 4, 32, 2, G, bx);
                EpiY E{(bf16_t*)(ws + OFF_Q)};
                _Pragma("unroll 1") for (int rep_ = 0; rep_ < REP_GEMM; ++rep_) pg8::gemm_phase(lds, g, S, E, wave);
            }
            GSYNC();
            {
                pg8::Gemm g{(const char*)(ws + OFF_Q), (const char*)(ws + OFF_WGL + (size_t)l * SZ_WGL), 512, 512, (size_t)256 * 512 * 2, 0, (size_t)256 * 512 * 2, 0, 8, 0};
                pg8::Order S; S.init(256, 4, 1, 0, G, bx);
                EpiGated<1> E{(bf16_t*)P.out, 1024, nullptr};
                _Pragma("unroll 1") for (int rep_ = 0; rep_ < REP_GEMM; ++rep_) pg8::gemm_phase(lds, g, S, E, wave);
            }
            GSYNC();
            {
                pg8::Gemm g{(const char*)P.out, (const char*)(ws + OFF_WOUT + (size_t)l * SZ_WOUT), 1024, 1024, (size_t)256 * 1024 * 2, 0, (size_t)256 * 1024 * 2, 0, 16, 0};
                pg8::Order S; S.init(256, 4, 1, 0, G, bx);
                EpiMerge E{(const bf16_t*)(ws + OFF_M1), (const bf16_t*)(ws + OFF_SB), (bf16_t*)(ws + OFF_K), wave};
                _Pragma("unroll 1") for (int rep_ = 0; rep_ < REP_GEMM; ++rep_) pg8::gemm_phase(lds, g, S, E, wave);
            }
            GSYNC();
            gfin = pg8::Gemm{(const char*)(ws + OFF_K), (const char*)(ws + OFF_WO + (size_t)l * SZ_WO), 1024, 1024, (size_t)256 * 1024 * 2, 0, (size_t)256 * 1024 * 2, 0, 16, 0};
        }
        {
            pg8::Order S; S.init(256, 4, 1, 0, G, bx);
            EpiDown E{(bf16_t*)(ws + OFF_M1), (float*)(ws + OFF_SSP)};
            _Pragma("unroll 1") for (int rep_ = 0; rep_ < REP_GEMM; ++rep_) pg8::gemm_phase(lds, gfin, S, E, wave);
        }
        GSYNC();
        {
            const float* gains = P.in[I_GAINS];
            ew_phase(P, false, step == 11, s == 1 ? 1.f : 0.5f, gains + (size_t)(2 * step + 1) * 1024, wave);
            if (s == 0) { _Pragma("unroll 1") for (int rb_ = 0; rb_ < REP_BUILD; ++rb_) build_w12(P, l, wave); }
        }
        if (step != 11) GSYNC();
    }
}

extern "C" void kernel_launch(void* const* d_in, const int* in_sizes, int n_in, void* d_out, int out_size, void* d_ws, size_t ws_size, hipStream_t stream) {
    static int grid = 0;
    if (grid == 0) {
        if (n_in != 20 || out_size != NTOK * DM || ws_size < WS_END) { fprintf(stderr, "kernel_launch: unexpected shapes: n_in %d out %d ws %zu (need %zu)\n", n_in, out_size, ws_size, (size_t)WS_END); grid = -1; return; }
        int dev = 0, cus = 0, per_cu = 0;
        hipGetDevice(&dev);
        hipDeviceGetAttribute(&cus, hipDeviceAttributeMultiprocessorCount, dev);
        if (hipFuncSetAttribute((const void*)mk_fwd, hipFuncAttributeMaxDynamicSharedMemorySize, LDS_BYTES) != hipSuccess) { fprintf(stderr, "kernel_launch: hipFuncSetAttribute failed\n"); grid = -1; return; }
        if (hipOccupancyMaxActiveBlocksPerMultiprocessor(&per_cu, (const void*)mk_fwd, NTHREADS, LDS_BYTES) != hipSuccess || per_cu < 1) { fprintf(stderr, "kernel_launch: occupancy query failed (%d)\n", per_cu); per_cu = 1; }
        (void)hipGetLastError();
        grid = cus * per_cu;
    }
    if (grid < 0) return;
    if (hipMemsetAsync((char*)d_ws + OFF_BAR, 0, BAR_BYTES, stream) != hipSuccess) { fprintf(stderr, "kernel_launch: memset failed\n"); return; }
    Params p{};
    for (int i = 0; i < 20; ++i) p.in[i] = (const float*)d_in[i];
    p.out = (float*)d_out; p.ws = (unsigned char*)d_ws;
    void* args[] = {&p};
    hipError_t e = hipLaunchCooperativeKernel((const void*)mk_fwd, dim3(grid), dim3(NTHREADS), args, LDS_BYTES, stream);
    if (e != hipSuccess) fprintf(stderr, "cooperative launch failed: %s (grid %d)\n", hipGetErrorString(e), grid);
}
```

```cpp
#include <hip/hip_runtime.h>
#include <hip/hip_cooperative_groups.h>
#include <cstdio>
#include <cstdint>
namespace cg = cooperative_groups;

#define LAS __attribute__((address_space(3)))
typedef unsigned short bf16_t;
typedef short bf16x8 __attribute__((ext_vector_type(8)));
typedef short s16x4 __attribute__((ext_vector_type(4)));
typedef float f32x4 __attribute__((ext_vector_type(4)));
typedef float f32x2 __attribute__((ext_vector_type(2)));
typedef float f32x16 __attribute__((ext_vector_type(16)));
typedef unsigned u32x4 __attribute__((ext_vector_type(4)));
typedef unsigned u32x2 __attribute__((ext_vector_type(2)));
typedef __bf16 bf2_t __attribute__((ext_vector_type(2)));
#define DI __device__ __forceinline__

constexpr int NTOK = 65536, DM = 1024, FF = 2816, NL = 4, NGRP = 32, SEQ = 4096;
constexpr float RMS_EPS = 1e-6f;
constexpr int NTHREADS = 512, NWAVES = 8;
constexpr int LDS_MAIN = 131072, LDS_BYTES = LDS_MAIN + 16;
#ifndef REP_GEMM
#define REP_GEMM 1
#endif
#ifndef REP_SYNC
#define REP_SYNC 1
#endif
#ifndef REP_EW
#define REP_EW 0
#endif
#ifndef REP_PRO
#define REP_PRO 1
#endif
#ifndef REP_CARRY
#define REP_CARRY 1
#endif
#ifndef REP_BUILD
#define REP_BUILD 1
#endif
#define GSYNC() do { _Pragma("unroll 1") for (int rs_ = 0; rs_ < REP_SYNC; ++rs_) xcd_barrier(xbar, wave); } while (0)
#ifndef REP_ATTN
#define REP_ATTN 1
#endif

constexpr size_t SZ_WGU = (size_t)5632 * 1024 * 2, SZ_WD = (size_t)1024 * 2816 * 2, SZ_WIN = (size_t)4096 * 1024 * 2;
constexpr size_t SZ_WGL = (size_t)1024 * 512 * 2, SZ_WOUT = (size_t)1024 * 1024 * 2, SZ_WO = (size_t)1024 * 1024 * 2;
constexpr size_t OFF_WGU = 0;
constexpr size_t OFF_WD = OFF_WGU + 8 * SZ_WGU;
constexpr size_t OFF_WIN = OFF_WD + 8 * SZ_WD;
constexpr size_t OFF_WGL = OFF_WIN + 4 * SZ_WIN;
constexpr size_t OFF_WOUT = OFF_WGL + 4 * SZ_WGL;
constexpr size_t OFF_WO = OFF_WOUT + 4 * SZ_WOUT;
constexpr size_t SZ_PW1 = (size_t)65 * 64 * 2 * 4;
constexpr size_t SZ_BB1 = (size_t)64 * 16 * 2 * 4;
constexpr size_t SZ_KE1 = (size_t)64 * 256 * 4;
constexpr size_t OFF_PW = OFF_WO + 4 * SZ_WO;
constexpr size_t OFF_BB = OFF_PW + 128 * SZ_PW1;
constexpr size_t OFF_KERN = OFF_BB + 128 * SZ_BB1;
constexpr size_t OFF_W1 = OFF_KERN + 128 * SZ_KE1;
constexpr size_t OFF_W2 = OFF_W1 + (size_t)32 * 256 * 1024 * 2;
constexpr size_t OFF_XN = OFF_W2 + (size_t)32 * 1024 * 1152 * 2;
constexpr size_t OFF_M1 = OFF_XN + (size_t)NTOK * 1024 * 2;
constexpr size_t OFF_SSP = OFF_M1 + (size_t)NTOK * 1024 * 2;
constexpr size_t OFF_RS = OFF_SSP + (size_t)64 * NTOK * 4;
constexpr size_t OFF_OV = OFF_RS + (size_t)NTOK * 4;
constexpr size_t OFF_H = OFF_OV;
constexpr size_t OFF_U = OFF_OV;
constexpr size_t OFF_Q = OFF_U + (size_t)32 * 1024 * 1152 * 2;
constexpr size_t OFF_K = OFF_Q + (size_t)NTOK * 512 * 2;
constexpr size_t OFF_VT = OFF_K + (size_t)NTOK * 512 * 2;
constexpr size_t OFF_SB = OFF_VT + (size_t)NTOK * 512 * 2;
constexpr size_t OFF_S = OFF_SB + (size_t)NTOK * 1024 * 2;
constexpr size_t OV_MIX = OFF_S + (size_t)32 * 1024 * 128 * 4 - OFF_OV;
constexpr size_t OV_FFN = (size_t)NTOK * 2816 * 2;
constexpr size_t OFF_BAR = OFF_OV + (OV_MIX > OV_FFN ? OV_MIX : OV_FFN);
constexpr size_t BAR_BYTES = 16384;
constexpr size_t WS_END = OFF_BAR + BAR_BYTES;

DI const char* uni_ptr(const char* p) { const unsigned long long v = (unsigned long long)p; const unsigned lo = __builtin_amdgcn_readfirstlane((unsigned)v), hi = __builtin_amdgcn_readfirstlane((unsigned)(v >> 32)); return (const char*)(((unsigned long long)hi << 32) | lo); }
DI int opaque_tid(int wave_s) { int t = wave_s * 64 + (int)__builtin_amdgcn_mbcnt_hi(~0u, __builtin_amdgcn_mbcnt_lo(~0u, 0u)); asm volatile("" : "+v"(t)); return t; }
DI unsigned pk2(float a, float b) { f32x2 v = {a, b}; bf2_t r = __builtin_convertvector(v, bf2_t); return __builtin_bit_cast(unsigned, r); }
DI float bflo(unsigned u) { return __uint_as_float(u << 16); }
DI float bfhi(unsigned u) { return __uint_as_float(u & 0xffff0000u); }
DI float shx(float v, int lane, int o) { return __int_as_float(__builtin_amdgcn_ds_bpermute((lane ^ o) << 2, __float_as_int(v))); }
DI float wave_sum(float v, int lane) {
#pragma unroll
    for (int o = 1; o < 64; o <<= 1) v += shx(v, lane, o);
    return v;
}
DI float fsigmoid(float x) { return __builtin_amdgcn_rcpf(1.f + __expf(-x)); }
DI float fsilu(float x) { return x * fsigmoid(x); }
DI float fgelu_tanh(float x) { return x * fsigmoid(1.5957691216f * (x + 0.044715f * x * x * x)); }
DI u32x4 pack8(const f32x4 a, const f32x4 b) { u32x4 w; w.x = pk2(a[0], a[1]); w.y = pk2(a[2], a[3]); w.z = pk2(b[0], b[1]); w.w = pk2(b[2], b[3]); return w; }
DI void unpack8(const u32x4 w, f32x4& a, f32x4& b) { a = (f32x4){bflo(w.x), bfhi(w.x), bflo(w.y), bfhi(w.y)}; b = (f32x4){bflo(w.z), bfhi(w.z), bflo(w.w), bfhi(w.w)}; }


#define XB_TMO      128
#define XB_XCNT(j)  (256  + 64 * (j))
#define XB_XSUB(j)  (1280 + 64 * (j))
#define XB_XGEN(j)  (2304 + 64 * (j))
#define XB_TOP      3328
#define XB_TOPGEN   3392
#define XCD_BAR_WORDS 3456
#define XB_SPIN_CAP (1u << 20)
DI unsigned xb_ld(unsigned* p)              { return __hip_atomic_load(p, __ATOMIC_RELAXED, __HIP_MEMORY_SCOPE_AGENT); }
DI unsigned xb_add(unsigned* p, unsigned v) { return __hip_atomic_fetch_add(p, v, __ATOMIC_RELAXED, __HIP_MEMORY_SCOPE_AGENT); }
DI unsigned xb_xcc_id() { return (unsigned)__builtin_amdgcn_s_getreg((3 << 11) | 20) & 0xFu; }
#define XB_SPIN(cond, bar) do { unsigned _sp = 0; while (cond) { __builtin_amdgcn_s_sleep(1); \
    if ((++_sp & 255u) == 0u) { if (xb_ld(&(bar)[XB_TMO])) break; if (_sp > XB_SPIN_CAP) { atomicAdd(&(bar)[XB_TMO], 1u); break; } } } } while (0)
struct XcdBarrier { unsigned* bar; unsigned x; volatile LAS unsigned* st; };
DI void xcd_barrier_complete(unsigned* bar, unsigned x, unsigned& nloc, unsigned& nx) {
    const unsigned G = gridDim.x;
    unsigned sum, cnt, mine, sp = 0u;
    for (;;) {
        sum = 0u; cnt = 0u; mine = 0u;
#pragma unroll
        for (unsigned j = 0; j < 16; ++j) { const unsigned c = xb_ld(&bar[XB_XCNT(j)]); sum += c; cnt += (c > 0u) ? 1u : 0u; mine = (j == x) ? c : mine; }
        if (sum == G) break;
        __builtin_amdgcn_s_sleep(1);
        if ((++sp & 255u) == 0u) { if (xb_ld(&bar[XB_TMO])) break; if (sp > XB_SPIN_CAP) { atomicAdd(&bar[XB_TMO], 1u); break; } }
    }
    nloc = mine > 0u ? mine : 1u; nx = cnt > 0u ? cnt : 1u;
}
DI void xcd_barrier(const XcdBarrier& b, int wave_s) {
    asm volatile("s_waitcnt vmcnt(0)" ::: "memory");
    __syncthreads();
    if (opaque_tid(wave_s) == 0) {
        unsigned* bar = b.bar;
        __builtin_amdgcn_s_waitcnt(0);
        unsigned nloc = b.st[0], nx = b.st[1];
        if (nloc == 0u) { xcd_barrier_complete(bar, b.x, nloc, nx); b.st[0] = nloc; b.st[1] = nx; }
        const unsigned old = xb_add(&bar[XB_XSUB(b.x)], 1u);
        const unsigned gen = old / nloc;
        if (old + 1u == (gen + 1u) * nloc) {
            __builtin_amdgcn_fence(__ATOMIC_RELEASE, "agent");
            asm volatile("s_waitcnt vmcnt(0)" ::: "memory");
            const unsigned og = xb_add(&bar[XB_TOP], 1u);
            const unsigned tg = og / nx;
            if (og + 1u == (tg + 1u) * nx) xb_add(&bar[XB_TOPGEN], 1u);
            else XB_SPIN(xb_ld(&bar[XB_TOPGEN]) == tg, bar);
            __builtin_amdgcn_fence(__ATOMIC_ACQUIRE, "agent");
            xb_add(&bar[XB_XGEN(b.x)], 1u);
            asm volatile("s_waitcnt vmcnt(0)" ::: "memory");
        } else {
            XB_SPIN(xb_ld(&bar[XB_XGEN(b.x)]) == gen, bar);
            __builtin_amdgcn_fence(__ATOMIC_ACQUIRE, "agent");
            asm volatile("s_waitcnt vmcnt(0)" ::: "memory");
        }
    }
    __syncthreads();
}

namespace pg8 {
constexpr int BM = 256, BK = 64, HALF = 128, HTB = HALF * BK * 2, STAGE_BYTES = 8 * HTB, NXCD = 8, WGM = 8;
DI int lds_byte(int r, int c) { const int st = (r >> 4) * 2 + (c >> 5), rr = r & 15, cc = c & 31, ob = rr * 64 + cc * 2; return st * 1024 + (ob ^ (((ob >> 9) & 1) << 5)); }
DI void stage_rc(int b, int& R, int& C) { const int st = b / 1024, sb = b % 1024, swz = sb ^ (((sb >> 9) & 1) << 5); R = (st >> 1) * 16 + swz / 64; C = (st & 1) * 32 + (swz % 64) / 2; }
DI int perm32(int rho) { const int n = rho >> 4, i = rho & 15; return 8 * (i >> 2) + 4 * n + (i & 3); }

struct Unit { int pm, pn, pb; };
struct Gemm { const char* A; const char* B; int lda, ldb; size_t a_pm, a_pb, b_pn, b_pb; int nt0, ntstep; };
struct Order {
    int nM, nN, nB, nwg, G, c, mode;
    DI void init(int nM_, int nN_, int nB_, int mode_, int G_, int c_) { nM = nM_; nN = nN_; nB = nB_; mode = mode_; nwg = nM * nN * nB; G = G_; c = c_; }
    DI bool next(int i, Unit& u) const {
        const long L = (long)i * G + c; if (L >= nwg) return false;
        if (mode == 0) {
            int wgid = (int)L; { const int q = nwg / NXCD, r = nwg % NXCD, xcd = wgid % NXCD, off = wgid / NXCD; wgid = (xcd < r ? xcd * (q + 1) : r * (q + 1) + (xcd - r) * q) + off; }
            const int nig = WGM * nN, gid = wgid / nig, fm = gid * WGM, gsz = (nM - fm) < WGM ? (nM - fm) : WGM;
            u.pm = fm + ((wgid % nig) % gsz); u.pn = (wgid % nig) / gsz; u.pb = 0;
        } else {
            const int per = nM * nN, l = (int)L; u.pb = l / per; const int rem = l % per; u.pm = rem / nN; int pn = rem % nN;
            if (mode == 2 && (i & 1)) pn = nN - 1 - pn;
            u.pn = pn;
        }
        u.pm = __builtin_amdgcn_readfirstlane(u.pm); u.pn = __builtin_amdgcn_readfirstlane(u.pn); u.pb = __builtin_amdgcn_readfirstlane(u.pb);
        return true;
    }
};

template <class Epi>
DI void gemm_phase(LAS unsigned char* lds, const Gemm g, const Order& S, const Epi& E, int wave_s) {
    const int tid = opaque_tid(wave_s);
    const int wid = __builtin_amdgcn_readfirstlane(tid >> 6), lane = tid & 63, wr = wid >> 2, wc = wid & 3, fr = lane & 15, fq = lane >> 4;
    unsigned voffA[2], voffB[2];
#pragma unroll
    for (int i = 0; i < 2; ++i) { int R, C; stage_rc(tid * 16 + i * 8192, R, C); const int Rb = (R & ~31) + perm32(R & 31);
        voffA[i] = (unsigned)(R * g.lda + C) * 2u; voffB[i] = (unsigned)(Rb * g.ldb + C) * 2u; }
    const size_t kstep = (size_t)(BK * 2);
    const size_t hstepA = (size_t)HALF * g.lda * 2, hstepB = (size_t)HALF * g.ldb * 2;
    const unsigned ldsw = (unsigned)wid * 1024u;
    const int aoff = lds_byte(wr * 64 + fr, fq * 8), boff = lds_byte(wc * 32 + fr, fq * 8);
#define PG8_SA(b, h) (((b) * 2 + (h)) * HTB)
#define PG8_SB(b, h) ((4 + (b) * 2 + (h)) * HTB)
#define PG8_STAGE(bufoff, gbase, voff) do { _Pragma("unroll") for (int _i = 0; _i < 2; ++_i) \
        __builtin_amdgcn_global_load_lds((const unsigned*)((const char*)(gbase) + (voff)[_i]), (LAS unsigned*)(lds + (bufoff) + ldsw + _i * 8192), 16, 0, 0); } while (0)
#define PG8_LDA(dst, b, h) do { _Pragma("unroll") for (int m = 0; m < 4; ++m) _Pragma("unroll") for (int k = 0; k < 2; ++k) dst[m][k] = *(const LAS bf16x8*)(lds + PG8_SA(b, h) + aoff + m * 2048 + k * 1024); } while (0)
#define PG8_LDB(dst, b, h) do { _Pragma("unroll") for (int n = 0; n < 2; ++n) _Pragma("unroll") for (int k = 0; k < 2; ++k) dst[n][k] = *(const LAS bf16x8*)(lds + PG8_SB(b, h) + boff + n * 2048 + k * 1024); } while (0)
#define PG8_MMA(ai, bj, At, Bt) do { __builtin_amdgcn_s_setprio(1); _Pragma("unroll") for (int m = 0; m < 4; ++m) _Pragma("unroll") for (int n = 0; n < 2; ++n) _Pragma("unroll") for (int k = 0; k < 2; ++k) \
        acc[ai][bj][m][n] = __builtin_amdgcn_mfma_f32_16x16x32_bf16(Bt[n][k], At[m][k], acc[ai][bj][m][n], 0, 0, 0); __builtin_amdgcn_s_setprio(0); } while (0)
#define PG8_WAIT_V(n) asm volatile("s_waitcnt vmcnt(" #n ")" ::: "memory")
#define PG8_WAIT_L(n) asm volatile("s_waitcnt lgkmcnt(" #n ")" ::: "memory")
#define PG8_BAR __builtin_amdgcn_s_barrier()
#define PG8_SCHED __builtin_amdgcn_sched_barrier(0)
    Unit cur, nxt; int ui = 0;
    if (!S.next(0, cur)) return;
    f32x4 acc[2][2][4][2];
#pragma unroll
    for (int a = 0; a < 2; ++a)
#pragma unroll
        for (int b = 0; b < 2; ++b)
#pragma unroll
            for (int m = 0; m < 4; ++m)
#pragma unroll
                for (int n = 0; n < 2; ++n) acc[a][b][m][n] = (f32x4){0.f, 0.f, 0.f, 0.f};
    bf16x8 At[4][2], B0[2][2], B1[2][2];
    const char* cA = uni_ptr(g.A + (size_t)cur.pb * g.a_pb + (size_t)cur.pm * g.a_pm);
    const char* cB = uni_ptr(g.B + (size_t)cur.pb * g.b_pb + (size_t)cur.pn * g.b_pn);
    PG8_STAGE(PG8_SB(0, 0), cB, voffB); PG8_STAGE(PG8_SB(0, 1), cB + hstepB, voffB); PG8_STAGE(PG8_SA(0, 0), cA, voffA); PG8_STAGE(PG8_SA(0, 1), cA + hstepA, voffA);
    if (wr == 1) PG8_BAR;
    PG8_WAIT_V(2); PG8_BAR;
    PG8_STAGE(PG8_SB(1, 0), cB + kstep, voffB); PG8_STAGE(PG8_SA(1, 0), cA + kstep, voffA); PG8_STAGE(PG8_SB(1, 1), cB + hstepB + kstep, voffB);
    PG8_WAIT_V(6); PG8_BAR;
    for (;;) {
        const bool has_next = S.next(ui + 1, nxt);
        const char* nA = uni_ptr(has_next ? g.A + (size_t)nxt.pb * g.a_pb + (size_t)nxt.pm * g.a_pm : cA);
        const char* nB = uni_ptr(has_next ? g.B + (size_t)nxt.pb * g.b_pb + (size_t)nxt.pn * g.b_pn : cB);
        const int nt = g.nt0 + g.ntstep * cur.pn;
        for (int t = 0; t < nt; t += 2) {
            const bool last = (t == nt - 2);
            if constexpr (Epi::HAS_MID) { if (t == Epi::TMID) E.mid(acc, cur, wr, wc, fr, fq); }
            const char* a1 = cA + (size_t)(t + 1) * kstep;
            const char* a2 = last ? nA : cA + (size_t)(t + 2) * kstep; const char* b2 = last ? nB : cB + (size_t)(t + 2) * kstep;
            const char* a3 = a2 + kstep; const char* b3 = b2 + kstep;
            PG8_LDB(B0, 0, 0); PG8_LDB(B1, 0, 1); PG8_SCHED; PG8_LDA(At, 0, 0); PG8_STAGE(PG8_SA(1, 1), a1 + hstepA, voffA);
            PG8_WAIT_V(8); PG8_WAIT_L(0); PG8_BAR; PG8_MMA(0, 0, At, B0); PG8_MMA(0, 1, At, B1); PG8_BAR; PG8_SCHED;
            PG8_LDA(At, 0, 1); PG8_STAGE(PG8_SB(0, 0), b2, voffB); PG8_STAGE(PG8_SB(0, 1), b2 + hstepB, voffB); PG8_STAGE(PG8_SA(0, 0), a2, voffA);
            PG8_WAIT_V(8); PG8_WAIT_L(0); PG8_BAR; PG8_MMA(1, 0, At, B0); PG8_MMA(1, 1, At, B1); PG8_BAR; PG8_SCHED;
            PG8_LDB(B0, 1, 0); PG8_LDB(B1, 1, 1); PG8_SCHED; PG8_LDA(At, 1, 0); PG8_STAGE(PG8_SA(0, 1), a2 + hstepA, voffA);
            PG8_WAIT_V(8); PG8_WAIT_L(0); PG8_BAR; PG8_MMA(0, 0, At, B0); PG8_MMA(0, 1, At, B1); PG8_BAR; PG8_SCHED;
            PG8_LDA(At, 1, 1); PG8_STAGE(PG8_SB(1, 0), b3, voffB); PG8_STAGE(PG8_SB(1, 1), b3 + hstepB, voffB); PG8_STAGE(PG8_SA(1, 0), a3, voffA);
            PG8_WAIT_V(8); PG8_WAIT_L(0); PG8_BAR; PG8_MMA(1, 0, At, B0); PG8_MMA(1, 1, At, B1); PG8_BAR; PG8_SCHED;
        }
        if (wr == 0) PG8_BAR;
        E(acc, cur, wr, wc, fr, fq);
        if (!has_next) break;
#pragma unroll
        for (int a = 0; a < 2; ++a)
#pragma unroll
            for (int b = 0; b < 2; ++b)
#pragma unroll
                for (int m = 0; m < 4; ++m)
#pragma unroll
                    for (int n = 0; n < 2; ++n) acc[a][b][m][n] = (f32x4){0.f, 0.f, 0.f, 0.f};
        cur = nxt; cA = nA; cB = nB; ++ui;
        if (wr == 1) PG8_BAR;
    }
    PG8_WAIT_V(0);
    PG8_BAR;
#undef PG8_SA
#undef PG8_SB
#undef PG8_STAGE
#undef PG8_LDA
#undef PG8_LDB
#undef PG8_MMA
#undef PG8_WAIT_V
#undef PG8_WAIT_L
#undef PG8_BAR
#undef PG8_SCHED
}
}
using pg8::Unit;
typedef f32x4 AccT[2][2][4][2];

template <int ACT> struct EpiGated {
    static constexpr bool HAS_MID = false; static constexpr int TMID = -1;
    bf16_t* O; int ldc; const float* rs;
    DI void mid(AccT&, const Unit&, int, int, int, int) const {}
    DI void operator()(const AccT& acc, const Unit& u, int wr, int wc, int fr, int fq) const {
        const int row0 = u.pm * 256 + wr * 64 + fr, col0 = u.pn * 128 + wc * 32 + 8 * fq;
#pragma unroll
        for (int ai = 0; ai < 2; ++ai)
#pragma unroll
            for (int m = 0; m < 4; ++m) {
                f32x4 o[2]; const float rv = rs ? rs[row0 + ai * 128 + m * 16] : 1.f;
#pragma unroll
                for (int n = 0; n < 2; ++n)
#pragma unroll
                    for (int e = 0; e < 4; ++e) { const float a = acc[ai][0][m][n][e] * rv, b = acc[ai][1][m][n][e] * rv; o[n][e] = ACT == 0 ? fsilu(a) * b : a * fsigmoid(b); }
                *(u32x4*)(O + (size_t)(row0 + ai * 128 + m * 16) * ldc + col0) = pack8(o[0], o[1]);
            }
    }
};
struct EpiDown {
    static constexpr bool HAS_MID = false; static constexpr int TMID = -1;
    bf16_t* O; float* ssp;
    DI void mid(AccT&, const Unit&, int, int, int, int) const {}
    DI void operator()(const AccT& acc, const Unit& u, int wr, int wc, int fr, int fq) const {
        const int row0 = u.pm * 256 + wr * 64 + fr, col0 = u.pn * 256 + wc * 32 + 8 * fq;
#pragma unroll
        for (int ai = 0; ai < 2; ++ai)
#pragma unroll
            for (int m = 0; m < 4; ++m) {
                const int row = row0 + ai * 128 + m * 16; float ss = 0.f;
#pragma unroll
                for (int bj = 0; bj < 2; ++bj) {
                    const f32x4 v0 = acc[ai][bj][m][0], v1 = acc[ai][bj][m][1];
                    ss += (v0[0] * v0[0] + v0[1] * v0[1]) + (v0[2] * v0[2] + v0[3] * v0[3]) + (v1[0] * v1[0] + v1[1] * v1[1]) + (v1[2] * v1[2] + v1[3] * v1[3]);
                    *(u32x4*)(O + (size_t)row * 1024 + col0 + bj * 128) = pack8(v0, v1);
                }
                ssp[(size_t)(u.pn * 16 + wc * 4 + fq) * NTOK + row] = ss;
            }
    }
};
struct EpiWin {
    static constexpr bool HAS_MID = false; static constexpr int TMID = -1;
    bf16_t *U, *Q, *K, *VT, *R, *SB; const float* rs;
    DI void mid(AccT&, const Unit&, int, int, int, int) const {}
    DI void operator()(AccT& acc, const Unit& u, int wr, int wc, int fr, int fq) const {
        const int row0 = u.pm * 256 + wr * 64 + fr, pn = u.pn;
#pragma unroll
        for (int ai = 0; ai < 2; ++ai)
#pragma unroll
            for (int m = 0; m < 4; ++m) { const float rv = rs[row0 + ai * 128 + m * 16];
#pragma unroll
                for (int bj = 0; bj < 2; ++bj) { acc[ai][bj][m][0] *= rv; acc[ai][bj][m][1] *= rv; } }
        if (pn < 2) {
#pragma unroll
            for (int ai = 0; ai < 2; ++ai)
#pragma unroll
                for (int m = 0; m < 4; ++m) { const int row = row0 + ai * 128 + m * 16, bc = row >> 6, j = row & 63;
#pragma unroll
                    for (int bj = 0; bj < 2; ++bj) { const int c = pn * 256 + bj * 128 + wc * 32 + 8 * fq, gi = c >> 4, h0 = c & 15;
                        *(u32x4*)(U + ((size_t)gi * 1024 + bc) * 1152 + 128 + j * 16 + h0) = pack8(acc[ai][bj][m][0], acc[ai][bj][m][1]); } }
        } else if (pn < 6) {
            bf16_t* O = pn < 4 ? Q : K; const int cb = (pn & 1) * 256 + wc * 32 + 8 * fq;
#pragma unroll
            for (int ai = 0; ai < 2; ++ai)
#pragma unroll
                for (int m = 0; m < 4; ++m) { const int row = row0 + ai * 128 + m * 16;
#pragma unroll
                    for (int bj = 0; bj < 2; ++bj) *(u32x4*)(O + (size_t)row * 512 + cb + bj * 128) = pack8(acc[ai][bj][m][0], acc[ai][bj][m][1]); }
        } else if (pn < 8) {
#pragma unroll
            for (int ai = 0; ai < 2; ++ai)
#pragma unroll
                for (int m = 0; m < 4; ++m) { const int row = row0 + ai * 128 + m * 16, b = row >> 12, s = row & 4095;
#pragma unroll
                    for (int bj = 0; bj < 2; ++bj) { const int c = (pn - 6) * 256 + bj * 128 + wc * 32 + 8 * fq, hd = c >> 6, d0 = c & 63;
                        bf16_t* o = VT + (((size_t)b * 8 + hd) * 64 + d0) * 4096 + s;
                        const u32x4 w = pack8(acc[ai][bj][m][0], acc[ai][bj][m][1]);
                        o[0 * 4096] = (bf16_t)(w.x & 0xffff); o[1 * 4096] = (bf16_t)(w.x >> 16); o[2 * 4096] = (bf16_t)(w.y & 0xffff); o[3 * 4096] = (bf16_t)(w.y >> 16);
                        o[4 * 4096] = (bf16_t)(w.z & 0xffff); o[5 * 4096] = (bf16_t)(w.z >> 16); o[6 * 4096] = (bf16_t)(w.w & 0xffff); o[7 * 4096] = (bf16_t)(w.w >> 16); } }
        } else {
            const int cb = (pn - 8) * 128 + wc * 32 + 8 * fq;
#pragma unroll
            for (int ai = 0; ai < 2; ++ai)
#pragma unroll
                for (int m = 0; m < 4; ++m) { const int row = row0 + ai * 128 + m * 16; f32x4 r[2], sb[2];
#pragma unroll
                    for (int n = 0; n < 2; ++n)
#pragma unroll
                        for (int e = 0; e < 4; ++e) { const float sa = fsigmoid(acc[ai][0][m][n][e]), sbv = fsigmoid(acc[ai][1][m][n][e]); sb[n][e] = sbv; r[n][e] = sa * __builtin_amdgcn_rcpf(sbv); }
                    *(u32x4*)(R + (size_t)row * 1024 + cb) = pack8(r[0], r[1]);
                    *(u32x4*)(SB + (size_t)row * 1024 + cb) = pack8(sb[0], sb[1]); }
        }
    }
};
struct EpiS {
    static constexpr bool HAS_MID = false; static constexpr int TMID = -1;
    float* S;
    DI void mid(AccT&, const Unit&, int, int, int, int) const {}
    DI void operator()(const AccT& acc, const Unit& u, int wr, int wc, int fr, int fq) const {
        const int row0 = u.pm * 256 + wr * 64 + fr, col0 = wc * 32 + 8 * fq;
#pragma unroll
        for (int ai = 0; ai < 2; ++ai)
#pragma unroll
            for (int m = 0; m < 4; ++m) { float* o = S + ((size_t)u.pb * 1024 + row0 + ai * 128 + m * 16) * 128 + col0;
                *(f32x4*)o = acc[ai][0][m][0]; *(f32x4*)(o + 4) = acc[ai][0][m][1]; }
    }
};
struct EpiY {
    static constexpr bool HAS_MID = false; static constexpr int TMID = -1;
    bf16_t* YA;
    DI void mid(AccT&, const Unit&, int, int, int, int) const {}
    DI void operator()(const AccT& acc, const Unit& u, int wr, int wc, int fr, int fq) const {
        const int row0 = u.pm * 256 + wr * 64 + fr;
#pragma unroll
        for (int ai = 0; ai < 2; ++ai)
#pragma unroll
            for (int m = 0; m < 4; ++m) { const int row = row0 + ai * 128 + m * 16;
#pragma unroll
                for (int bj = 0; bj < 2; ++bj) { const int c = u.pn * 256 + bj * 128 + wc * 32 + 8 * fq, t = c >> 4, h0 = c & 15; f32x4 o[2];
#pragma unroll
                    for (int n = 0; n < 2; ++n)
#pragma unroll
                        for (int e = 0; e < 4; ++e) o[n][e] = fgelu_tanh(acc[ai][bj][m][n][e]);
                    *(u32x4*)(YA + ((size_t)row * 64 + t) * 512 + u.pb * 16 + h0) = pack8(o[0], o[1]); } }
    }
};
struct EpiMerge {
    static constexpr bool HAS_MID = true; static constexpr int TMID = 8;
    const bf16_t *R, *SB; bf16_t* O; int wave_s;
    DI void scale(AccT& acc, const Unit& u, int, int, int, int, const bf16_t* P) const {
        const int t_ = opaque_tid(wave_s), wid = __builtin_amdgcn_readfirstlane(t_ >> 6), ln = t_ & 63, wr = wid >> 2, wc = wid & 3, fr = ln & 15, fq = ln >> 4;
        const int row0 = u.pm * 256 + wr * 64 + fr, col0 = u.pn * 256 + wc * 32 + 8 * fq;
#pragma unroll
        for (int ai = 0; ai < 2; ++ai)
#pragma unroll
            for (int m = 0; m < 4; ++m)
#pragma unroll
                for (int bj = 0; bj < 2; ++bj) { const u32x4 w = *(const u32x4*)(P + (size_t)(row0 + ai * 128 + m * 16) * 1024 + col0 + bj * 128); f32x4 a, b; unpack8(w, a, b);
                    acc[ai][bj][m][0] *= a; acc[ai][bj][m][1] *= b; }
    }
    DI void mid(AccT& acc, const Unit& u, int wr, int wc, int fr, int fq) const { scale(acc, u, wr, wc, fr, fq, R); }
    DI void operator()(AccT& acc, const Unit& u, int wr, int wc, int fr, int fq) const {
        scale(acc, u, wr, wc, fr, fq, SB);
        const int row0 = u.pm * 256 + wr * 64 + fr, col0 = u.pn * 256 + wc * 32 + 8 * fq;
#pragma unroll
        for (int ai = 0; ai < 2; ++ai)
#pragma unroll
            for (int m = 0; m < 4; ++m)
#pragma unroll
                for (int bj = 0; bj < 2; ++bj) *(u32x4*)(O + (size_t)(row0 + ai * 128 + m * 16) * 1024 + col0 + bj * 128) = pack8(acc[ai][bj][m][0], acc[ai][bj][m][1]);
    }
};

struct Params { const float* in[20]; float* out; unsigned char* ws; };
enum { I_X = 0, I_GAINS, I_WGATE, I_WUP, I_WDOWN, I_WIN, I_LRE, I_LIM, I_LOGDT, I_BRE, I_BIM, I_CRE, I_CIM, I_DSKIP, I_GLUV, I_GLUG, I_OSSM, I_RELB, I_OATT, I_WO };

DI int map_row(int map, int n) {
    if (map == 0) return n;
    if (map == 1) return 256 * (n >> 7) + (n & 127);
    if (map == 2) return 256 * (n >> 7) + 128 + (n & 127);
    if (n < 2048) return n;
    if (n < 3072) { const int j = n - 2048; return 2048 + 256 * (j >> 7) + (j & 127); }
    const int j = n - 3072; return 2048 + 256 * (j >> 7) + 128 + (j & 127);
}
DI void cvt_item(const float* W, int K, int N, bf16_t* WT, int ldk, int koff, int map, LAS float* scr, int item, int lane, const float* gk = nullptr) {
    const int nblk = N / 32, kb = item / nblk, nb = item % nblk, k0 = 64 * kb, n0 = 32 * nb;
    const float sc = (map == 3 && n0 >= 512 && n0 < 1024) ? 0.125f * 1.4426950408889634f : 1.f;
    { const int kq = lane >> 3, n4 = (lane & 7) * 4;
      f32x4 wv[8];
#pragma unroll
      for (int i = 0; i < 8; ++i) wv[i] = *(const f32x4*)(W + (size_t)(k0 + i * 8 + kq) * N + n0 + n4);
#pragma unroll
      for (int i = 0; i < 8; ++i) { const int kk = i * 8 + kq; const float m = gk ? sc * gk[k0 + kk] : sc;
          scr[kk * 33 + n4] = wv[i][0] * m; scr[kk * 33 + n4 + 1] = wv[i][1] * m; scr[kk * 33 + n4 + 2] = wv[i][2] * m; scr[kk * 33 + n4 + 3] = wv[i][3] * m; } }
    asm volatile("s_waitcnt lgkmcnt(0)" ::: "memory");
    const int c = lane & 7;
#pragma unroll
    for (int j = 0; j < 4; ++j) { const int n = (lane >> 3) + 8 * j; const LAS float* s = scr + (8 * c) * 33 + n;
        u32x4 o; o.x = pk2(s[0 * 33], s[1 * 33]); o.y = pk2(s[2 * 33], s[3 * 33]); o.z = pk2(s[4 * 33], s[5 * 33]); o.w = pk2(s[6 * 33], s[7 * 33]);
        *(u32x4*)(WT + (size_t)map_row(map, n0 + n) * ldk + koff + k0 + 8 * c) = o; }
    asm volatile("s_waitcnt lgkmcnt(0)" ::: "memory");
}
DI void cvt_matrix(const float* W, int K, int N, bf16_t* WT, int ldk, int koff, int map, LAS float* scr, int gw, int NGW, int lane) {
    const int nitems = (K / 64) * (N / 32);
    for (int it = gw; it < nitems; it += NGW) cvt_item(W, K, N, WT, ldk, koff, map, scr, it, lane);
}

DI void s5_tables(const Params& P, LAS unsigned char* lds, int lg) {
    LAS float* pw = (LAS float*)lds;
    LAS float* bb = pw + 65 * 64 * 2;
    LAS float* cc = bb + 64 * 16 * 2;
    LAS float* ff = cc + 16 * 64 * 2;
    const int tid = threadIdx.x;
    unsigned char* ws = P.ws;
    float* gPW = (float*)(ws + OFF_PW + (size_t)lg * SZ_PW1);
    float* gBB = (float*)(ws + OFF_BB + (size_t)lg * SZ_BB1);
    float* gKE = (float*)(ws + OFF_KERN + (size_t)lg * SZ_KE1);
    const double dt = exp((double)P.in[I_LOGDT][lg]);
    const float* lre = P.in[I_LRE] + (size_t)lg * 64; const float* lim = P.in[I_LIM] + (size_t)lg * 64;
    for (int idx = tid; idx < 65 * 64; idx += NTHREADS) {
        const int tau = idx >> 6, p = idx & 63;
        const double lr = lre[p], li = lim[p];
        const float mag = __expf((float)(lr * dt * tau));
        double rev = li * dt * tau * 0.15915494309189535; rev -= rint(rev);
        const float cs = __builtin_amdgcn_cosf((float)rev), sn = __builtin_amdgcn_sinf((float)rev);
        const float re = mag * cs, im = mag * sn;
        pw[idx * 2] = re; pw[idx * 2 + 1] = im; gPW[idx * 2] = re; gPW[idx * 2 + 1] = im;
        if (tau == 1) {
            const double nr = (double)re - 1.0, ni = im, den = lr * lr + li * li;
            ff[p * 2] = (float)((nr * lr + ni * li) / den); ff[p * 2 + 1] = (float)((ni * lr - nr * li) / den);
        }
    }
    __syncthreads();
    const float* bre = P.in[I_BRE] + (size_t)lg * 1024; const float* bim = P.in[I_BIM] + (size_t)lg * 1024;
    const float* cre = P.in[I_CRE] + (size_t)lg * 1024; const float* cim = P.in[I_CIM] + (size_t)lg * 1024;
    for (int idx = tid; idx < 1024; idx += NTHREADS) {
        const int p = idx >> 4;
        const float fr_ = ff[p * 2], fi_ = ff[p * 2 + 1], br = bre[idx], bi = bim[idx];
        const float re = fr_ * br - fi_ * bi, im = fr_ * bi + fi_ * br;
        bb[idx * 2] = re; bb[idx * 2 + 1] = im; gBB[idx * 2] = re; gBB[idx * 2 + 1] = im;
        cc[idx * 2] = cre[idx]; cc[idx * 2 + 1] = cim[idx];
    }
    __syncthreads();
    const float* dsk = P.in[I_DSKIP] + (size_t)lg * 16;
    for (int pair = tid; pair < 1024; pair += NTHREADS) {
        const int tau = pair >> 4, h = pair & 15;
        float a[16];
#pragma unroll
        for (int j = 0; j < 16; ++j) a[j] = 0.f;
        for (int p = 0; p < 64; ++p) {
            const float cr = cc[(h * 64 + p) * 2], ci = cc[(h * 64 + p) * 2 + 1], pr = pw[(tau * 64 + p) * 2], pi = pw[(tau * 64 + p) * 2 + 1];
            const float xr = cr * pr - ci * pi, xi = cr * pi + ci * pr;
#pragma unroll
            for (int j = 0; j < 16; ++j) a[j] += xr * bb[(p * 16 + j) * 2] - xi * bb[(p * 16 + j) * 2 + 1];
        }
        const float dv = dsk[h];
#pragma unroll
        for (int j = 0; j < 16; ++j) gKE[(size_t)pair * 16 + j] = a[j] + ((tau == 0 && j == h) ? dv : 0.f);
    }
    __syncthreads();
}

DI void build_w12(const Params& P, int l, int wave_s) {
    unsigned char* ws = P.ws;
    const float* gPW = (const float*)(ws + OFF_PW) + (size_t)l * 32 * (65 * 64 * 2);
    const float* gBB = (const float*)(ws + OFF_BB) + (size_t)l * 32 * (64 * 16 * 2);
    const float* gKE = (const float*)(ws + OFF_KERN) + (size_t)l * 32 * (64 * 256);
    bf16_t* W1 = (bf16_t*)(ws + OFF_W1); bf16_t* W2 = (bf16_t*)(ws + OFF_W2);
    const int gt = blockIdx.x * NTHREADS + opaque_tid(wave_s), NT = gridDim.x * NTHREADS;
    for (int it = gt; it < 32 * 256 * 128; it += NT) {
        const int kk = it & 127, n = (it >> 7) & 255, g = it >> 15;
        float v[8];
        if (n >= 128) {
#pragma unroll
            for (int e = 0; e < 8; ++e) v[e] = 0.f;
        } else {
            const int p = n & 63, im = n >> 6, j = kk >> 1, h0 = (kk & 1) * 8;
            const float* pwp = gPW + ((size_t)g * 65 + (63 - j)) * 128 + p * 2; const float pr = pwp[0], pi = pwp[1];
            const float* bp = gBB + ((size_t)g * 64 + p) * 32 + h0 * 2;
#pragma unroll
            for (int e = 0; e < 8; ++e) { const float br = bp[e * 2], bi = bp[e * 2 + 1]; v[e] = im ? (pr * bi + pi * br) : (pr * br - pi * bi); }
        }
        u32x4 o; o.x = pk2(v[0], v[1]); o.y = pk2(v[2], v[3]); o.z = pk2(v[4], v[5]); o.w = pk2(v[6], v[7]);
        *(u32x4*)(W1 + (size_t)it * 8) = o;
    }
    const float* cre = P.in[I_CRE] + (size_t)l * 32 * 1024; const float* cim = P.in[I_CIM] + (size_t)l * 32 * 1024;
    for (int it = gt; it < 32 * 1024 * 144; it += NT) {
        const int kk = it % 144, n = (it / 144) & 1023, g = it / (144 * 1024), t = n >> 4, h = n & 15;
        float v[8];
        if (kk < 16) {
            const int im = kk >> 3, p0 = (kk & 7) * 8;
            const float* pwp = gPW + ((size_t)g * 65 + (t + 1)) * 128 + p0 * 2;
            const float* crp = cre + ((size_t)g * 16 + h) * 64 + p0; const float* cip = cim + ((size_t)g * 16 + h) * 64 + p0;
#pragma unroll
            for (int e = 0; e < 8; ++e) { const float cr = crp[e], ci = cip[e], pr = pwp[e * 2], pi = pwp[e * 2 + 1]; v[e] = im ? -(cr * pi + ci * pr) : (cr * pr - ci * pi); }
        } else {
            const int j = (kk - 16) >> 1, h0 = ((kk - 16) & 1) * 8;
            if (j <= t) { const float* kp = gKE + (((size_t)g * 64 + (t - j)) * 16 + h) * 16 + h0;
#pragma unroll
                for (int e = 0; e < 8; ++e) v[e] = kp[e];
            } else {
#pragma unroll
                for (int e = 0; e < 8; ++e) v[e] = 0.f;
            }
        }
        u32x4 o; o.x = pk2(v[0], v[1]); o.y = pk2(v[2], v[3]); o.z = pk2(v[4], v[5]); o.w = pk2(v[6], v[7]);
        *(u32x4*)(W2 + (size_t)it * 8) = o;
    }
}

DI void ew_rows(unsigned char* ws, float* outp, const float* xin, bool first, bool last, float coef, const float* gpost, int rbeg, int rend, int lane) {
    const bf16_t* M1 = (const bf16_t*)(ws + OFF_M1); const float* ssp = (const float*)(ws + OFF_SSP); bf16_t* XB = (bf16_t*)(ws + OFF_XN); float* RS = (float*)(ws + OFF_RS);
    for (int r0 = rbeg; r0 < rend; r0 += 4) {
        f32x4 ssv = {0.f, 0.f, 0.f, 0.f};
        u32x2 xr[4][4], mr[4][4]; f32x4 xf[4][4];
        if (first) {
#pragma unroll
            for (int q = 0; q < 4; ++q)
#pragma unroll
                for (int j = 0; j < 4; ++j) xf[q][j] = *(const f32x4*)(xin + (size_t)(r0 + q) * 1024 + j * 256 + lane * 4);
        } else {
            ssv = *(const f32x4*)(ssp + (size_t)lane * NTOK + r0);
#pragma unroll
            for (int q = 0; q < 4; ++q)
#pragma unroll
                for (int j = 0; j < 4; ++j) { xr[q][j] = *(const u32x2*)(XB + (size_t)(r0 + q) * 1024 + j * 256 + lane * 4); mr[q][j] = *(const u32x2*)(M1 + (size_t)(r0 + q) * 1024 + j * 256 + lane * 4); }
        }
#pragma unroll
        for (int q = 0; q < 4; ++q) {
            const int row = r0 + q;
            f32x4 v[4];
            if (first) {
#pragma unroll
                for (int j = 0; j < 4; ++j) v[j] = xf[q][j];
            } else {
                const float rstd = __builtin_amdgcn_rsqf(wave_sum(ssv[q], lane) * (1.f / 1024.f) + RMS_EPS) * coef;
#pragma unroll
                for (int j = 0; j < 4; ++j) {
                    const u32x2 xw = xr[q][j], w = mr[q][j];
                    const f32x4 gp = *(const f32x4*)(gpost + j * 256 + lane * 4);
                    const f32x4 xv = {bflo(xw.x), bfhi(xw.x), bflo(xw.y), bfhi(xw.y)};
                    const f32x4 mv = {bflo(w.x), bfhi(w.x), bflo(w.y), bfhi(w.y)};
                    v[j] = xv + gp * mv * rstd;
                }
            }
            if (last) {
#pragma unroll
                for (int j = 0; j < 4; ++j) *(f32x4*)(outp + (size_t)row * 1024 + j * 256 + lane * 4) = v[j];
            } else {
                float ss = 0.f;
#pragma unroll
                for (int j = 0; j < 4; ++j) ss += (v[j][0] * v[j][0] + v[j][1] * v[j][1]) + (v[j][2] * v[j][2] + v[j][3] * v[j][3]);
                const float rstd2 = __builtin_amdgcn_rsqf(wave_sum(ss, lane) * (1.f / 1024.f) + RMS_EPS);
                if (lane == 0) RS[row] = rstd2;
#pragma unroll
                for (int j = 0; j < 4; ++j) { u32x2 w; w.x = pk2(v[j][0], v[j][1]); w.y = pk2(v[j][2], v[j][3]);
                    *(u32x2*)(XB + (size_t)row * 1024 + j * 256 + lane * 4) = w; }
            }
        }
    }
}
DI void ew_phase(const Params& P, bool first, bool last, float coef, const float* gpost, int wave_s) {
    const int tid_ = opaque_tid(wave_s), lane = tid_ & 63, wave = __builtin_amdgcn_readfirstlane(tid_ >> 6);
    const int gw = blockIdx.x * NWAVES + wave, NGW = gridDim.x * NWAVES;
    const int rpw = (NTOK / 4 + NGW - 1) / NGW * 4;
    const int rbeg = gw * rpw, rend = (rbeg + rpw) < NTOK ? (rbeg + rpw) : NTOK;
    ew_rows(P.ws, P.out, P.in[I_X], first, last, coef, gpost, rbeg, rend, lane);
}

DI void carry_phase(const Params& P, int l, int wave_s) {
    const int tid_ = opaque_tid(wave_s), lane = tid_ & 63, wave = __builtin_amdgcn_readfirstlane(tid_ >> 6);
    unsigned char* ws = P.ws;
    const float* gPW = (const float*)(ws + OFF_PW) + (size_t)l * 32 * (65 * 64 * 2);
    const float* S = (const float*)(ws + OFF_S); bf16_t* U = (bf16_t*)(ws + OFF_U);
    const int gw = blockIdx.x * NWAVES + wave, NGW = gridDim.x * NWAVES;
    for (int task = gw; task < 512; task += NGW) {
        const int g = task >> 4, b = task & 15, p = lane;
        const float ar = gPW[((size_t)g * 65 + 64) * 128 + p * 2], ai = gPW[((size_t)g * 65 + 64) * 128 + p * 2 + 1];
        float xr = 0.f, xi = 0.f;
        const float* sp = S + ((size_t)g * 1024 + b * 64) * 128; bf16_t* up = U + ((size_t)g * 1024 + b * 64) * 1152;
#pragma unroll 8
        for (int c = 0; c < 64; ++c) {
            up[(size_t)c * 1152 + p] = (bf16_t)(pk2(xr, 0.f) & 0xffff); up[(size_t)c * 1152 + 64 + p] = (bf16_t)(pk2(xi, 0.f) & 0xffff);
            const float sr = sp[c * 128 + p], si = sp[c * 128 + 64 + p];
            const float nr = ar * xr - ai * xi + sr, ni = ar * xi + ai * xr + si;
            xr = nr; xi = ni;
        }
    }
}

DI int crow(int reg, int h) { return (reg & 3) + 8 * (reg >> 2) + 4 * h; }
#define MFMA32(a, b, c) __builtin_amdgcn_mfma_f32_32x32x16_bf16((a), (b), (c), 0, 0, 0)
DI bf16x8 pack_step(const f32x16& x, int s) {
    u32x4 p; p.x = pk2(x[8 * s], x[8 * s + 1]); p.y = pk2(x[8 * s + 2], x[8 * s + 3]); p.z = pk2(x[8 * s + 4], x[8 * s + 5]); p.w = pk2(x[8 * s + 6], x[8 * s + 7]);
    return __builtin_bit_cast(bf16x8, p);
}
#define ATTN_STEP(KT, BUF, KREG, VREG) \
            { LAS unsigned char* kb = kbuf + BUF * 9216; LAS unsigned char* vb = vbuf + BUF * 8704; \
            *(LAS u32x4*)(kb + lr * 144 + lsg * 16) = KREG; \
            { u32x2 a; a.x = VREG.x; a.y = VREG.y; u32x2 c; c.x = VREG.z; c.y = VREG.w; \
              *(LAS u32x2*)(vb + lr * 136 + lsg * 16) = a; *(LAS u32x2*)(vb + lr * 136 + lsg * 16 + 8) = c; } \
            __syncthreads(); \
            if (KT + 2 <= kthi) { KREG = *(const u32x4*)(kgp + (size_t)(KT + 2) * 64 * 512); VREG = *(const u32x4*)(vgp + (KT + 2) * 64); } \
            if (KT + 8 >= cc && KT <= cc) { \
                f32x16 s0, s1; \
_Pragma("unroll") \
                for (int i = 0; i < 16; ++i) { s0[i] = 0.f; s1[i] = 0.f; } \
_Pragma("unroll") \
                for (int ks = 0; ks < 4; ++ks) { \
                    const bf16x8 k0 = *(const LAS bf16x8*)(kb + n * 144 + ks * 32 + gq * 16), k1 = *(const LAS bf16x8*)(kb + (32 + n) * 144 + ks * 32 + gq * 16); \
                    s0 = MFMA32(k0, Qf[ks], s0); s1 = MFMA32(k1, Qf[ks], s1); \
                } \
                const int delta = cc - (KT); \
                if (delta < 3) { const int base = 64 * delta + qh * 32 + n + 128; \
_Pragma("unroll") \
                    for (int i = 0; i < 16; ++i) { const int key = crow(i, gq); int i0 = base - key, i1 = base - key - 32; \
                        i0 = i0 > 256 ? 256 : i0; i1 = i1 > 256 ? 256 : i1; i0 = i0 < 0 ? 0 : i0; i1 = i1 < 0 ? 0 : i1; \
                        s0[i] += bth[i0]; s1[i] += bth[i1]; } \
                } \
                float mx = s0[0]; \
_Pragma("unroll") \
                for (int i = 1; i < 16; ++i) mx = fmaxf(mx, s0[i]); \
_Pragma("unroll") \
                for (int i = 0; i < 16; ++i) mx = fmaxf(mx, s1[i]); \
                mx = fmaxf(mx, shx(mx, lane, 32)); \
                const float mnew = fmaxf(mrun, mx), alpha = __builtin_amdgcn_exp2f(mrun - mnew); mrun = mnew; \
                float ps = 0.f; \
_Pragma("unroll") \
                for (int i = 0; i < 16; ++i) { s0[i] = __builtin_amdgcn_exp2f(s0[i] - mnew); s1[i] = __builtin_amdgcn_exp2f(s1[i] - mnew); ps += s0[i] + s1[i]; } \
                lrun = lrun * alpha + ps; \
_Pragma("unroll") \
                for (int i = 0; i < 16; ++i) { O0[i] *= alpha; O1[i] *= alpha; } \
_Pragma("unroll") \
                for (int kg = 0; kg < 2; ++kg) \
_Pragma("unroll") \
                    for (int s = 0; s < 2; ++s) { \
                        const bf16x8 Pf = pack_step(kg == 0 ? s0 : s1, s); \
                        const LAS unsigned char* v0 = vb + n * 136 + 64 * kg + 32 * s + 8 * gq; \
                        const s16x4 lo0 = *(const LAS s16x4*)(v0), hi0 = *(const LAS s16x4*)(v0 + 16); \
                        const s16x4 lo1 = *(const LAS s16x4*)(v0 + 32 * 136), hi1 = *(const LAS s16x4*)(v0 + 32 * 136 + 16); \
                        const bf16x8 V0 = __builtin_shufflevector(lo0, hi0, 0, 1, 2, 3, 4, 5, 6, 7), V1 = __builtin_shufflevector(lo1, hi1, 0, 1, 2, 3, 4, 5, 6, 7); \
                        O0 = MFMA32(V0, Pf, O0); O1 = MFMA32(V1, Pf, O1); \
                    } \
            } }
DI void attn_phase(const Params& P, int l, LAS unsigned char* lds, int wave_s) {
    const int tid_ = opaque_tid(wave_s), lane = tid_ & 63, wave = __builtin_amdgcn_readfirstlane(tid_ >> 6);
    unsigned char* ws = P.ws;
    const bf16_t* Q = (const bf16_t*)(ws + OFF_Q); const bf16_t* K = (const bf16_t*)(ws + OFF_K); const bf16_t* VT = (const bf16_t*)(ws + OFF_VT);
    bf16_t* ZA = (bf16_t*)P.out;
    LAS float* bt = (LAS float*)lds;
    LAS unsigned char* kbuf = lds + 8448;
    LAS unsigned char* vbuf = kbuf + 2 * 9216;
    const float* relb = P.in[I_RELB] + (size_t)l * 8 * 257;
    for (int i = tid_; i < 8 * 257; i += NTHREADS) bt[i] = (relb[i] - relb[(i / 257) * 257 + 256]) * 1.4426950408889634f;
    __syncthreads();
    const int n = lane & 31, gq = lane >> 5;
    const int ci = wave >> 1, qh = wave & 1;
    const int lr = tid_ >> 3, lsg = tid_ & 7;
    for (int it = blockIdx.x; it < 2048; it += gridDim.x) {
        const int y = it >> 4, cg4 = ((it & 15) + (it >> 8)) & 15, hd = y & 7, b = y >> 3;
        const int c0 = cg4 * 4, cc = c0 + ci;
        const int ktlo = c0 > 8 ? c0 - 8 : 0, kthi = c0 + 3;
        const size_t tok0 = (size_t)b * SEQ + cc * 64 + qh * 32;
        bf16x8 Qf[4];
        { const bf16_t* qp = Q + (tok0 + n) * 512 + hd * 64 + gq * 8;
#pragma unroll
          for (int ks = 0; ks < 4; ++ks) Qf[ks] = *(const bf16x8*)(qp + ks * 16); }
        f32x16 O0, O1;
#pragma unroll
        for (int i = 0; i < 16; ++i) { O0[i] = 0.f; O1[i] = 0.f; }
        float mrun = -1e30f, lrun = 0.f;
        const LAS float* bth = bt + hd * 257;
        const bf16_t* kgp = K + ((size_t)b * SEQ + lr) * 512 + hd * 64 + lsg * 8;
        const bf16_t* vgp = VT + (((size_t)b * 8 + hd) * 64 + lr) * SEQ + lsg * 8;
        u32x4 kregA = *(const u32x4*)(kgp + (size_t)ktlo * 64 * 512), vregA = *(const u32x4*)(vgp + ktlo * 64);
        u32x4 kregB = *(const u32x4*)(kgp + (size_t)(ktlo + 1) * 64 * 512), vregB = *(const u32x4*)(vgp + (ktlo + 1) * 64);
        for (int kt = ktlo; kt <= kthi; kt += 2) {
            ATTN_STEP(kt, 0, kregA, vregA)
            ATTN_STEP(kt + 1, 1, kregB, vregB)
        }
        lrun += shx(lrun, lane, 32);
        const float inv = 1.f / lrun;
        bf16_t* op = ZA + (tok0 + n) * 1024 + 512 + hd * 64 + gq * 4;
#pragma unroll
        for (int g4 = 0; g4 < 4; ++g4) {
            u32x2 w0, w1;
            w0.x = pk2(O0[4 * g4] * inv, O0[4 * g4 + 1] * inv); w0.y = pk2(O0[4 * g4 + 2] * inv, O0[4 * g4 + 3] * inv);
            w1.x = pk2(O1[4 * g4] * inv, O1[4 * g4 + 1] * inv); w1.y = pk2(O1[4 * g4 + 2] * inv, O1[4 * g4 + 3] * inv);
            *(u32x2*)(op + 8 * g4) = w0; *(u32x2*)(op + 32 + 8 * g4) = w1;
        }
        __syncthreads();
    }
}

__global__ void __launch_bounds__(NTHREADS, 2) mk_fwd(Params P) {
    extern __shared__ __attribute__((aligned(16))) unsigned char lds_raw[];
    LAS unsigned char* lds = (LAS unsigned char*)lds_raw;
    cg::grid_group grid = cg::this_grid();
    const int tid = threadIdx.x, lane = tid & 63, wave = __builtin_amdgcn_readfirstlane(tid >> 6);
    const int G = gridDim.x, bx = blockIdx.x;
    unsigned char* ws = P.ws;
    const int gw = bx * NWAVES + wave, NGW = G * NWAVES;
    volatile LAS unsigned* xst = (volatile LAS unsigned*)(lds + LDS_MAIN);
    if (tid == 0) { xst[0] = 0u; xst[1] = 0u; }
    __syncthreads();
    XcdBarrier xbar; xbar.bar = (unsigned*)(ws + OFF_BAR); xbar.x = xb_xcc_id(); xbar.st = xst;
    if (tid == 0) (void)xb_add(&xbar.bar[XB_XCNT(xbar.x)], 1u);

    {
        _Pragma("unroll 1") for (int rp_ = 0; rp_ < REP_PRO; ++rp_) {
        for (int lg = bx; lg < 128; lg += G) s5_tables(P, lds, lg);
        __syncthreads();
        LAS float* scr = (LAS float*)(lds + wave * 8704);
        for (int it = gw; it < 4 * 11776; it += NGW) {
            const int l = it / 11776; int r = it - l * 11776;
            if (r < 6 * 1408) {
                const int which = r / 1408, f = which & 1, kind = which >> 1; r -= which * 1408;
                bf16_t* wgu = (bf16_t*)(ws + OFF_WGU + (size_t)(l * 2 + f) * SZ_WGU);
                const float* gk = P.in[I_GAINS] + (size_t)(l * 6 + 4 * f) * 1024;
                if (kind == 0) cvt_item(P.in[I_WGATE] + (size_t)(l * 2 + f) * 1024 * 2816, 1024, 2816, wgu, 1024, 0, 1, scr, r, lane, gk);
                else if (kind == 1) cvt_item(P.in[I_WUP] + (size_t)(l * 2 + f) * 1024 * 2816, 1024, 2816, wgu, 1024, 0, 2, scr, r, lane, gk);
                else cvt_item(P.in[I_WDOWN] + (size_t)(l * 2 + f) * 2816 * 1024, 2816, 1024, (bf16_t*)(ws + OFF_WD + (size_t)(l * 2 + f) * SZ_WD), 2816, 0, 0, scr, r, lane);
                continue;
            }
            r -= 6 * 1408;
            if (r < 2048) { cvt_item(P.in[I_WIN] + (size_t)l * 1024 * 4096, 1024, 4096, (bf16_t*)(ws + OFF_WIN + (size_t)l * SZ_WIN), 1024, 0, 3, scr, r, lane, P.in[I_GAINS] + (size_t)(l * 6 + 2) * 1024); continue; }
            r -= 2048;
            if (r < 256) { const int gsel = r >> 7; r &= 127;
                cvt_item(P.in[gsel ? I_GLUG : I_GLUV] + (size_t)l * 512 * 512, 512, 512, (bf16_t*)(ws + OFF_WGL + (size_t)l * SZ_WGL), 512, 0, 1 + gsel, scr, r, lane); continue; }
            r -= 256;
            if (r < 512) { const int osel = r >> 8; r &= 255;
                cvt_item(P.in[osel ? I_OATT : I_OSSM] + (size_t)l * 512 * 1024, 512, 1024, (bf16_t*)(ws + OFF_WOUT + (size_t)l * SZ_WOUT), 1024, osel * 512, 0, scr, r, lane); continue; }
            r -= 512;
            cvt_item(P.in[I_WO] + (size_t)l * 1024 * 1024, 1024, 1024, (bf16_t*)(ws + OFF_WO + (size_t)l * SZ_WO), 1024, 0, 0, scr, r, lane);
        }
        __syncthreads();
        }
        ew_phase(P, true, false, 0.f, nullptr, wave);
        __syncthreads();
    }
    grid.sync();

    for (int step = 0; step < 12; ++step) {
        const int l = step / 3, s = step % 3;
        unsigned char* ws = P.ws; asm volatile("" : "+s"(ws));
        pg8::Gemm gfin;
        if (s != 1) {
            const int f = s >> 1;
            pg8::Gemm g{(const char*)(ws + OFF_XN), (const char*)(ws + OFF_WGU + (size_t)(l * 2 + f) * SZ_WGU), 1024, 1024, (size_t)256 * 1024 * 2, 0, (size_t)256 * 1024 * 2, 0, 16, 0};
            pg8::Order S; S.init(256, 22, 1, 0, G, bx);
            EpiGated<0> E{(bf16_t*)(ws + OFF_H), 2816, (const float*)(ws + OFF_RS)};
            _Pragma("unroll 1") for (int rep_ = 0; rep_ < REP_GEMM; ++rep_) pg8::gemm_phase(lds, g, S, E, wave);
            GSYNC();
            gfin = pg8::Gemm{(const char*)(ws + OFF_H), (const char*)(ws + OFF_WD + (size_t)(l * 2 + f) * SZ_WD), 2816, 2816, (size_t)256 * 2816 * 2, 0, (size_t)256 * 2816 * 2, 0, 44, 0};
        } else {
            {
                pg8::Gemm g{(const char*)(ws + OFF_XN), (const char*)(ws + OFF_WIN + (size_t)l * SZ_WIN), 1024, 1024, (size_t)256 * 1024 * 2, 0, (size_t)256 * 1024 * 2, 0, 16, 0};
                pg8::Order S; S.init(256, 16, 1, 0, G, bx);
                EpiWin E{(bf16_t*)(ws + OFF_U), (bf16_t*)(ws + OFF_Q), (bf16_t*)(ws + OFF_K), (bf16_t*)(ws + OFF_VT), (bf16_t*)(ws + OFF_M1), (bf16_t*)(ws + OFF_SB), (const float*)(ws + OFF_RS)};
                _Pragma("unroll 1") for (int rep_ = 0; rep_ < REP_GEMM; ++rep_) pg8::gemm_phase(lds, g, S, E, wave);
            }
            GSYNC();
            {
                pg8::Gemm g{(const char*)(ws + OFF_U) + 256, (const char*)(ws + OFF_W1), 1152, 1024, (size_t)256 * 1152 * 2, (size_t)1024 * 1152 * 2, 0, (size_t)256 * 1024 * 2, 16, 0};
                pg8::Order S; S.init(4, 1, 32, 1, G, bx);
                EpiS E{(float*)(ws + OFF_S)};
                _Pragma("unroll 1") for (int rep_ = 0; rep_ < REP_GEMM; ++rep_) pg8::gemm_phase(lds, g, S, E, wave);
                __syncthreads();
                _Pragma("unroll 1") for (int rep_ = 0; rep_ < REP_ATTN; ++rep_) attn_phase(P, l, lds, wave);
            }
            GSYNC();
            _Pragma("unroll 1") for (int rc_ = 0; rc_ < REP_CARRY; ++rc_) carry_phase(P, l, wave);
            GSYNC();
            {
                pg8::Gemm g{(const char*)(ws + OFF_U), (const char*)(ws + OFF_W2), 1152, 1152, (size_t)256 * 1152 * 2, (size_t)1024 * 1152 * 2, (size_t)256 * 1152 * 2, (size_t)1024 * 1152 * 2, 6, 4};
                pg8::Order S; S.init(4, 4, 32, 2, G, bx);
                EpiY E{(bf16_t*)(ws + OFF_Q)};
                _Pragma("unroll 1") for (int rep_ = 0; rep_ < REP_GEMM; ++rep_) pg8::gemm_phase(lds, g, S, E, wave);
            }
            GSYNC();
            {
                pg8::Gemm g{(const char*)(ws + OFF_Q), (const char*)(ws + OFF_WGL + (size_t)l * SZ_WGL), 512, 512, (size_t)256 * 512 * 2, 0, (size_t)256 * 512 * 2, 0, 8, 0};
                pg8::Order S; S.init(256, 4, 1, 0, G, bx);
                EpiGated<1> E{(bf16_t*)P.out, 1024, nullptr};
                _Pragma("unroll 1") for (int rep_ = 0; rep_ < REP_GEMM; ++rep_) pg8::gemm_phase(lds, g, S, E, wave);
            }
            GSYNC();
            {
                pg8::Gemm g{(const char*)P.out, (const char*)(ws + OFF_WOUT + (size_t)l * SZ_WOUT), 1024, 1024, (size_t)256 * 1024 * 2, 0, (size_t)256 * 1024 * 2, 0, 16, 0};
                pg8::Order S; S.init(256, 4, 1, 0, G, bx);
                EpiMerge E{(const bf16_t*)(ws + OFF_M1), (const bf16_t*)(ws + OFF_SB), (bf16_t*)(ws + OFF_K), wave};
                _Pragma("unroll 1") for (int rep_ = 0; rep_ < REP_GEMM; ++rep_) pg8::gemm_phase(lds, g, S, E, wave);
            }
            GSYNC();
            gfin = pg8::Gemm{(const char*)(ws + OFF_K), (const char*)(ws + OFF_WO + (size_t)l * SZ_WO), 1024, 1024, (size_t)256 * 1024 * 2, 0, (size_t)256 * 1024 * 2, 0, 16, 0};
        }
        {
            pg8::Order S; S.init(256, 4, 1, 0, G, bx);
            EpiDown E{(bf16_t*)(ws + OFF_M1), (float*)(ws + OFF_SSP)};
            _Pragma("unroll 1") for (int rep_ = 0; rep_ < REP_GEMM; ++rep_) pg8::gemm_phase(lds, gfin, S, E, wave);
        }
        GSYNC();
        {
            const float* gains = P.in[I_GAINS];
            ew_phase(P, false, step == 11, s == 1 ? 1.f : 0.5f, gains + (size_t)(2 * step + 1) * 1024, wave);
            if (s == 0) { _Pragma("unroll 1") for (int rb_ = 0; rb_ < REP_BUILD; ++rb_) build_w12(P, l, wave); }
        }
        if (step != 11) GSYNC();
    }
}

extern "C" void kernel_launch(void* const* d_in, const int* in_sizes, int n_in, void* d_out, int out_size, void* d_ws, size_t ws_size, hipStream_t stream) {
    static int grid = 0;
    if (grid == 0) {
        if (n_in != 20 || out_size != NTOK * DM || ws_size < WS_END) { fprintf(stderr, "kernel_launch: unexpected shapes: n_in %d out %d ws %zu (need %zu)\n", n_in, out_size, ws_size, (size_t)WS_END); grid = -1; return; }
        int dev = 0, cus = 0, per_cu = 0;
        hipGetDevice(&dev);
        hipDeviceGetAttribute(&cus, hipDeviceAttributeMultiprocessorCount, dev);
        if (hipFuncSetAttribute((const void*)mk_fwd, hipFuncAttributeMaxDynamicSharedMemorySize, LDS_BYTES) != hipSuccess) { fprintf(stderr, "kernel_launch: hipFuncSetAttribute failed\n"); grid = -1; return; }
        if (hipOccupancyMaxActiveBlocksPerMultiprocessor(&per_cu, (const void*)mk_fwd, NTHREADS, LDS_BYTES) != hipSuccess || per_cu < 1) { fprintf(stderr, "kernel_launch: occupancy query failed (%d)\n", per_cu); per_cu = 1; }
        (void)hipGetLastError();
        grid = cus * per_cu;
    }
    if (grid < 0) return;
    if (hipMemsetAsync((char*)d_ws + OFF_BAR, 0, BAR_BYTES, stream) != hipSuccess) { fprintf(stderr, "kernel_launch: memset failed\n"); return; }
    Params p{};
    for (int i = 0; i < 20; ++i) p.in[i] = (const float*)d_in[i];
    p.out = (float*)d_out; p.ws = (unsigned char*)d_ws;
    void* args[] = {&p};
    hipError_t e = hipLaunchCooperativeKernel((const void*)mk_fwd, dim3(grid), dim3(NTHREADS), args, LDS_BYTES, stream);
    if (e != hipSuccess) fprintf(stderr, "cooperative launch failed: %s (grid %d)\n", hipGetErrorString(e), grid);
}
```

```cpp
#include <hip/hip_runtime.h>
#include <hip/hip_cooperative_groups.h>
#include <cstdio>
#include <cstdint>
namespace cg = cooperative_groups;

#define LAS __attribute__((address_space(3)))
#define GAS __attribute__((address_space(1)))
typedef unsigned short bf16_t;
typedef short bf16x8 __attribute__((ext_vector_type(8)));
typedef short s16x4 __attribute__((ext_vector_type(4)));
typedef float f32x4 __attribute__((ext_vector_type(4)));
typedef float f32x2 __attribute__((ext_vector_type(2)));
typedef float f32x16 __attribute__((ext_vector_type(16)));
typedef unsigned u32x4 __attribute__((ext_vector_type(4)));
typedef unsigned u32x2 __attribute__((ext_vector_type(2)));
typedef __bf16 bf2_t __attribute__((ext_vector_type(2)));
#define DI __device__ __forceinline__

constexpr int NTOK = 65536, DM = 1024, FF = 2816, NL = 4, NGRP = 32, SEQ = 4096;
constexpr float RMS_EPS = 1e-6f;
constexpr int NTHREADS = 512, NWAVES = 8;
constexpr int LDS_MAIN = 131072, LDS_BYTES = LDS_MAIN + 16;
#ifndef REP_GEMM
#define REP_GEMM 1
#endif
#ifndef REP_SYNC
#define REP_SYNC 1
#endif
#ifndef REP_EW
#define REP_EW 0
#endif
#ifndef REP_PRO
#define REP_PRO 1
#endif
#ifndef REP_CARRY
#define REP_CARRY 1
#endif
#ifndef REP_BUILD
#define REP_BUILD 1
#endif
#define GSYNC() do { _Pragma("unroll 1") for (int rs_ = 0; rs_ < REP_SYNC; ++rs_) xcd_barrier(xbar, wave); } while (0)
#ifndef REP_ATTN
#define REP_ATTN 1
#endif

constexpr size_t SZ_WGU = (size_t)5632 * 1024 * 2, SZ_WD = (size_t)1024 * 2816 * 2, SZ_WIN = (size_t)4096 * 1024 * 2;
constexpr size_t SZ_WGL = (size_t)1024 * 512 * 2, SZ_WOUT = (size_t)1024 * 1024 * 2, SZ_WO = (size_t)1024 * 1024 * 2;
constexpr size_t OFF_WGU = 0;
constexpr size_t OFF_WD = OFF_WGU + 8 * SZ_WGU;
constexpr size_t OFF_WIN = OFF_WD + 8 * SZ_WD;
constexpr size_t OFF_WGL = OFF_WIN + 4 * SZ_WIN;
constexpr size_t OFF_WOUT = OFF_WGL + 4 * SZ_WGL;
constexpr size_t OFF_WO = OFF_WOUT + 4 * SZ_WOUT;
constexpr size_t SZ_PW1 = (size_t)65 * 64 * 2 * 4;
constexpr size_t SZ_BB1 = (size_t)64 * 16 * 2 * 4;
constexpr size_t SZ_KE1 = (size_t)64 * 256 * 4;
constexpr size_t OFF_PW = OFF_WO + 4 * SZ_WO;
constexpr size_t OFF_BB = OFF_PW + 128 * SZ_PW1;
constexpr size_t OFF_KERN = OFF_BB + 128 * SZ_BB1;
constexpr size_t OFF_W1 = OFF_KERN + 128 * SZ_KE1;
constexpr size_t OFF_W2 = OFF_W1 + (size_t)32 * 256 * 1024 * 2;
constexpr size_t OFF_XN = OFF_W2 + (size_t)32 * 1024 * 1152 * 2;
constexpr size_t OFF_M1 = OFF_XN + (size_t)NTOK * 1024 * 2;
constexpr size_t OFF_SSP = OFF_M1 + (size_t)NTOK * 1024 * 2;
constexpr size_t OFF_RS = OFF_SSP + (size_t)64 * NTOK * 4;
constexpr size_t OFF_OV = OFF_RS + (size_t)NTOK * 4;
constexpr size_t OFF_H = OFF_OV;
constexpr size_t OFF_U = OFF_OV;
constexpr size_t OFF_Q = OFF_U + (size_t)32 * 1024 * 1152 * 2;
constexpr size_t OFF_K = OFF_Q + (size_t)NTOK * 512 * 2;
constexpr size_t OFF_VT = OFF_K + (size_t)NTOK * 512 * 2;
constexpr size_t OFF_SB = OFF_VT + (size_t)NTOK * 512 * 2;
constexpr size_t OFF_S = OFF_SB + (size_t)NTOK * 1024 * 2;
constexpr size_t OV_MIX = OFF_S + (size_t)32 * 1024 * 128 * 4 - OFF_OV;
constexpr size_t OV_FFN = (size_t)NTOK * 2816 * 2;
constexpr size_t OFF_BAR = OFF_OV + (OV_MIX > OV_FFN ? OV_MIX : OV_FFN);
constexpr size_t BAR_BYTES = 16384;
constexpr size_t WS_END = OFF_BAR + BAR_BYTES;

DI const char* uni_ptr(const char* p) { const unsigned long long v = (unsigned long long)p; const unsigned lo = __builtin_amdgcn_readfirstlane((unsigned)v), hi = __builtin_amdgcn_readfirstlane((unsigned)(v >> 32)); return (const char*)(((unsigned long long)hi << 32) | lo); }
DI int opaque_tid(int wave_s) { int t = wave_s * 64 + (int)__builtin_amdgcn_mbcnt_hi(~0u, __builtin_amdgcn_mbcnt_lo(~0u, 0u)); asm volatile("" : "+v"(t)); return t; }
DI unsigned pk2(float a, float b) { f32x2 v = {a, b}; bf2_t r = __builtin_convertvector(v, bf2_t); return __builtin_bit_cast(unsigned, r); }
DI float bflo(unsigned u) { return __uint_as_float(u << 16); }
DI float bfhi(unsigned u) { return __uint_as_float(u & 0xffff0000u); }
DI float shx(float v, int lane, int o) { return __int_as_float(__builtin_amdgcn_ds_bpermute((lane ^ o) << 2, __float_as_int(v))); }
DI float wave_sum(float v, int lane) {
#pragma unroll
    for (int o = 1; o < 64; o <<= 1) v += shx(v, lane, o);
    return v;
}
DI float fsigmoid(float x) { return __builtin_amdgcn_rcpf(1.f + __expf(-x)); }
DI float fsilu(float x) { return x * fsigmoid(x); }
DI float fgelu_tanh(float x) { return x * fsigmoid(1.5957691216f * (x + 0.044715f * x * x * x)); }
DI u32x4 pack8(const f32x4 a, const f32x4 b) { u32x4 w; w.x = pk2(a[0], a[1]); w.y = pk2(a[2], a[3]); w.z = pk2(b[0], b[1]); w.w = pk2(b[2], b[3]); return w; }
DI void unpack8(const u32x4 w, f32x4& a, f32x4& b) { a = (f32x4){bflo(w.x), bfhi(w.x), bflo(w.y), bfhi(w.y)}; b = (f32x4){bflo(w.z), bfhi(w.z), bflo(w.w), bfhi(w.w)}; }


#define XB_TMO      128
#define XB_XCNT(j)  (256  + 64 * (j))
#define XB_XSUB(j)  (1280 + 64 * (j))
#define XB_XGEN(j)  (2304 + 64 * (j))
#define XB_TOP      3328
#define XB_TOPGEN   3392
#define XCD_BAR_WORDS 3456
#define XB_SPIN_CAP (1u << 20)
DI unsigned xb_ld(unsigned* p)              { return __hip_atomic_load(p, __ATOMIC_RELAXED, __HIP_MEMORY_SCOPE_AGENT); }
DI unsigned xb_add(unsigned* p, unsigned v) { return __hip_atomic_fetch_add(p, v, __ATOMIC_RELAXED, __HIP_MEMORY_SCOPE_AGENT); }
DI unsigned xb_xcc_id() { return (unsigned)__builtin_amdgcn_s_getreg((3 << 11) | 20) & 0xFu; }
#define XB_SPIN(cond, bar) do { unsigned _sp = 0; while (cond) { __builtin_amdgcn_s_sleep(1); \
    if ((++_sp & 255u) == 0u) { if (xb_ld(&(bar)[XB_TMO])) break; if (_sp > XB_SPIN_CAP) { atomicAdd(&(bar)[XB_TMO], 1u); break; } } } } while (0)
struct XcdBarrier { unsigned* bar; unsigned x; volatile LAS unsigned* st; };
DI void xcd_barrier_complete(unsigned* bar, unsigned x, unsigned& nloc, unsigned& nx) {
    const unsigned G = gridDim.x;
    unsigned sum, cnt, mine, sp = 0u;
    for (;;) {
        sum = 0u; cnt = 0u; mine = 0u;
#pragma unroll
        for (unsigned j = 0; j < 16; ++j) { const unsigned c = xb_ld(&bar[XB_XCNT(j)]); sum += c; cnt += (c > 0u) ? 1u : 0u; mine = (j == x) ? c : mine; }
        if (sum == G) break;
        __builtin_amdgcn_s_sleep(1);
        if ((++sp & 255u) == 0u) { if (xb_ld(&bar[XB_TMO])) break; if (sp > XB_SPIN_CAP) { atomicAdd(&bar[XB_TMO], 1u); break; } }
    }
    nloc = mine > 0u ? mine : 1u; nx = cnt > 0u ? cnt : 1u;
}
DI void xcd_barrier(const XcdBarrier& b, int wave_s) {
    asm volatile("s_waitcnt vmcnt(0)" ::: "memory");
    __syncthreads();
    if (opaque_tid(wave_s) == 0) {
        unsigned* bar = b.bar;
        __builtin_amdgcn_s_waitcnt(0);
        unsigned nloc = b.st[0], nx = b.st[1];
        if (nloc == 0u) { xcd_barrier_complete(bar, b.x, nloc, nx); b.st[0] = nloc; b.st[1] = nx; }
        const unsigned old = xb_add(&bar[XB_XSUB(b.x)], 1u);
        const unsigned gen = old / nloc;
        if (old + 1u == (gen + 1u) * nloc) {
            __builtin_amdgcn_fence(__ATOMIC_RELEASE, "agent");
            asm volatile("s_waitcnt vmcnt(0)" ::: "memory");
            const unsigned og = xb_add(&bar[XB_TOP], 1u);
            const unsigned tg = og / nx;
            if (og + 1u == (tg + 1u) * nx) xb_add(&bar[XB_TOPGEN], 1u);
            else XB_SPIN(xb_ld(&bar[XB_TOPGEN]) == tg, bar);
            __builtin_amdgcn_fence(__ATOMIC_ACQUIRE, "agent");
            xb_add(&bar[XB_XGEN(b.x)], 1u);
            asm volatile("s_waitcnt vmcnt(0)" ::: "memory");
        } else {
            XB_SPIN(xb_ld(&bar[XB_XGEN(b.x)]) == gen, bar);
            __builtin_amdgcn_fence(__ATOMIC_ACQUIRE, "agent");
            asm volatile("s_waitcnt vmcnt(0)" ::: "memory");
        }
    }
    __syncthreads();
}

namespace pg8 {
constexpr int BM = 256, BK = 64, HALF = 128, HTB = HALF * BK * 2, STAGE_BYTES = 8 * HTB, NXCD = 8, WGM = 8;
DI int lds_byte(int r, int c) { const int st = (r >> 4) * 2 + (c >> 5), rr = r & 15, cc = c & 31, ob = rr * 64 + cc * 2; return st * 1024 + (ob ^ (((ob >> 9) & 1) << 5)); }
DI void stage_rc(int b, int& R, int& C) { const int st = b / 1024, sb = b % 1024, swz = sb ^ (((sb >> 9) & 1) << 5); R = (st >> 1) * 16 + swz / 64; C = (st & 1) * 32 + (swz % 64) / 2; }
DI int perm32(int rho) { const int n = rho >> 4, i = rho & 15; return 8 * (i >> 2) + 4 * n + (i & 3); }

struct Unit { int pm, pn, pb; };
struct Gemm { const char* A; const char* B; int lda, ldb; size_t a_pm, a_pb, b_pn, b_pb; int nt0, ntstep; };
struct Order {
    int nM, nN, nB, nwg, G, c, mode;
    DI void init(int nM_, int nN_, int nB_, int mode_, int G_, int c_) { nM = nM_; nN = nN_; nB = nB_; mode = mode_; nwg = nM * nN * nB; G = G_; c = c_; }
    DI bool next(int i, Unit& u) const {
        const long L = (long)i * G + c; if (L >= nwg) return false;
        if (mode == 0) {
            int wgid = (int)L; { const int q = nwg / NXCD, r = nwg % NXCD, xcd = wgid % NXCD, off = wgid / NXCD; wgid = (xcd < r ? xcd * (q + 1) : r * (q + 1) + (xcd - r) * q) + off; }
            const int nig = WGM * nN, gid = wgid / nig, fm = gid * WGM, gsz = (nM - fm) < WGM ? (nM - fm) : WGM;
            u.pm = fm + ((wgid % nig) % gsz); u.pn = (wgid % nig) / gsz; u.pb = 0;
        } else {
            const int per = nM * nN, l = (int)L; u.pb = l / per; const int rem = l % per; u.pm = rem / nN; int pn = rem % nN;
            if (mode == 2 && (i & 1)) pn = nN - 1 - pn;
            u.pn = pn;
        }
        u.pm = __builtin_amdgcn_readfirstlane(u.pm); u.pn = __builtin_amdgcn_readfirstlane(u.pn); u.pb = __builtin_amdgcn_readfirstlane(u.pb);
        return true;
    }
};

template <class Epi>
DI void gemm_phase(LAS unsigned char* lds, const Gemm g, const Order& S, const Epi& E, int wave_s) {
    const int tid = opaque_tid(wave_s);
    const int wid = __builtin_amdgcn_readfirstlane(tid >> 6), lane = tid & 63, wr = wid >> 2, wc = wid & 3, fr = lane & 15, fq = lane >> 4;
    unsigned voffA[2], voffB[2];
#pragma unroll
    for (int i = 0; i < 2; ++i) { int R, C; stage_rc(tid * 16 + i * 8192, R, C); const int Rb = (R & ~31) + perm32(R & 31);
        voffA[i] = (unsigned)(R * g.lda + C) * 2u; voffB[i] = (unsigned)(Rb * g.ldb + C) * 2u; }
    const size_t kstep = (size_t)(BK * 2);
    const size_t hstepA = (size_t)HALF * g.lda * 2, hstepB = (size_t)HALF * g.ldb * 2;
    const unsigned ldsw = (unsigned)wid * 1024u;
    const int aoff = lds_byte(wr * 64 + fr, fq * 8), boff = lds_byte(wc * 32 + fr, fq * 8);
#define PG8_SA(b, h) (((b) * 2 + (h)) * HTB)
#define PG8_SB(b, h) ((4 + (b) * 2 + (h)) * HTB)
#define PG8_STAGE(bufoff, gbase, voff) do { _Pragma("unroll") for (int _i = 0; _i < 2; ++_i) \
        __builtin_amdgcn_global_load_lds((const unsigned*)((const char*)(gbase) + (voff)[_i]), (LAS unsigned*)(lds + (bufoff) + ldsw + _i * 8192), 16, 0, 0); } while (0)
#define PG8_LDA(dst, b, h) do { _Pragma("unroll") for (int m = 0; m < 4; ++m) _Pragma("unroll") for (int k = 0; k < 2; ++k) dst[m][k] = *(const LAS bf16x8*)(lds + PG8_SA(b, h) + aoff + m * 2048 + k * 1024); } while (0)
#define PG8_LDB(dst, b, h) do { _Pragma("unroll") for (int n = 0; n < 2; ++n) _Pragma("unroll") for (int k = 0; k < 2; ++k) dst[n][k] = *(const LAS bf16x8*)(lds + PG8_SB(b, h) + boff + n * 2048 + k * 1024); } while (0)
#define PG8_MMA(ai, bj, At, Bt) do { __builtin_amdgcn_s_setprio(1); _Pragma("unroll") for (int m = 0; m < 4; ++m) _Pragma("unroll") for (int n = 0; n < 2; ++n) _Pragma("unroll") for (int k = 0; k < 2; ++k) \
        acc[ai][bj][m][n] = __builtin_amdgcn_mfma_f32_16x16x32_bf16(Bt[n][k], At[m][k], acc[ai][bj][m][n], 0, 0, 0); __builtin_amdgcn_s_setprio(0); } while (0)
#define PG8_WAIT_V(n) asm volatile("s_waitcnt vmcnt(" #n ")" ::: "memory")
#define PG8_WAIT_L(n) asm volatile("s_waitcnt lgkmcnt(" #n ")" ::: "memory")
#define PG8_BAR __builtin_amdgcn_s_barrier()
#define PG8_SCHED __builtin_amdgcn_sched_barrier(0)
    Unit cur, nxt; int ui = 0;
    if (!S.next(0, cur)) return;
    f32x4 acc[2][2][4][2];
#pragma unroll
    for (int a = 0; a < 2; ++a)
#pragma unroll
        for (int b = 0; b < 2; ++b)
#pragma unroll
            for (int m = 0; m < 4; ++m)
#pragma unroll
                for (int n = 0; n < 2; ++n) acc[a][b][m][n] = (f32x4){0.f, 0.f, 0.f, 0.f};
    bf16x8 At[4][2], B0[2][2], B1[2][2];
    const char* cA = uni_ptr(g.A + (size_t)cur.pb * g.a_pb + (size_t)cur.pm * g.a_pm);
    const char* cB = uni_ptr(g.B + (size_t)cur.pb * g.b_pb + (size_t)cur.pn * g.b_pn);
    PG8_STAGE(PG8_SB(0, 0), cB, voffB); PG8_STAGE(PG8_SB(0, 1), cB + hstepB, voffB); PG8_STAGE(PG8_SA(0, 0), cA, voffA); PG8_STAGE(PG8_SA(0, 1), cA + hstepA, voffA);
    if (wr == 1) PG8_BAR;
    PG8_WAIT_V(2); PG8_BAR;
    PG8_STAGE(PG8_SB(1, 0), cB + kstep, voffB); PG8_STAGE(PG8_SA(1, 0), cA + kstep, voffA); PG8_STAGE(PG8_SB(1, 1), cB + hstepB + kstep, voffB);
    PG8_WAIT_V(6); PG8_BAR;
    for (;;) {
        const bool has_next = S.next(ui + 1, nxt);
        const char* nA = uni_ptr(has_next ? g.A + (size_t)nxt.pb * g.a_pb + (size_t)nxt.pm * g.a_pm : cA);
        const char* nB = uni_ptr(has_next ? g.B + (size_t)nxt.pb * g.b_pb + (size_t)nxt.pn * g.b_pn : cB);
        const int nt = g.nt0 + g.ntstep * cur.pn;
        for (int t = 0; t < nt; t += 2) {
            const bool last = (t == nt - 2);
            if constexpr (Epi::HAS_MID) { if (t == Epi::TMID) E.mid(acc, cur, wr, wc, fr, fq); }
            const char* a1 = cA + (size_t)(t + 1) * kstep;
            const char* a2 = last ? nA : cA + (size_t)(t + 2) * kstep; const char* b2 = last ? nB : cB + (size_t)(t + 2) * kstep;
            const char* a3 = a2 + kstep; const char* b3 = b2 + kstep;
            PG8_LDB(B0, 0, 0); PG8_LDB(B1, 0, 1); PG8_SCHED; PG8_LDA(At, 0, 0); PG8_STAGE(PG8_SA(1, 1), a1 + hstepA, voffA);
            PG8_WAIT_V(8); PG8_WAIT_L(0); PG8_BAR; PG8_MMA(0, 0, At, B0); PG8_MMA(0, 1, At, B1); PG8_BAR; PG8_SCHED;
            PG8_LDA(At, 0, 1); PG8_STAGE(PG8_SB(0, 0), b2, voffB); PG8_STAGE(PG8_SB(0, 1), b2 + hstepB, voffB); PG8_STAGE(PG8_SA(0, 0), a2, voffA);
            PG8_WAIT_V(8); PG8_WAIT_L(0); PG8_BAR; PG8_MMA(1, 0, At, B0); PG8_MMA(1, 1, At, B1); PG8_BAR; PG8_SCHED;
            PG8_LDB(B0, 1, 0); PG8_LDB(B1, 1, 1); PG8_SCHED; PG8_LDA(At, 1, 0); PG8_STAGE(PG8_SA(0, 1), a2 + hstepA, voffA);
            PG8_WAIT_V(8); PG8_WAIT_L(0); PG8_BAR; PG8_MMA(0, 0, At, B0); PG8_MMA(0, 1, At, B1); PG8_BAR; PG8_SCHED;
            PG8_LDA(At, 1, 1); PG8_STAGE(PG8_SB(1, 0), b3, voffB); PG8_STAGE(PG8_SB(1, 1), b3 + hstepB, voffB); PG8_STAGE(PG8_SA(1, 0), a3, voffA);
            PG8_WAIT_V(8); PG8_WAIT_L(0); PG8_BAR; PG8_MMA(1, 0, At, B0); PG8_MMA(1, 1, At, B1); PG8_BAR; PG8_SCHED;
        }
        if (wr == 0) PG8_BAR;
        E(acc, cur, wr, wc, fr, fq);
        if (!has_next) break;
#pragma unroll
        for (int a = 0; a < 2; ++a)
#pragma unroll
            for (int b = 0; b < 2; ++b)
#pragma unroll
                for (int m = 0; m < 4; ++m)
#pragma unroll
                    for (int n = 0; n < 2; ++n) acc[a][b][m][n] = (f32x4){0.f, 0.f, 0.f, 0.f};
        cur = nxt; cA = nA; cB = nB; ++ui;
        if (wr == 1) PG8_BAR;
    }
    PG8_WAIT_V(0);
    PG8_BAR;
#undef PG8_SA
#undef PG8_SB
#undef PG8_STAGE
#undef PG8_LDA
#undef PG8_LDB
#undef PG8_MMA
#undef PG8_WAIT_V
#undef PG8_WAIT_L
#undef PG8_BAR
#undef PG8_SCHED
}
}
using pg8::Unit;
typedef f32x4 AccT[2][2][4][2];

template <int ACT> struct EpiGated {
    static constexpr bool HAS_MID = false; static constexpr int TMID = -1;
    bf16_t* O; int ldc; const float* rs;
    DI void mid(AccT&, const Unit&, int, int, int, int) const {}
    DI void operator()(const AccT& acc, const Unit& u, int wr, int wc, int fr, int fq) const {
        const int row0 = u.pm * 256 + wr * 64 + fr, col0 = u.pn * 128 + wc * 32 + 8 * fq;
#pragma unroll
        for (int ai = 0; ai < 2; ++ai)
#pragma unroll
            for (int m = 0; m < 4; ++m) {
                f32x4 o[2]; const float rv = rs ? ((const GAS float*)rs)[row0 + ai * 128 + m * 16] : 1.f;
#pragma unroll
                for (int n = 0; n < 2; ++n)
#pragma unroll
                    for (int e = 0; e < 4; ++e) { const float a = acc[ai][0][m][n][e] * rv, b = acc[ai][1][m][n][e] * rv; o[n][e] = ACT == 0 ? fsilu(a) * b : a * fsigmoid(b); }
                *(GAS u32x4*)(O + (size_t)(row0 + ai * 128 + m * 16) * ldc + col0) = pack8(o[0], o[1]);
            }
    }
};
struct EpiDown {
    static constexpr bool HAS_MID = false; static constexpr int TMID = -1;
    bf16_t* O; float* ssp;
    DI void mid(AccT&, const Unit&, int, int, int, int) const {}
    DI void operator()(const AccT& acc, const Unit& u, int wr, int wc, int fr, int fq) const {
        const int row0 = u.pm * 256 + wr * 64 + fr, col0 = u.pn * 256 + wc * 32 + 8 * fq;
#pragma unroll
        for (int ai = 0; ai < 2; ++ai)
#pragma unroll
            for (int m = 0; m < 4; ++m) {
                const int row = row0 + ai * 128 + m * 16; float ss = 0.f;
#pragma unroll
                for (int bj = 0; bj < 2; ++bj) {
                    const f32x4 v0 = acc[ai][bj][m][0], v1 = acc[ai][bj][m][1];
                    ss += (v0[0] * v0[0] + v0[1] * v0[1]) + (v0[2] * v0[2] + v0[3] * v0[3]) + (v1[0] * v1[0] + v1[1] * v1[1]) + (v1[2] * v1[2] + v1[3] * v1[3]);
                    *(GAS u32x4*)(O + (size_t)row * 1024 + col0 + bj * 128) = pack8(v0, v1);
                }
                ((GAS float*)ssp)[(size_t)(u.pn * 16 + wc * 4 + fq) * NTOK + row] = ss;
            }
    }
};
struct EpiWin {
    static constexpr bool HAS_MID = false; static constexpr int TMID = -1;
    bf16_t *U, *Q, *K, *VT, *R, *SB; const float* rs;
    DI void mid(AccT&, const Unit&, int, int, int, int) const {}
    DI void operator()(AccT& acc, const Unit& u, int wr, int wc, int fr, int fq) const {
        const int row0 = u.pm * 256 + wr * 64 + fr, pn = u.pn;
#pragma unroll
        for (int ai = 0; ai < 2; ++ai)
#pragma unroll
            for (int m = 0; m < 4; ++m) { const float rv = ((const GAS float*)rs)[row0 + ai * 128 + m * 16];
#pragma unroll
                for (int bj = 0; bj < 2; ++bj) { acc[ai][bj][m][0] *= rv; acc[ai][bj][m][1] *= rv; } }
        if (pn < 2) {
#pragma unroll
            for (int ai = 0; ai < 2; ++ai)
#pragma unroll
                for (int m = 0; m < 4; ++m) { const int row = row0 + ai * 128 + m * 16, bc = row >> 6, j = row & 63;
#pragma unroll
                    for (int bj = 0; bj < 2; ++bj) { const int c = pn * 256 + bj * 128 + wc * 32 + 8 * fq, gi = c >> 4, h0 = c & 15;
                        *(GAS u32x4*)(U + ((size_t)gi * 1024 + bc) * 1152 + 128 + j * 16 + h0) = pack8(acc[ai][bj][m][0], acc[ai][bj][m][1]); } }
        } else if (pn < 6) {
            bf16_t* O = pn < 4 ? Q : K; const int cb = (pn & 1) * 256 + wc * 32 + 8 * fq;
#pragma unroll
            for (int ai = 0; ai < 2; ++ai)
#pragma unroll
                for (int m = 0; m < 4; ++m) { const int row = row0 + ai * 128 + m * 16;
#pragma unroll
                    for (int bj = 0; bj < 2; ++bj) *(GAS u32x4*)(O + (size_t)row * 512 + cb + bj * 128) = pack8(acc[ai][bj][m][0], acc[ai][bj][m][1]); }
        } else if (pn < 8) {
#pragma unroll
            for (int ai = 0; ai < 2; ++ai)
#pragma unroll
                for (int m = 0; m < 4; ++m) { const int row = row0 + ai * 128 + m * 16, b = row >> 12, s = row & 4095;
#pragma unroll
                    for (int bj = 0; bj < 2; ++bj) { const int c = (pn - 6) * 256 + bj * 128 + wc * 32 + 8 * fq, hd = c >> 6, d0 = c & 63;
                        GAS bf16_t* o = (GAS bf16_t*)(VT + (((size_t)b * 8 + hd) * 64 + d0) * 4096 + s);
                        const u32x4 w = pack8(acc[ai][bj][m][0], acc[ai][bj][m][1]);
                        o[0 * 4096] = (bf16_t)(w.x & 0xffff); o[1 * 4096] = (bf16_t)(w.x >> 16); o[2 * 4096] = (bf16_t)(w.y & 0xffff); o[3 * 4096] = (bf16_t)(w.y >> 16);
                        o[4 * 4096] = (bf16_t)(w.z & 0xffff); o[5 * 4096] = (bf16_t)(w.z >> 16); o[6 * 4096] = (bf16_t)(w.w & 0xffff); o[7 * 4096] = (bf16_t)(w.w >> 16); } }
        } else {
            const int cb = (pn - 8) * 128 + wc * 32 + 8 * fq;
#pragma unroll
            for (int ai = 0; ai < 2; ++ai)
#pragma unroll
                for (int m = 0; m < 4; ++m) { const int row = row0 + ai * 128 + m * 16; f32x4 r[2], sb[2];
#pragma unroll
                    for (int n = 0; n < 2; ++n)
#pragma unroll
                        for (int e = 0; e < 4; ++e) { const float sa = fsigmoid(acc[ai][0][m][n][e]), sbv = fsigmoid(acc[ai][1][m][n][e]); sb[n][e] = sbv; r[n][e] = sa * __builtin_amdgcn_rcpf(sbv); }
                    *(GAS u32x4*)(R + (size_t)row * 1024 + cb) = pack8(r[0], r[1]);
                    *(GAS u32x4*)(SB + (size_t)row * 1024 + cb) = pack8(sb[0], sb[1]); }
        }
    }
};
struct EpiS {
    static constexpr bool HAS_MID = false; static constexpr int TMID = -1;
    float* S;
    DI void mid(AccT&, const Unit&, int, int, int, int) const {}
    DI void operator()(const AccT& acc, const Unit& u, int wr, int wc, int fr, int fq) const {
        const int row0 = u.pm * 256 + wr * 64 + fr, col0 = wc * 32 + 8 * fq;
#pragma unroll
        for (int ai = 0; ai < 2; ++ai)
#pragma unroll
            for (int m = 0; m < 4; ++m) { GAS float* o = (GAS float*)(S + ((size_t)u.pb * 1024 + row0 + ai * 128 + m * 16) * 128 + col0);
                *(f32x4*)o = acc[ai][0][m][0]; *(GAS f32x4*)(o + 4) = acc[ai][0][m][1]; }
    }
};
struct EpiY {
    static constexpr bool HAS_MID = false; static constexpr int TMID = -1;
    bf16_t* YA;
    DI void mid(AccT&, const Unit&, int, int, int, int) const {}
    DI void operator()(const AccT& acc, const Unit& u, int wr, int wc, int fr, int fq) const {
        const int row0 = u.pm * 256 + wr * 64 + fr;
#pragma unroll
        for (int ai = 0; ai < 2; ++ai)
#pragma unroll
            for (int m = 0; m < 4; ++m) { const int row = row0 + ai * 128 + m * 16;
#pragma unroll
                for (int bj = 0; bj < 2; ++bj) { const int c = u.pn * 256 + bj * 128 + wc * 32 + 8 * fq, t = c >> 4, h0 = c & 15; f32x4 o[2];
#pragma unroll
                    for (int n = 0; n < 2; ++n)
#pragma unroll
                        for (int e = 0; e < 4; ++e) o[n][e] = fgelu_tanh(acc[ai][bj][m][n][e]);
                    *(GAS u32x4*)(YA + ((size_t)row * 64 + t) * 512 + u.pb * 16 + h0) = pack8(o[0], o[1]); } }
    }
};
struct EpiMerge {
    static constexpr bool HAS_MID = true; static constexpr int TMID = 8;
    const bf16_t *R, *SB; bf16_t* O; int wave_s;
    DI void scale(AccT& acc, const Unit& u, int, int, int, int, const bf16_t* P) const {
        const int t_ = opaque_tid(wave_s), wid = __builtin_amdgcn_readfirstlane(t_ >> 6), ln = t_ & 63, wr = wid >> 2, wc = wid & 3, fr = ln & 15, fq = ln >> 4;
        const int row0 = u.pm * 256 + wr * 64 + fr, col0 = u.pn * 256 + wc * 32 + 8 * fq;
#pragma unroll
        for (int ai = 0; ai < 2; ++ai)
#pragma unroll
            for (int m = 0; m < 4; ++m)
#pragma unroll
                for (int bj = 0; bj < 2; ++bj) { const u32x4 w = *(const GAS u32x4*)(P + (size_t)(row0 + ai * 128 + m * 16) * 1024 + col0 + bj * 128); f32x4 a, b; unpack8(w, a, b);
                    acc[ai][bj][m][0] *= a; acc[ai][bj][m][1] *= b; }
    }
    DI void mid(AccT& acc, const Unit& u, int wr, int wc, int fr, int fq) const { scale(acc, u, wr, wc, fr, fq, R); }
    DI void operator()(AccT& acc, const Unit& u, int wr, int wc, int fr, int fq) const {
        scale(acc, u, wr, wc, fr, fq, SB);
        const int row0 = u.pm * 256 + wr * 64 + fr, col0 = u.pn * 256 + wc * 32 + 8 * fq;
#pragma unroll
        for (int ai = 0; ai < 2; ++ai)
#pragma unroll
            for (int m = 0; m < 4; ++m)
#pragma unroll
                for (int bj = 0; bj < 2; ++bj) *(GAS u32x4*)(O + (size_t)(row0 + ai * 128 + m * 16) * 1024 + col0 + bj * 128) = pack8(acc[ai][bj][m][0], acc[ai][bj][m][1]);
    }
};

struct Params { const float* in[20]; float* out; unsigned char* ws; };
enum { I_X = 0, I_GAINS, I_WGATE, I_WUP, I_WDOWN, I_WIN, I_LRE, I_LIM, I_LOGDT, I_BRE, I_BIM, I_CRE, I_CIM, I_DSKIP, I_GLUV, I_GLUG, I_OSSM, I_RELB, I_OATT, I_WO };

DI int map_row(int map, int n) {
    if (map == 0) return n;
    if (map == 1) return 256 * (n >> 7) + (n & 127);
    if (map == 2) return 256 * (n >> 7) + 128 + (n & 127);
    if (n < 2048) return n;
    if (n < 3072) { const int j = n - 2048; return 2048 + 256 * (j >> 7) + (j & 127); }
    const int j = n - 3072; return 2048 + 256 * (j >> 7) + 128 + (j & 127);
}
DI void cvt_item(const float* W, int K, int N, bf16_t* WT, int ldk, int koff, int map, LAS float* scr, int item, int lane, const float* gk = nullptr) {
    const int nblk = N / 32, kb = item / nblk, nb = item % nblk, k0 = 64 * kb, n0 = 32 * nb;
    const float sc = (map == 3 && n0 >= 512 && n0 < 1024) ? 0.125f * 1.4426950408889634f : 1.f;
    { const int kq = lane >> 3, n4 = (lane & 7) * 4;
      f32x4 wv[8];
#pragma unroll
      for (int i = 0; i < 8; ++i) wv[i] = *(const GAS f32x4*)(W + (size_t)(k0 + i * 8 + kq) * N + n0 + n4);
#pragma unroll
      for (int i = 0; i < 8; ++i) { const int kk = i * 8 + kq; const float m = gk ? sc * gk[k0 + kk] : sc;
          scr[kk * 33 + n4] = wv[i][0] * m; scr[kk * 33 + n4 + 1] = wv[i][1] * m; scr[kk * 33 + n4 + 2] = wv[i][2] * m; scr[kk * 33 + n4 + 3] = wv[i][3] * m; } }
    asm volatile("s_waitcnt lgkmcnt(0)" ::: "memory");
    const int c = lane & 7;
#pragma unroll
    for (int j = 0; j < 4; ++j) { const int n = (lane >> 3) + 8 * j; const LAS float* s = scr + (8 * c) * 33 + n;
        u32x4 o; o.x = pk2(s[0 * 33], s[1 * 33]); o.y = pk2(s[2 * 33], s[3 * 33]); o.z = pk2(s[4 * 33], s[5 * 33]); o.w = pk2(s[6 * 33], s[7 * 33]);
        *(GAS u32x4*)(WT + (size_t)map_row(map, n0 + n) * ldk + koff + k0 + 8 * c) = o; }
    asm volatile("s_waitcnt lgkmcnt(0)" ::: "memory");
}
DI void cvt_matrix(const float* W, int K, int N, bf16_t* WT, int ldk, int koff, int map, LAS float* scr, int gw, int NGW, int lane) {
    const int nitems = (K / 64) * (N / 32);
    for (int it = gw; it < nitems; it += NGW) cvt_item(W, K, N, WT, ldk, koff, map, scr, it, lane);
}

DI void s5_tables(const Params& P, LAS unsigned char* lds, int lg) {
    LAS float* pw = (LAS float*)lds;
    LAS float* bb = pw + 65 * 64 * 2;
    LAS float* cc = bb + 64 * 16 * 2;
    LAS float* ff = cc + 16 * 64 * 2;
    const int tid = threadIdx.x;
    unsigned char* ws = P.ws;
    float* gPW = (float*)(ws + OFF_PW + (size_t)lg * SZ_PW1);
    float* gBB = (float*)(ws + OFF_BB + (size_t)lg * SZ_BB1);
    float* gKE = (float*)(ws + OFF_KERN + (size_t)lg * SZ_KE1);
    const double dt = exp((double)P.in[I_LOGDT][lg]);
    const float* lre = P.in[I_LRE] + (size_t)lg * 64; const float* lim = P.in[I_LIM] + (size_t)lg * 64;
    for (int idx = tid; idx < 65 * 64; idx += NTHREADS) {
        const int tau = idx >> 6, p = idx & 63;
        const double lr = lre[p], li = lim[p];
        const float mag = __expf((float)(lr * dt * tau));
        double rev = li * dt * tau * 0.15915494309189535; rev -= rint(rev);
        const float cs = __builtin_amdgcn_cosf((float)rev), sn = __builtin_amdgcn_sinf((float)rev);
        const float re = mag * cs, im = mag * sn;
        pw[idx * 2] = re; pw[idx * 2 + 1] = im; gPW[idx * 2] = re; gPW[idx * 2 + 1] = im;
        if (tau == 1) {
            const double nr = (double)re - 1.0, ni = im, den = lr * lr + li * li;
            ff[p * 2] = (float)((nr * lr + ni * li) / den); ff[p * 2 + 1] = (float)((ni * lr - nr * li) / den);
        }
    }
    __syncthreads();
    const float* bre = P.in[I_BRE] + (size_t)lg * 1024; const float* bim = P.in[I_BIM] + (size_t)lg * 1024;
    const float* cre = P.in[I_CRE] + (size_t)lg * 1024; const float* cim = P.in[I_CIM] + (size_t)lg * 1024;
    for (int idx = tid; idx < 1024; idx += NTHREADS) {
        const int p = idx >> 4;
        const float fr_ = ff[p * 2], fi_ = ff[p * 2 + 1], br = bre[idx], bi = bim[idx];
        const float re = fr_ * br - fi_ * bi, im = fr_ * bi + fi_ * br;
        bb[idx * 2] = re; bb[idx * 2 + 1] = im; gBB[idx * 2] = re; gBB[idx * 2 + 1] = im;
        cc[idx * 2] = cre[idx]; cc[idx * 2 + 1] = cim[idx];
    }
    __syncthreads();
    const float* dsk = P.in[I_DSKIP] + (size_t)lg * 16;
    for (int pair = tid; pair < 1024; pair += NTHREADS) {
        const int tau = pair >> 4, h = pair & 15;
        float a[16];
#pragma unroll
        for (int j = 0; j < 16; ++j) a[j] = 0.f;
        for (int p = 0; p < 64; ++p) {
            const float cr = cc[(h * 64 + p) * 2], ci = cc[(h * 64 + p) * 2 + 1], pr = pw[(tau * 64 + p) * 2], pi = pw[(tau * 64 + p) * 2 + 1];
            const float xr = cr * pr - ci * pi, xi = cr * pi + ci * pr;
#pragma unroll
            for (int j = 0; j < 16; ++j) a[j] += xr * bb[(p * 16 + j) * 2] - xi * bb[(p * 16 + j) * 2 + 1];
        }
        const float dv = dsk[h];
#pragma unroll
        for (int j = 0; j < 16; ++j) gKE[(size_t)pair * 16 + j] = a[j] + ((tau == 0 && j == h) ? dv : 0.f);
    }
    __syncthreads();
}

DI void build_w12(const Params& P, int l, int wave_s) {
    unsigned char* ws = P.ws;
    const float* gPW = (const float*)(ws + OFF_PW) + (size_t)l * 32 * (65 * 64 * 2);
    const float* gBB = (const float*)(ws + OFF_BB) + (size_t)l * 32 * (64 * 16 * 2);
    const float* gKE = (const float*)(ws + OFF_KERN) + (size_t)l * 32 * (64 * 256);
    bf16_t* W1 = (bf16_t*)(ws + OFF_W1); bf16_t* W2 = (bf16_t*)(ws + OFF_W2);
    const int gt = blockIdx.x * NTHREADS + opaque_tid(wave_s), NT = gridDim.x * NTHREADS;
    for (int it = gt; it < 32 * 256 * 128; it += NT) {
        const int kk = it & 127, n = (it >> 7) & 255, g = it >> 15;
        float v[8];
        if (n >= 128) {
#pragma unroll
            for (int e = 0; e < 8; ++e) v[e] = 0.f;
        } else {
            const int p = n & 63, im = n >> 6, j = kk >> 1, h0 = (kk & 1) * 8;
            const float* pwp = gPW + ((size_t)g * 65 + (63 - j)) * 128 + p * 2; const float pr = pwp[0], pi = pwp[1];
            const float* bp = gBB + ((size_t)g * 64 + p) * 32 + h0 * 2;
#pragma unroll
            for (int e = 0; e < 8; ++e) { const float br = bp[e * 2], bi = bp[e * 2 + 1]; v[e] = im ? (pr * bi + pi * br) : (pr * br - pi * bi); }
        }
        u32x4 o; o.x = pk2(v[0], v[1]); o.y = pk2(v[2], v[3]); o.z = pk2(v[4], v[5]); o.w = pk2(v[6], v[7]);
        *(GAS u32x4*)(W1 + (size_t)it * 8) = o;
    }
    const float* cre = P.in[I_CRE] + (size_t)l * 32 * 1024; const float* cim = P.in[I_CIM] + (size_t)l * 32 * 1024;
    for (int it = gt; it < 32 * 1024 * 144; it += NT) {
        const int kk = it % 144, n = (it / 144) & 1023, g = it / (144 * 1024), t = n >> 4, h = n & 15;
        float v[8];
        if (kk < 16) {
            const int im = kk >> 3, p0 = (kk & 7) * 8;
            const float* pwp = gPW + ((size_t)g * 65 + (t + 1)) * 128 + p0 * 2;
            const float* crp = cre + ((size_t)g * 16 + h) * 64 + p0; const float* cip = cim + ((size_t)g * 16 + h) * 64 + p0;
#pragma unroll
            for (int e = 0; e < 8; ++e) { const float cr = crp[e], ci = cip[e], pr = pwp[e * 2], pi = pwp[e * 2 + 1]; v[e] = im ? -(cr * pi + ci * pr) : (cr * pr - ci * pi); }
        } else {
            const int j = (kk - 16) >> 1, h0 = ((kk - 16) & 1) * 8;
            if (j <= t) { const float* kp = gKE + (((size_t)g * 64 + (t - j)) * 16 + h) * 16 + h0;
#pragma unroll
                for (int e = 0; e < 8; ++e) v[e] = kp[e];
            } else {
#pragma unroll
                for (int e = 0; e < 8; ++e) v[e] = 0.f;
            }
        }
        u32x4 o; o.x = pk2(v[0], v[1]); o.y = pk2(v[2], v[3]); o.z = pk2(v[4], v[5]); o.w = pk2(v[6], v[7]);
        *(GAS u32x4*)(W2 + (size_t)it * 8) = o;
    }
}

DI void ew_rows(unsigned char* ws, float* outp, const float* xin, bool first, bool last, float coef, const float* gpost, int rbeg, int rend, int lane) {
    const bf16_t* M1 = (const bf16_t*)(ws + OFF_M1); const float* ssp = (const float*)(ws + OFF_SSP); bf16_t* XB = (bf16_t*)(ws + OFF_XN); float* RS = (float*)(ws + OFF_RS);
    for (int r0 = rbeg; r0 < rend; r0 += 4) {
        f32x4 ssv = {0.f, 0.f, 0.f, 0.f};
        u32x2 xr[4][4], mr[4][4]; f32x4 xf[4][4];
        if (first) {
#pragma unroll
            for (int q = 0; q < 4; ++q)
#pragma unroll
                for (int j = 0; j < 4; ++j) xf[q][j] = *(const GAS f32x4*)(xin + (size_t)(r0 + q) * 1024 + j * 256 + lane * 4);
        } else {
            ssv = *(const GAS f32x4*)(ssp + (size_t)lane * NTOK + r0);
#pragma unroll
            for (int q = 0; q < 4; ++q)
#pragma unroll
                for (int j = 0; j < 4; ++j) { xr[q][j] = *(const GAS u32x2*)(XB + (size_t)(r0 + q) * 1024 + j * 256 + lane * 4); mr[q][j] = *(const GAS u32x2*)(M1 + (size_t)(r0 + q) * 1024 + j * 256 + lane * 4); }
        }
#pragma unroll
        for (int q = 0; q < 4; ++q) {
            const int row = r0 + q;
            f32x4 v[4];
            if (first) {
#pragma unroll
                for (int j = 0; j < 4; ++j) v[j] = xf[q][j];
            } else {
                const float rstd = __builtin_amdgcn_rsqf(wave_sum(ssv[q], lane) * (1.f / 1024.f) + RMS_EPS) * coef;
#pragma unroll
                for (int j = 0; j < 4; ++j) {
                    const u32x2 xw = xr[q][j], w = mr[q][j];
                    const f32x4 gp = *(const GAS f32x4*)(gpost + j * 256 + lane * 4);
                    const f32x4 xv = {bflo(xw.x), bfhi(xw.x), bflo(xw.y), bfhi(xw.y)};
                    const f32x4 mv = {bflo(w.x), bfhi(w.x), bflo(w.y), bfhi(w.y)};
                    v[j] = xv + gp * mv * rstd;
                }
            }
            if (last) {
#pragma unroll
                for (int j = 0; j < 4; ++j) *(GAS f32x4*)(outp + (size_t)row * 1024 + j * 256 + lane * 4) = v[j];
            } else {
                float ss = 0.f;
#pragma unroll
                for (int j = 0; j < 4; ++j) ss += (v[j][0] * v[j][0] + v[j][1] * v[j][1]) + (v[j][2] * v[j][2] + v[j][3] * v[j][3]);
                const float rstd2 = __builtin_amdgcn_rsqf(wave_sum(ss, lane) * (1.f / 1024.f) + RMS_EPS);
                if (lane == 0) ((GAS float*)RS)[row] = rstd2;
#pragma unroll
                for (int j = 0; j < 4; ++j) { u32x2 w; w.x = pk2(v[j][0], v[j][1]); w.y = pk2(v[j][2], v[j][3]);
                    *(GAS u32x2*)(XB + (size_t)row * 1024 + j * 256 + lane * 4) = w; }
            }
        }
    }
}
DI void ew_phase(const Params& P, bool first, bool last, float coef, const float* gpost, int wave_s) {
    const int tid_ = opaque_tid(wave_s), lane = tid_ & 63, wave = __builtin_amdgcn_readfirstlane(tid_ >> 6);
    const int gw = blockIdx.x * NWAVES + wave, NGW = gridDim.x * NWAVES;
    const int rpw = (NTOK / 4 + NGW - 1) / NGW * 4;
    const int rbeg = gw * rpw, rend = (rbeg + rpw) < NTOK ? (rbeg + rpw) : NTOK;
    ew_rows(P.ws, P.out, P.in[I_X], first, last, coef, gpost, rbeg, rend, lane);
}

DI void carry_phase(const Params& P, int l, int wave_s) {
    const int tid_ = opaque_tid(wave_s), lane = tid_ & 63, wave = __builtin_amdgcn_readfirstlane(tid_ >> 6);
    unsigned char* ws = P.ws;
    const float* gPW = (const float*)(ws + OFF_PW) + (size_t)l * 32 * (65 * 64 * 2);
    const float* S = (const float*)(ws + OFF_S); bf16_t* U = (bf16_t*)(ws + OFF_U);
    const int gw = blockIdx.x * NWAVES + wave, NGW = gridDim.x * NWAVES;
    for (int task = gw; task < 512; task += NGW) {
        const int g = task >> 4, b = task & 15, p = lane;
        const float ar = gPW[((size_t)g * 65 + 64) * 128 + p * 2], ai = gPW[((size_t)g * 65 + 64) * 128 + p * 2 + 1];
        float xr = 0.f, xi = 0.f;
        const GAS float* sp = (const GAS float*)(S + ((size_t)g * 1024 + b * 64) * 128); GAS bf16_t* up = (GAS bf16_t*)(U + ((size_t)g * 1024 + b * 64) * 1152);
#pragma unroll 8
        for (int c = 0; c < 64; ++c) {
            up[(size_t)c * 1152 + p] = (bf16_t)(pk2(xr, 0.f) & 0xffff); up[(size_t)c * 1152 + 64 + p] = (bf16_t)(pk2(xi, 0.f) & 0xffff);
            const float sr = sp[c * 128 + p], si = sp[c * 128 + 64 + p];
            const float nr = ar * xr - ai * xi + sr, ni = ar * xi + ai * xr + si;
            xr = nr; xi = ni;
        }
    }
}

DI int crow(int reg, int h) { return (reg & 3) + 8 * (reg >> 2) + 4 * h; }
#define MFMA32(a, b, c) __builtin_amdgcn_mfma_f32_32x32x16_bf16((a), (b), (c), 0, 0, 0)
DI bf16x8 pack_step(const f32x16& x, int s) {
    u32x4 p; p.x = pk2(x[8 * s], x[8 * s + 1]); p.y = pk2(x[8 * s + 2], x[8 * s + 3]); p.z = pk2(x[8 * s + 4], x[8 * s + 5]); p.w = pk2(x[8 * s + 6], x[8 * s + 7]);
    return __builtin_bit_cast(bf16x8, p);
}
#define ATTN_STEP(KT, BUF, KREG, VREG) \
            { LAS unsigned char* kb = kbuf + BUF * 9216; LAS unsigned char* vb = vbuf + BUF * 8704; \
            *(LAS u32x4*)(kb + lr * 144 + lsg * 16) = KREG; \
            { u32x2 a; a.x = VREG.x; a.y = VREG.y; u32x2 c; c.x = VREG.z; c.y = VREG.w; \
              *(LAS u32x2*)(vb + lr * 136 + lsg * 16) = a; *(LAS u32x2*)(vb + lr * 136 + lsg * 16 + 8) = c; } \
            __syncthreads(); \
            if (KT + 2 <= kthi) { KREG = *(const GAS u32x4*)(kgp + (size_t)(KT + 2) * 64 * 512); VREG = *(const GAS u32x4*)(vgp + (KT + 2) * 64); } \
            if (KT + 8 >= cc && KT <= cc) { \
                f32x16 s0, s1; \
_Pragma("unroll") \
                for (int i = 0; i < 16; ++i) { s0[i] = 0.f; s1[i] = 0.f; } \
_Pragma("unroll") \
                for (int ks = 0; ks < 4; ++ks) { \
                    const bf16x8 k0 = *(const LAS bf16x8*)(kb + n * 144 + ks * 32 + gq * 16), k1 = *(const LAS bf16x8*)(kb + (32 + n) * 144 + ks * 32 + gq * 16); \
                    s0 = MFMA32(k0, Qf[ks], s0); s1 = MFMA32(k1, Qf[ks], s1); \
                } \
                const int delta = cc - (KT); \
                if (delta < 3) { const int base = 64 * delta + qh * 32 + n + 128; \
_Pragma("unroll") \
                    for (int i = 0; i < 16; ++i) { const int key = crow(i, gq); int i0 = base - key, i1 = base - key - 32; \
                        i0 = i0 > 256 ? 256 : i0; i1 = i1 > 256 ? 256 : i1; i0 = i0 < 0 ? 0 : i0; i1 = i1 < 0 ? 0 : i1; \
                        s0[i] += bth[i0]; s1[i] += bth[i1]; } \
                } \
                float mx = s0[0]; \
_Pragma("unroll") \
                for (int i = 1; i < 16; ++i) mx = fmaxf(mx, s0[i]); \
_Pragma("unroll") \
                for (int i = 0; i < 16; ++i) mx = fmaxf(mx, s1[i]); \
                mx = fmaxf(mx, shx(mx, lane, 32)); \
                const float mnew = fmaxf(mrun, mx), alpha = __builtin_amdgcn_exp2f(mrun - mnew); mrun = mnew; \
                float ps = 0.f; \
_Pragma("unroll") \
                for (int i = 0; i < 16; ++i) { s0[i] = __builtin_amdgcn_exp2f(s0[i] - mnew); s1[i] = __builtin_amdgcn_exp2f(s1[i] - mnew); ps += s0[i] + s1[i]; } \
                lrun = lrun * alpha + ps; \
_Pragma("unroll") \
                for (int i = 0; i < 16; ++i) { O0[i] *= alpha; O1[i] *= alpha; } \
_Pragma("unroll") \
                for (int kg = 0; kg < 2; ++kg) \
_Pragma("unroll") \
                    for (int s = 0; s < 2; ++s) { \
                        const bf16x8 Pf = pack_step(kg == 0 ? s0 : s1, s); \
                        const LAS unsigned char* v0 = vb + n * 136 + 64 * kg + 32 * s + 8 * gq; \
                        const s16x4 lo0 = *(const LAS s16x4*)(v0), hi0 = *(const LAS s16x4*)(v0 + 16); \
                        const s16x4 lo1 = *(const LAS s16x4*)(v0 + 32 * 136), hi1 = *(const LAS s16x4*)(v0 + 32 * 136 + 16); \
                        const bf16x8 V0 = __builtin_shufflevector(lo0, hi0, 0, 1, 2, 3, 4, 5, 6, 7), V1 = __builtin_shufflevector(lo1, hi1, 0, 1, 2, 3, 4, 5, 6, 7); \
                        O0 = MFMA32(V0, Pf, O0); O1 = MFMA32(V1, Pf, O1); \
                    } \
            } }
DI void attn_phase(const Params& P, int l, LAS unsigned char* lds, int wave_s) {
    const int tid_ = opaque_tid(wave_s), lane = tid_ & 63, wave = __builtin_amdgcn_readfirstlane(tid_ >> 6);
    unsigned char* ws = P.ws;
    const bf16_t* Q = (const bf16_t*)(ws + OFF_Q); const bf16_t* K = (const bf16_t*)(ws + OFF_K); const bf16_t* VT = (const bf16_t*)(ws + OFF_VT);
    bf16_t* ZA = (bf16_t*)P.out;
    LAS float* bt = (LAS float*)lds;
    LAS unsigned char* kbuf = lds + 8448;
    LAS unsigned char* vbuf = kbuf + 2 * 9216;
    const float* relb = P.in[I_RELB] + (size_t)l * 8 * 257;
    for (int i = tid_; i < 8 * 257; i += NTHREADS) bt[i] = (relb[i] - relb[(i / 257) * 257 + 256]) * 1.4426950408889634f;
    __syncthreads();
    const int n = lane & 31, gq = lane >> 5;
    const int ci = wave >> 1, qh = wave & 1;
    const int lr = tid_ >> 3, lsg = tid_ & 7;
    for (int it = blockIdx.x; it < 2048; it += gridDim.x) {
        const int y = it >> 4, cg4 = ((it & 15) + (it >> 8)) & 15, hd = y & 7, b = y >> 3;
        const int c0 = cg4 * 4, cc = c0 + ci;
        const int ktlo = c0 > 8 ? c0 - 8 : 0, kthi = c0 + 3;
        const size_t tok0 = (size_t)b * SEQ + cc * 64 + qh * 32;
        bf16x8 Qf[4];
        { const bf16_t* qp = Q + (tok0 + n) * 512 + hd * 64 + gq * 8;
#pragma unroll
          for (int ks = 0; ks < 4; ++ks) Qf[ks] = *(const GAS bf16x8*)(qp + ks * 16); }
        f32x16 O0, O1;
#pragma unroll
        for (int i = 0; i < 16; ++i) { O0[i] = 0.f; O1[i] = 0.f; }
        float mrun = -1e30f, lrun = 0.f;
        const LAS float* bth = bt + hd * 257;
        const bf16_t* kgp = K + ((size_t)b * SEQ + lr) * 512 + hd * 64 + lsg * 8;
        const bf16_t* vgp = VT + (((size_t)b * 8 + hd) * 64 + lr) * SEQ + lsg * 8;
        u32x4 kregA = *(const GAS u32x4*)(kgp + (size_t)ktlo * 64 * 512), vregA = *(const GAS u32x4*)(vgp + ktlo * 64);
        u32x4 kregB = *(const GAS u32x4*)(kgp + (size_t)(ktlo + 1) * 64 * 512), vregB = *(const GAS u32x4*)(vgp + (ktlo + 1) * 64);
        for (int kt = ktlo; kt <= kthi; kt += 2) {
            ATTN_STEP(kt, 0, kregA, vregA)
            ATTN_STEP(kt + 1, 1, kregB, vregB)
        }
        lrun += shx(lrun, lane, 32);
        const float inv = 1.f / lrun;
        bf16_t* op = ZA + (tok0 + n) * 1024 + 512 + hd * 64 + gq * 4;
#pragma unroll
        for (int g4 = 0; g4 < 4; ++g4) {
            u32x2 w0, w1;
            w0.x = pk2(O0[4 * g4] * inv, O0[4 * g4 + 1] * inv); w0.y = pk2(O0[4 * g4 + 2] * inv, O0[4 * g4 + 3] * inv);
            w1.x = pk2(O1[4 * g4] * inv, O1[4 * g4 + 1] * inv); w1.y = pk2(O1[4 * g4 + 2] * inv, O1[4 * g4 + 3] * inv);
            *(GAS u32x2*)(op + 8 * g4) = w0; *(GAS u32x2*)(op + 32 + 8 * g4) = w1;
        }
        __syncthreads();
    }
}

__global__ void __launch_bounds__(NTHREADS, 2) mk_fwd(Params P) {
    extern __shared__ __attribute__((aligned(16))) unsigned char lds_raw[];
    LAS unsigned char* lds = (LAS unsigned char*)lds_raw;
    cg::grid_group grid = cg::this_grid();
    const int tid = threadIdx.x, lane = tid & 63, wave = __builtin_amdgcn_readfirstlane(tid >> 6);
    const int G = gridDim.x, bx = blockIdx.x;
    unsigned char* ws = P.ws;
    const int gw = bx * NWAVES + wave, NGW = G * NWAVES;
    volatile LAS unsigned* xst = (volatile LAS unsigned*)(lds + LDS_MAIN);
    if (tid == 0) { xst[0] = 0u; xst[1] = 0u; }
    __syncthreads();
    XcdBarrier xbar; xbar.bar = (unsigned*)(ws + OFF_BAR); xbar.x = xb_xcc_id(); xbar.st = xst;
    if (tid == 0) (void)xb_add(&xbar.bar[XB_XCNT(xbar.x)], 1u);

    {
        _Pragma("unroll 1") for (int rp_ = 0; rp_ < REP_PRO; ++rp_) {
        for (int lg = bx; lg < 128; lg += G) s5_tables(P, lds, lg);
        __syncthreads();
        LAS float* scr = (LAS float*)(lds + wave * 8704);
        for (int it = gw; it < 4 * 11776; it += NGW) {
            const int l = it / 11776; int r = it - l * 11776;
            if (r < 6 * 1408) {
                const int which = r / 1408, f = which & 1, kind = which >> 1; r -= which * 1408;
                bf16_t* wgu = (bf16_t*)(ws + OFF_WGU + (size_t)(l * 2 + f) * SZ_WGU);
                const float* gk = P.in[I_GAINS] + (size_t)(l * 6 + 4 * f) * 1024;
                if (kind == 0) cvt_item(P.in[I_WGATE] + (size_t)(l * 2 + f) * 1024 * 2816, 1024, 2816, wgu, 1024, 0, 1, scr, r, lane, gk);
                else if (kind == 1) cvt_item(P.in[I_WUP] + (size_t)(l * 2 + f) * 1024 * 2816, 1024, 2816, wgu, 1024, 0, 2, scr, r, lane, gk);
                else cvt_item(P.in[I_WDOWN] + (size_t)(l * 2 + f) * 2816 * 1024, 2816, 1024, (bf16_t*)(ws + OFF_WD + (size_t)(l * 2 + f) * SZ_WD), 2816, 0, 0, scr, r, lane);
                continue;
            }
            r -= 6 * 1408;
            if (r < 2048) { cvt_item(P.in[I_WIN] + (size_t)l * 1024 * 4096, 1024, 4096, (bf16_t*)(ws + OFF_WIN + (size_t)l * SZ_WIN), 1024, 0, 3, scr, r, lane, P.in[I_GAINS] + (size_t)(l * 6 + 2) * 1024); continue; }
            r -= 2048;
            if (r < 256) { const int gsel = r >> 7; r &= 127;
                cvt_item(P.in[gsel ? I_GLUG : I_GLUV] + (size_t)l * 512 * 512, 512, 512, (bf16_t*)(ws + OFF_WGL + (size_t)l * SZ_WGL), 512, 0, 1 + gsel, scr, r, lane); continue; }
            r -= 256;
            if (r < 512) { const int osel = r >> 8; r &= 255;
                cvt_item(P.in[osel ? I_OATT : I_OSSM] + (size_t)l * 512 * 1024, 512, 1024, (bf16_t*)(ws + OFF_WOUT + (size_t)l * SZ_WOUT), 1024, osel * 512, 0, scr, r, lane); continue; }
            r -= 512;
            cvt_item(P.in[I_WO] + (size_t)l * 1024 * 1024, 1024, 1024, (bf16_t*)(ws + OFF_WO + (size_t)l * SZ_WO), 1024, 0, 0, scr, r, lane);
        }
        __syncthreads();
        }
        ew_phase(P, true, false, 0.f, nullptr, wave);
        __syncthreads();
    }
    grid.sync();

    for (int step = 0; step < 12; ++step) {
        const int l = step / 3, s = step % 3;
        unsigned char* ws = P.ws; asm volatile("" : "+s"(ws));
        pg8::Gemm gfin;
        if (s != 1) {
            const int f = s >> 1;
            pg8::Gemm g{(const char*)(ws + OFF_XN), (const char*)(ws + OFF_WGU + (size_t)(l * 2 + f) * SZ_WGU), 1024, 1024, (size_t)256 * 1024 * 2, 0, (size_t)256 * 1024 * 2, 0, 16, 0};
            pg8::Order S; S.init(256, 22, 1, 0, G, bx);
            EpiGated<0> E{(bf16_t*)(ws + OFF_H), 2816, (const float*)(ws + OFF_RS)};
            _Pragma("unroll 1") for (int rep_ = 0; rep_ < REP_GEMM; ++rep_) pg8::gemm_phase(lds, g, S, E, wave);
            GSYNC();
            gfin = pg8::Gemm{(const char*)(ws + OFF_H), (const char*)(ws + OFF_WD + (size_t)(l * 2 + f) * SZ_WD), 2816, 2816, (size_t)256 * 2816 * 2, 0, (size_t)256 * 2816 * 2, 0, 44, 0};
        } else {
            {
                pg8::Gemm g{(const char*)(ws + OFF_XN), (const char*)(ws + OFF_WIN + (size_t)l * SZ_WIN), 1024, 1024, (size_t)256 * 1024 * 2, 0, (size_t)256 * 1024 * 2, 0, 16, 0};
                pg8::Order S; S.init(256, 16, 1, 0, G, bx);
                EpiWin E{(bf16_t*)(ws + OFF_U), (bf16_t*)(ws + OFF_Q), (bf16_t*)(ws + OFF_K), (bf16_t*)(ws + OFF_VT), (bf16_t*)(ws + OFF_M1), (bf16_t*)(ws + OFF_SB), (const float*)(ws + OFF_RS)};
                _Pragma("unroll 1") for (int rep_ = 0; rep_ < REP_GEMM; ++rep_) pg8::gemm_phase(lds, g, S, E, wave);
            }
            GSYNC();
            {
                pg8::Gemm g{(const char*)(ws + OFF_U) + 256, (const char*)(ws + OFF_W1), 1152, 1024, (size_t)256 * 1152 * 2, (size_t)1024 * 1152 * 2, 0, (size_t)256 * 1024 * 2, 16, 0};
                pg8::Order S; S.init(4, 1, 32, 1, G, bx);
                EpiS E{(float*)(ws + OFF_S)};
                _Pragma("unroll 1") for (int rep_ = 0; rep_ < REP_GEMM; ++rep_) pg8::gemm_phase(lds, g, S, E, wave);
                __syncthreads();
                _Pragma("unroll 1") for (int rep_ = 0; rep_ < REP_ATTN; ++rep_) attn_phase(P, l, lds, wave);
            }
            GSYNC();
            _Pragma("unroll 1") for (int rc_ = 0; rc_ < REP_CARRY; ++rc_) carry_phase(P, l, wave);
            GSYNC();
            {
                pg8::Gemm g{(const char*)(ws + OFF_U), (const char*)(ws + OFF_W2), 1152, 1152, (size_t)256 * 1152 * 2, (size_t)1024 * 1152 * 2, (size_t)256 * 1152 * 2, (size_t)1024 * 1152 * 2, 6, 4};
                pg8::Order S; S.init(4, 4, 32, 2, G, bx);
                EpiY E{(bf16_t*)(ws + OFF_Q)};
                _Pragma("unroll 1") for (int rep_ = 0; rep_ < REP_GEMM; ++rep_) pg8::gemm_phase(lds, g, S, E, wave);
            }
            GSYNC();
            {
                pg8::Gemm g{(const char*)(ws + OFF_Q), (const char*)(ws + OFF_WGL + (size_t)l * SZ_WGL), 512, 512, (size_t)256 * 512 * 2, 0, (size_t)256 * 512 * 2, 0, 8, 0};
                pg8::Order S; S.init(256, 4, 1, 0, G, bx);
                EpiGated<1> E{(bf16_t*)P.out, 1024, nullptr};
                _Pragma("unroll 1") for (int rep_ = 0; rep_ < REP_GEMM; ++rep_) pg8::gemm_phase(lds, g, S, E, wave);
            }
            GSYNC();
            {
                pg8::Gemm g{(const char*)P.out, (const char*)(ws + OFF_WOUT + (size_t)l * SZ_WOUT), 1024, 1024, (size_t)256 * 1024 * 2, 0, (size_t)256 * 1024 * 2, 0, 16, 0};
                pg8::Order S; S.init(256, 4, 1, 0, G, bx);
                EpiMerge E{(const bf16_t*)(ws + OFF_M1), (const bf16_t*)(ws + OFF_SB), (bf16_t*)(ws + OFF_K), wave};
                _Pragma("unroll 1") for (int rep_ = 0; rep_ < REP_GEMM; ++rep_) pg8::gemm_phase(lds, g, S, E, wave);
            }
            GSYNC();
            gfin = pg8::Gemm{(const char*)(ws + OFF_K), (const char*)(ws + OFF_WO + (size_t)l * SZ_WO), 1024, 1024, (size_t)256 * 1024 * 2, 0, (size_t)256 * 1024 * 2, 0, 16, 0};
        }
        {
            pg8::Order S; S.init(256, 4, 1, 0, G, bx);
            EpiDown E{(bf16_t*)(ws + OFF_M1), (float*)(ws + OFF_SSP)};
            _Pragma("unroll 1") for (int rep_ = 0; rep_ < REP_GEMM; ++rep_) pg8::gemm_phase(lds, gfin, S, E, wave);
        }
        GSYNC();
        {
            const float* gains = P.in[I_GAINS];
            ew_phase(P, false, step == 11, s == 1 ? 1.f : 0.5f, gains + (size_t)(2 * step + 1) * 1024, wave);
            if (s == 0) { _Pragma("unroll 1") for (int rb_ = 0; rb_ < REP_BUILD; ++rb_) build_w12(P, l, wave); }
        }
        if (step != 11) GSYNC();
    }
}

extern "C" void kernel_launch(void* const* d_in, const int* in_sizes, int n_in, void* d_out, int out_size, void* d_ws, size_t ws_size, hipStream_t stream) {
    static int grid = 0;
    if (grid == 0) {
        if (n_in != 20 || out_size != NTOK * DM || ws_size < WS_END) { fprintf(stderr, "kernel_launch: unexpected shapes: n_in %d out %d ws %zu (need %zu)\n", n_in, out_size, ws_size, (size_t)WS_END); grid = -1; return; }
        int dev = 0, cus = 0, per_cu = 0;
        hipGetDevice(&dev);
        hipDeviceGetAttribute(&cus, hipDeviceAttributeMultiprocessorCount, dev);
        if (hipFuncSetAttribute((const void*)mk_fwd, hipFuncAttributeMaxDynamicSharedMemorySize, LDS_BYTES) != hipSuccess) { fprintf(stderr, "kernel_launch: hipFuncSetAttribute failed\n"); grid = -1; return; }
        if (hipOccupancyMaxActiveBlocksPerMultiprocessor(&per_cu, (const void*)mk_fwd, NTHREADS, LDS_BYTES) != hipSuccess || per_cu < 1) { fprintf(stderr, "kernel_launch: occupancy query failed (%d)\n", per_cu); per_cu = 1; }
        (void)hipGetLastError();
        grid = cus * per_cu;
    }
    if (grid < 0) return;
    if (hipMemsetAsync((char*)d_ws + OFF_BAR, 0, BAR_BYTES, stream) != hipSuccess) { fprintf(stderr, "kernel_launch: memset failed\n"); return; }
    Params p{};
    for (int i = 0; i < 20; ++i) p.in[i] = (const float*)d_in[i];
    p.out = (float*)d_out; p.ws = (unsigned char*)d_ws;
    void* args[] = {&p};
    hipError_t e = hipLaunchCooperativeKernel((const void*)mk_fwd, dim3(grid), dim3(NTHREADS), args, LDS_BYTES, stream);
    if (e != hipSuccess) fprintf(stderr, "cooperative launch failed: %s (grid %d)\n", hipGetErrorString(e), grid);
}
```

```cpp
#include <hip/hip_runtime.h>
#include <hip/hip_cooperative_groups.h>
#include <cstdio>
#include <cstdint>
namespace cg = cooperative_groups;

#define LAS __attribute__((address_space(3)))
#define GAS __attribute__((address_space(1)))
typedef unsigned short bf16_t;
typedef short bf16x8 __attribute__((ext_vector_type(8)));
typedef short s16x4 __attribute__((ext_vector_type(4)));
typedef float f32x4 __attribute__((ext_vector_type(4)));
typedef float f32x2 __attribute__((ext_vector_type(2)));
typedef float f32x16 __attribute__((ext_vector_type(16)));
typedef unsigned u32x4 __attribute__((ext_vector_type(4)));
typedef unsigned u32x2 __attribute__((ext_vector_type(2)));
typedef __bf16 bf2_t __attribute__((ext_vector_type(2)));
#define DI __device__ __forceinline__

constexpr int NTOK = 65536, DM = 1024, FF = 2816, NL = 4, NGRP = 32, SEQ = 4096;
constexpr float RMS_EPS = 1e-6f;
constexpr int NTHREADS = 512, NWAVES = 8;
constexpr int LDS_MAIN = 131072, LDS_BYTES = LDS_MAIN + 16;
#ifndef REP_GEMM
#define REP_GEMM 1
#endif
#ifndef REP_SYNC
#define REP_SYNC 1
#endif
#ifndef REP_EW
#define REP_EW 0
#endif
#ifndef REP_PRO
#define REP_PRO 1
#endif
#ifndef REP_CARRY
#define REP_CARRY 1
#endif
#ifndef REP_BUILD
#define REP_BUILD 1
#endif
#define GSYNC() do { _Pragma("unroll 1") for (int rs_ = 0; rs_ < REP_SYNC; ++rs_) xcd_barrier(xbar, wave); } while (0)
#ifndef REP_ATTN
#define REP_ATTN 1
#endif

constexpr size_t SZ_WGU = (size_t)5632 * 1024 * 2, SZ_WD = (size_t)1024 * 2816 * 2, SZ_WIN = (size_t)4096 * 1024 * 2;
constexpr size_t SZ_WGL = (size_t)1024 * 512 * 2, SZ_WOUT = (size_t)1024 * 1024 * 2, SZ_WO = (size_t)1024 * 1024 * 2;
constexpr size_t OFF_WGU = 0;
constexpr size_t OFF_WD = OFF_WGU + 8 * SZ_WGU;
constexpr size_t OFF_WIN = OFF_WD + 8 * SZ_WD;
constexpr size_t OFF_WGL = OFF_WIN + 4 * SZ_WIN;
constexpr size_t OFF_WOUT = OFF_WGL + 4 * SZ_WGL;
constexpr size_t OFF_WO = OFF_WOUT + 4 * SZ_WOUT;
constexpr size_t SZ_PW1 = (size_t)65 * 64 * 2 * 4;
constexpr size_t SZ_BB1 = (size_t)64 * 16 * 2 * 4;
constexpr size_t SZ_KE1 = (size_t)64 * 256 * 4;
constexpr size_t OFF_PW = OFF_WO + 4 * SZ_WO;
constexpr size_t OFF_BB = OFF_PW + 128 * SZ_PW1;
constexpr size_t OFF_KERN = OFF_BB + 128 * SZ_BB1;
constexpr size_t OFF_W1 = OFF_KERN + 128 * SZ_KE1;
constexpr size_t OFF_W2 = OFF_W1 + (size_t)32 * 256 * 1024 * 2;
constexpr size_t OFF_XN = OFF_W2 + (size_t)32 * 1024 * 1152 * 2;
constexpr size_t OFF_M1 = OFF_XN + (size_t)NTOK * 1024 * 2;
constexpr size_t OFF_SSP = OFF_M1 + (size_t)NTOK * 1024 * 2;
constexpr size_t OFF_RS = OFF_SSP + (size_t)64 * NTOK * 4;
constexpr size_t OFF_OV = OFF_RS + (size_t)NTOK * 4;
constexpr size_t OFF_H = OFF_OV;
constexpr size_t OFF_U = OFF_OV;
constexpr size_t OFF_Q = OFF_U + (size_t)32 * 1024 * 1152 * 2;
constexpr size_t OFF_K = OFF_Q + (size_t)NTOK * 512 * 2;
constexpr size_t OFF_VT = OFF_K + (size_t)NTOK * 512 * 2;
constexpr size_t OFF_SB = OFF_VT + (size_t)NTOK * 512 * 2;
constexpr size_t OFF_S = OFF_SB + (size_t)NTOK * 1024 * 2;
constexpr size_t OV_MIX = OFF_S + (size_t)32 * 1024 * 128 * 4 - OFF_OV;
constexpr size_t OV_FFN = (size_t)NTOK * 2816 * 2;
constexpr size_t OFF_BAR = OFF_OV + (OV_MIX > OV_FFN ? OV_MIX : OV_FFN);
constexpr size_t BAR_BYTES = 32768;
constexpr size_t WS_END = OFF_BAR + BAR_BYTES;

DI const char* uni_ptr(const char* p) { const unsigned long long v = (unsigned long long)p; const unsigned lo = __builtin_amdgcn_readfirstlane((unsigned)v), hi = __builtin_amdgcn_readfirstlane((unsigned)(v >> 32)); return (const char*)(((unsigned long long)hi << 32) | lo); }
DI int opaque_tid(int wave_s) { int t = wave_s * 64 + (int)__builtin_amdgcn_mbcnt_hi(~0u, __builtin_amdgcn_mbcnt_lo(~0u, 0u)); asm volatile("" : "+v"(t)); return t; }
DI unsigned pk2(float a, float b) { f32x2 v = {a, b}; bf2_t r = __builtin_convertvector(v, bf2_t); return __builtin_bit_cast(unsigned, r); }
DI float bflo(unsigned u) { return __uint_as_float(u << 16); }
DI float bfhi(unsigned u) { return __uint_as_float(u & 0xffff0000u); }
DI float shx(float v, int lane, int o) { return __int_as_float(__builtin_amdgcn_ds_bpermute((lane ^ o) << 2, __float_as_int(v))); }
DI float wave_sum(float v, int lane) {
#pragma unroll
    for (int o = 1; o < 64; o <<= 1) v += shx(v, lane, o);
    return v;
}
DI float fsigmoid(float x) { return __builtin_amdgcn_rcpf(1.f + __expf(-x)); }
DI float fsilu(float x) { return x * fsigmoid(x); }
DI float fgelu_tanh(float x) { return x * fsigmoid(1.5957691216f * (x + 0.044715f * x * x * x)); }
DI u32x4 pack8(const f32x4 a, const f32x4 b) { u32x4 w; w.x = pk2(a[0], a[1]); w.y = pk2(a[2], a[3]); w.z = pk2(b[0], b[1]); w.w = pk2(b[2], b[3]); return w; }
DI void unpack8(const u32x4 w, f32x4& a, f32x4& b) { a = (f32x4){bflo(w.x), bfhi(w.x), bflo(w.y), bfhi(w.y)}; b = (f32x4){bflo(w.z), bfhi(w.z), bflo(w.w), bfhi(w.w)}; }


#define XB_TMO      128
#define XB_XCNT(j)  (256  + 64 * (j))
#define XB_XSUB(j)  (1280 + 64 * (j))
#define XB_XGEN(j)  (2304 + 64 * (j))
#define XB_TOP      3328
#define XB_TOPGEN   3392
#define XCD_BAR_WORDS 3456
#define XB_SPIN_CAP (1u << 20)
DI unsigned xb_ld(unsigned* p)              { return __hip_atomic_load(p, __ATOMIC_RELAXED, __HIP_MEMORY_SCOPE_AGENT); }
DI unsigned xb_add(unsigned* p, unsigned v) { return __hip_atomic_fetch_add(p, v, __ATOMIC_RELAXED, __HIP_MEMORY_SCOPE_AGENT); }
DI unsigned xb_xcc_id() { return (unsigned)__builtin_amdgcn_s_getreg((3 << 11) | 20) & 0xFu; }
#define XB_SPIN(cond, bar) do { unsigned _sp = 0; while (cond) { __builtin_amdgcn_s_sleep(1); \
    if ((++_sp & 255u) == 0u) { if (xb_ld(&(bar)[XB_TMO])) break; if (_sp > XB_SPIN_CAP) { atomicAdd(&(bar)[XB_TMO], 1u); break; } } } } while (0)
struct XcdBarrier { unsigned* bar; unsigned x; volatile LAS unsigned* st; };
DI void xcd_barrier_complete(unsigned* bar, unsigned x, unsigned& nloc, unsigned& nx) {
    const unsigned G = gridDim.x;
    unsigned sum, cnt, mine, sp = 0u;
    for (;;) {
        sum = 0u; cnt = 0u; mine = 0u;
#pragma unroll
        for (unsigned j = 0; j < 16; ++j) { const unsigned c = xb_ld(&bar[XB_XCNT(j)]); sum += c; cnt += (c > 0u) ? 1u : 0u; mine = (j == x) ? c : mine; }
        if (sum == G) break;
        __builtin_amdgcn_s_sleep(1);
        if ((++sp & 255u) == 0u) { if (xb_ld(&bar[XB_TMO])) break; if (sp > XB_SPIN_CAP) { atomicAdd(&bar[XB_TMO], 1u); break; } }
    }
    nloc = mine > 0u ? mine : 1u; nx = cnt > 0u ? cnt : 1u;
}
DI void xcd_barrier(const XcdBarrier& b, int wave_s) {
    asm volatile("s_waitcnt vmcnt(0)" ::: "memory");
    __syncthreads();
    if (opaque_tid(wave_s) == 0) {
        unsigned* bar = b.bar;
        __builtin_amdgcn_s_waitcnt(0);
        unsigned nloc = b.st[0], nx = b.st[1];
        if (nloc == 0u) { xcd_barrier_complete(bar, b.x, nloc, nx); b.st[0] = nloc; b.st[1] = nx; }
        const unsigned old = xb_add(&bar[XB_XSUB(b.x)], 1u);
        const unsigned gen = old / nloc;
        if (old + 1u == (gen + 1u) * nloc) {
            __builtin_amdgcn_fence(__ATOMIC_RELEASE, "agent");
            asm volatile("s_waitcnt vmcnt(0)" ::: "memory");
            const unsigned og = xb_add(&bar[XB_TOP], 1u);
            const unsigned tg = og / nx;
            if (og + 1u == (tg + 1u) * nx) xb_add(&bar[XB_TOPGEN], 1u);
            else XB_SPIN(xb_ld(&bar[XB_TOPGEN]) == tg, bar);
            __builtin_amdgcn_fence(__ATOMIC_ACQUIRE, "agent");
            xb_add(&bar[XB_XGEN(b.x)], 1u);
            asm volatile("s_waitcnt vmcnt(0)" ::: "memory");
        } else {
            XB_SPIN(xb_ld(&bar[XB_XGEN(b.x)]) == gen, bar);
            __builtin_amdgcn_fence(__ATOMIC_ACQUIRE, "agent");
            asm volatile("s_waitcnt vmcnt(0)" ::: "memory");
        }
    }
    __syncthreads();
}

DI void vx_barrier(unsigned* cnt, unsigned target, int wave_s) {
    asm volatile("s_waitcnt vmcnt(0)" ::: "memory");
    __syncthreads();
    if (opaque_tid(wave_s) == 0) {
        __builtin_amdgcn_s_waitcnt(0);
        (void)xb_add(cnt, 1u);
        unsigned sp = 0u;
        while (xb_ld(cnt) < target) { __builtin_amdgcn_s_sleep(1); if (++sp > (1u << 22)) break; }
        __builtin_amdgcn_fence(__ATOMIC_ACQUIRE, "agent");
        asm volatile("s_waitcnt vmcnt(0)" ::: "memory");
    }
    __syncthreads();
}

namespace pg8 {
constexpr int BM = 256, BK = 64, HALF = 128, HTB = HALF * BK * 2, STAGE_BYTES = 8 * HTB, NXCD = 8, WGM = 8;
DI int lds_byte(int r, int c) { const int st = (r >> 4) * 2 + (c >> 5), rr = r & 15, cc = c & 31, ob = rr * 64 + cc * 2; return st * 1024 + (ob ^ (((ob >> 9) & 1) << 5)); }
DI void stage_rc(int b, int& R, int& C) { const int st = b / 1024, sb = b % 1024, swz = sb ^ (((sb >> 9) & 1) << 5); R = (st >> 1) * 16 + swz / 64; C = (st & 1) * 32 + (swz % 64) / 2; }
DI int perm32(int rho) { const int n = rho >> 4, i = rho & 15; return 8 * (i >> 2) + 4 * n + (i & 3); }

struct Unit { int pm, pn, pb; };
struct Gemm { const char* A; const char* B; int lda, ldb; size_t a_pm, a_pb, b_pn, b_pb; int nt0, ntstep; };
struct Order {
    int nM, nN, nB, nwg, G, c, mode;
    DI void init(int nM_, int nN_, int nB_, int mode_, int G_, int c_) { nM = nM_; nN = nN_; nB = nB_; mode = mode_; nwg = nM * nN * nB; G = G_; c = c_; }
    DI bool next(int i, Unit& u) const {
        const long L = (long)i * G + c; if (L >= nwg) return false;
        if (mode == 0) {
            int wgid = (int)L; { const int q = nwg / NXCD, r = nwg % NXCD, xcd = wgid % NXCD, off = wgid / NXCD; wgid = (xcd < r ? xcd * (q + 1) : r * (q + 1) + (xcd - r) * q) + off; }
            const int nig = WGM * nN, gid = wgid / nig, fm = gid * WGM, gsz = (nM - fm) < WGM ? (nM - fm) : WGM;
            u.pm = fm + ((wgid % nig) % gsz); u.pn = (wgid % nig) / gsz; u.pb = 0;
        } else {
            const int per = nM * nN, l = (int)L; u.pb = l / per; const int rem = l % per; u.pm = rem / nN; int pn = rem % nN;
            if (mode == 2 && (i & 1)) pn = nN - 1 - pn;
            u.pn = pn;
        }
        u.pm = __builtin_amdgcn_readfirstlane(u.pm); u.pn = __builtin_amdgcn_readfirstlane(u.pn); u.pb = __builtin_amdgcn_readfirstlane(u.pb);
        return true;
    }
};

template <class Epi>
DI void gemm_phase(LAS unsigned char* lds, const Gemm g, const Order& S, const Epi& E, int wave_s) {
    const int tid = opaque_tid(wave_s);
    const int wid = __builtin_amdgcn_readfirstlane(tid >> 6), lane = tid & 63, wr = wid >> 2, wc = wid & 3, fr = lane & 15, fq = lane >> 4;
    unsigned voffA[2], voffB[2];
#pragma unroll
    for (int i = 0; i < 2; ++i) { int R, C; stage_rc(tid * 16 + i * 8192, R, C); const int Rb = (R & ~31) + perm32(R & 31);
        voffA[i] = (unsigned)(R * g.lda + C) * 2u; voffB[i] = (unsigned)(Rb * g.ldb + C) * 2u; }
    const size_t kstep = (size_t)(BK * 2);
    const size_t hstepA = (size_t)HALF * g.lda * 2, hstepB = (size_t)HALF * g.ldb * 2;
    const unsigned ldsw = (unsigned)wid * 1024u;
    const int aoff = lds_byte(wr * 64 + fr, fq * 8), boff = lds_byte(wc * 32 + fr, fq * 8);
#define PG8_SA(b, h) (((b) * 2 + (h)) * HTB)
#define PG8_SB(b, h) ((4 + (b) * 2 + (h)) * HTB)
#define PG8_STAGE(bufoff, gbase, voff) do { _Pragma("unroll") for (int _i = 0; _i < 2; ++_i) \
        __builtin_amdgcn_global_load_lds((const unsigned*)((const char*)(gbase) + (voff)[_i]), (LAS unsigned*)(lds + (bufoff) + ldsw + _i * 8192), 16, 0, 0); } while (0)
#define PG8_LDA(dst, b, h) do { _Pragma("unroll") for (int m = 0; m < 4; ++m) _Pragma("unroll") for (int k = 0; k < 2; ++k) dst[m][k] = *(const LAS bf16x8*)(lds + PG8_SA(b, h) + aoff + m * 2048 + k * 1024); } while (0)
#define PG8_LDB(dst, b, h) do { _Pragma("unroll") for (int n = 0; n < 2; ++n) _Pragma("unroll") for (int k = 0; k < 2; ++k) dst[n][k] = *(const LAS bf16x8*)(lds + PG8_SB(b, h) + boff + n * 2048 + k * 1024); } while (0)
#define PG8_MMA(ai, bj, At, Bt) do { __builtin_amdgcn_s_setprio(1); _Pragma("unroll") for (int m = 0; m < 4; ++m) _Pragma("unroll") for (int n = 0; n < 2; ++n) _Pragma("unroll") for (int k = 0; k < 2; ++k) \
        acc[ai][bj][m][n] = __builtin_amdgcn_mfma_f32_16x16x32_bf16(Bt[n][k], At[m][k], acc[ai][bj][m][n], 0, 0, 0); __builtin_amdgcn_s_setprio(0); } while (0)
#define PG8_WAIT_V(n) asm volatile("s_waitcnt vmcnt(" #n ")" ::: "memory")
#define PG8_WAIT_L(n) asm volatile("s_waitcnt lgkmcnt(" #n ")" ::: "memory")
#define PG8_BAR __builtin_amdgcn_s_barrier()
#define PG8_SCHED __builtin_amdgcn_sched_barrier(0)
    Unit cur, nxt; int ui = 0;
    if (!S.next(0, cur)) return;
    f32x4 acc[2][2][4][2];
#pragma unroll
    for (int a = 0; a < 2; ++a)
#pragma unroll
        for (int b = 0; b < 2; ++b)
#pragma unroll
            for (int m = 0; m < 4; ++m)
#pragma unroll
                for (int n = 0; n < 2; ++n) acc[a][b][m][n] = (f32x4){0.f, 0.f, 0.f, 0.f};
    bf16x8 At[4][2], B0[2][2], B1[2][2];
    const char* cA = uni_ptr(g.A + (size_t)cur.pb * g.a_pb + (size_t)cur.pm * g.a_pm);
    const char* cB = uni_ptr(g.B + (size_t)cur.pb * g.b_pb + (size_t)cur.pn * g.b_pn);
    PG8_STAGE(PG8_SB(0, 0), cB, voffB); PG8_STAGE(PG8_SB(0, 1), cB + hstepB, voffB); PG8_STAGE(PG8_SA(0, 0), cA, voffA); PG8_STAGE(PG8_SA(0, 1), cA + hstepA, voffA);
    if (wr == 1) PG8_BAR;
    PG8_WAIT_V(2); PG8_BAR;
    PG8_STAGE(PG8_SB(1, 0), cB + kstep, voffB); PG8_STAGE(PG8_SA(1, 0), cA + kstep, voffA); PG8_STAGE(PG8_SB(1, 1), cB + hstepB + kstep, voffB);
    PG8_WAIT_V(6); PG8_BAR;
    for (;;) {
        const bool has_next = S.next(ui + 1, nxt);
        const char* nA = uni_ptr(has_next ? g.A + (size_t)nxt.pb * g.a_pb + (size_t)nxt.pm * g.a_pm : cA);
        const char* nB = uni_ptr(has_next ? g.B + (size_t)nxt.pb * g.b_pb + (size_t)nxt.pn * g.b_pn : cB);
        const int nt = g.nt0 + g.ntstep * cur.pn;
        for (int t = 0; t < nt; t += 2) {
            const bool last = (t == nt - 2);
            if constexpr (Epi::HAS_MID) { if (t == Epi::TMID) E.mid(acc, cur, wr, wc, fr, fq); }
            const char* a1 = cA + (size_t)(t + 1) * kstep;
            const char* a2 = last ? nA : cA + (size_t)(t + 2) * kstep; const char* b2 = last ? nB : cB + (size_t)(t + 2) * kstep;
            const char* a3 = a2 + kstep; const char* b3 = b2 + kstep;
            PG8_LDB(B0, 0, 0); PG8_LDB(B1, 0, 1); PG8_SCHED; PG8_LDA(At, 0, 0); PG8_STAGE(PG8_SA(1, 1), a1 + hstepA, voffA);
            PG8_WAIT_V(8); PG8_WAIT_L(0); PG8_BAR; PG8_MMA(0, 0, At, B0); PG8_MMA(0, 1, At, B1); PG8_BAR; PG8_SCHED;
            PG8_LDA(At, 0, 1); PG8_STAGE(PG8_SB(0, 0), b2, voffB); PG8_STAGE(PG8_SB(0, 1), b2 + hstepB, voffB); PG8_STAGE(PG8_SA(0, 0), a2, voffA);
            PG8_WAIT_V(8); PG8_WAIT_L(0); PG8_BAR; PG8_MMA(1, 0, At, B0); PG8_MMA(1, 1, At, B1); PG8_BAR; PG8_SCHED;
            PG8_LDB(B0, 1, 0); PG8_LDB(B1, 1, 1); PG8_SCHED; PG8_LDA(At, 1, 0); PG8_STAGE(PG8_SA(0, 1), a2 + hstepA, voffA);
            PG8_WAIT_V(8); PG8_WAIT_L(0); PG8_BAR; PG8_MMA(0, 0, At, B0); PG8_MMA(0, 1, At, B1); PG8_BAR; PG8_SCHED;
            PG8_LDA(At, 1, 1); PG8_STAGE(PG8_SB(1, 0), b3, voffB); PG8_STAGE(PG8_SB(1, 1), b3 + hstepB, voffB); PG8_STAGE(PG8_SA(1, 0), a3, voffA);
            PG8_WAIT_V(8); PG8_WAIT_L(0); PG8_BAR; PG8_MMA(1, 0, At, B0); PG8_MMA(1, 1, At, B1); PG8_BAR; PG8_SCHED;
        }
        if (wr == 0) PG8_BAR;
        E(acc, cur, wr, wc, fr, fq);
        if (!has_next) break;
#pragma unroll
        for (int a = 0; a < 2; ++a)
#pragma unroll
            for (int b = 0; b < 2; ++b)
#pragma unroll
                for (int m = 0; m < 4; ++m)
#pragma unroll
                    for (int n = 0; n < 2; ++n) acc[a][b][m][n] = (f32x4){0.f, 0.f, 0.f, 0.f};
        cur = nxt; cA = nA; cB = nB; ++ui;
        if (wr == 1) PG8_BAR;
    }
    PG8_WAIT_V(0);
    PG8_BAR;
#undef PG8_SA
#undef PG8_SB
#undef PG8_STAGE
#undef PG8_LDA
#undef PG8_LDB
#undef PG8_MMA
#undef PG8_WAIT_V
#undef PG8_WAIT_L
#undef PG8_BAR
#undef PG8_SCHED
}
}
using pg8::Unit;
typedef f32x4 AccT[2][2][4][2];

template <int ACT> struct EpiGated {
    static constexpr bool HAS_MID = false; static constexpr int TMID = -1;
    bf16_t* O; int ldc; const float* rs;
    DI void mid(AccT&, const Unit&, int, int, int, int) const {}
    DI void operator()(const AccT& acc, const Unit& u, int wr, int wc, int fr, int fq) const {
        const int row0 = u.pm * 256 + wr * 64 + fr, col0 = u.pn * 128 + wc * 32 + 8 * fq;
#pragma unroll
        for (int ai = 0; ai < 2; ++ai)
#pragma unroll
            for (int m = 0; m < 4; ++m) {
                f32x4 o[2]; const float rv = rs ? ((const GAS float*)rs)[row0 + ai * 128 + m * 16] : 1.f;
#pragma unroll
                for (int n = 0; n < 2; ++n)
#pragma unroll
                    for (int e = 0; e < 4; e += 2) {
                        const float a0 = acc[ai][0][m][n][e] * rv, b0 = acc[ai][1][m][n][e] * rv, a1 = acc[ai][0][m][n][e + 1] * rv, b1 = acc[ai][1][m][n][e + 1] * rv;
                        const float g0 = ACT == 0 ? a0 : b0, g1 = ACT == 0 ? a1 : b1;
                        const float x0 = 1.f + __builtin_amdgcn_exp2f(fminf(-1.4426950408889634f * g0, 57.f)), x1 = 1.f + __builtin_amdgcn_exp2f(fminf(-1.4426950408889634f * g1, 57.f));
                        const float q = __builtin_amdgcn_rcpf(x0 * x1), s0 = q * x1, s1 = q * x0;
                        o[n][e] = (ACT == 0 ? a0 * b0 : a0) * s0; o[n][e + 1] = (ACT == 0 ? a1 * b1 : a1) * s1; }
                *(GAS u32x4*)(O + (size_t)(row0 + ai * 128 + m * 16) * ldc + col0) = pack8(o[0], o[1]);
            }
    }
};
struct EpiDown {
    static constexpr bool HAS_MID = false; static constexpr int TMID = -1;
    bf16_t* O; float* ssp;
    DI void mid(AccT&, const Unit&, int, int, int, int) const {}
    DI void operator()(const AccT& acc, const Unit& u, int wr, int wc, int fr, int fq) const {
        const int row0 = u.pm * 256 + wr * 64 + fr, col0 = u.pn * 256 + wc * 32 + 8 * fq;
#pragma unroll
        for (int ai = 0; ai < 2; ++ai)
#pragma unroll
            for (int m = 0; m < 4; ++m) {
                const int row = row0 + ai * 128 + m * 16; float ss = 0.f;
#pragma unroll
                for (int bj = 0; bj < 2; ++bj) {
                    const f32x4 v0 = acc[ai][bj][m][0], v1 = acc[ai][bj][m][1];
                    ss += (v0[0] * v0[0] + v0[1] * v0[1]) + (v0[2] * v0[2] + v0[3] * v0[3]) + (v1[0] * v1[0] + v1[1] * v1[1]) + (v1[2] * v1[2] + v1[3] * v1[3]);
                    *(GAS u32x4*)(O + (size_t)row * 1024 + col0 + bj * 128) = pack8(v0, v1);
                }
                ((GAS float*)ssp)[(size_t)(u.pn * 16 + wc * 4 + fq) * NTOK + row] = ss;
            }
    }
};
struct EpiWin {
    static constexpr bool HAS_MID = false; static constexpr int TMID = -1;
    bf16_t *U, *Q, *K, *VT, *R, *SB; const float* rs;
    DI void mid(AccT&, const Unit&, int, int, int, int) const {}
    DI void operator()(AccT& acc, const Unit& u, int wr, int wc, int fr, int fq) const {
        const int row0 = u.pm * 256 + wr * 64 + fr, pn = u.pn;
#pragma unroll
        for (int ai = 0; ai < 2; ++ai)
#pragma unroll
            for (int m = 0; m < 4; ++m) { const float rv = ((const GAS float*)rs)[row0 + ai * 128 + m * 16];
#pragma unroll
                for (int bj = 0; bj < 2; ++bj) { acc[ai][bj][m][0] *= rv; acc[ai][bj][m][1] *= rv; } }
        if (pn < 2) {
#pragma unroll
            for (int ai = 0; ai < 2; ++ai)
#pragma unroll
                for (int m = 0; m < 4; ++m) { const int row = row0 + ai * 128 + m * 16, bc = row >> 6, j = row & 63;
#pragma unroll
                    for (int bj = 0; bj < 2; ++bj) { const int c = pn * 256 + bj * 128 + wc * 32 + 8 * fq, gi = c >> 4, h0 = c & 15;
                        *(GAS u32x4*)(U + ((size_t)gi * 1024 + bc) * 1152 + 128 + j * 16 + h0) = pack8(acc[ai][bj][m][0], acc[ai][bj][m][1]); } }
        } else if (pn < 6) {
            bf16_t* O = pn < 4 ? Q : K; const int cb = (pn & 1) * 256 + wc * 32 + 8 * fq;
#pragma unroll
            for (int ai = 0; ai < 2; ++ai)
#pragma unroll
                for (int m = 0; m < 4; ++m) { const int row = row0 + ai * 128 + m * 16;
#pragma unroll
                    for (int bj = 0; bj < 2; ++bj) *(GAS u32x4*)(O + (size_t)row * 512 + cb + bj * 128) = pack8(acc[ai][bj][m][0], acc[ai][bj][m][1]); }
        } else if (pn < 8) {
#pragma unroll
            for (int ai = 0; ai < 2; ++ai)
#pragma unroll
                for (int m = 0; m < 4; ++m) { const int row = row0 + ai * 128 + m * 16, b = row >> 12, s = row & 4095;
#pragma unroll
                    for (int bj = 0; bj < 2; ++bj) { const int c = (pn - 6) * 256 + bj * 128 + wc * 32 + 8 * fq, hd = c >> 6, d0 = c & 63;
                        GAS bf16_t* o = (GAS bf16_t*)(VT + (((size_t)b * 8 + hd) * 64 + d0) * 4096 + s);
                        const u32x4 w = pack8(acc[ai][bj][m][0], acc[ai][bj][m][1]);
                        o[0 * 4096] = (bf16_t)(w.x & 0xffff); o[1 * 4096] = (bf16_t)(w.x >> 16); o[2 * 4096] = (bf16_t)(w.y & 0xffff); o[3 * 4096] = (bf16_t)(w.y >> 16);
                        o[4 * 4096] = (bf16_t)(w.z & 0xffff); o[5 * 4096] = (bf16_t)(w.z >> 16); o[6 * 4096] = (bf16_t)(w.w & 0xffff); o[7 * 4096] = (bf16_t)(w.w >> 16); } }
        } else {
            const int cb = (pn - 8) * 128 + wc * 32 + 8 * fq;
#pragma unroll
            for (int ai = 0; ai < 2; ++ai)
#pragma unroll
                for (int m = 0; m < 4; ++m) { const int row = row0 + ai * 128 + m * 16; f32x4 r[2], sb[2];
#pragma unroll
                    for (int n = 0; n < 2; ++n)
#pragma unroll
                        for (int e = 0; e < 4; ++e) {
                            const float ea = __builtin_amdgcn_exp2f(fminf(-1.4426950408889634f * acc[ai][0][m][n][e], 57.f)), eb = __builtin_amdgcn_exp2f(fminf(-1.4426950408889634f * acc[ai][1][m][n][e], 57.f));
                            const float pa = 1.f + ea, pb = 1.f + eb, q = __builtin_amdgcn_rcpf(pa * pb); sb[n][e] = q * pa; r[n][e] = q * pb * pb; }
                    *(GAS u32x4*)(R + (size_t)row * 1024 + cb) = pack8(r[0], r[1]);
                    *(GAS u32x4*)(SB + (size_t)row * 1024 + cb) = pack8(sb[0], sb[1]); }
        }
    }
};
struct EpiS {
    static constexpr bool HAS_MID = false; static constexpr int TMID = -1;
    float* S;
    DI void mid(AccT&, const Unit&, int, int, int, int) const {}
    DI void operator()(const AccT& acc, const Unit& u, int wr, int wc, int fr, int fq) const {
        const int row0 = u.pm * 256 + wr * 64 + fr, col0 = wc * 32 + 8 * fq;
#pragma unroll
        for (int ai = 0; ai < 2; ++ai)
#pragma unroll
            for (int m = 0; m < 4; ++m) { GAS float* o = (GAS float*)(S + ((size_t)u.pb * 1024 + row0 + ai * 128 + m * 16) * 128 + col0);
                *(f32x4*)o = acc[ai][0][m][0]; *(GAS f32x4*)(o + 4) = acc[ai][0][m][1]; }
    }
};
struct EpiY {
    static constexpr bool HAS_MID = false; static constexpr int TMID = -1;
    bf16_t* YA;
    DI void mid(AccT&, const Unit&, int, int, int, int) const {}
    DI void operator()(const AccT& acc, const Unit& u, int wr, int wc, int fr, int fq) const {
        const int row0 = u.pm * 256 + wr * 64 + fr;
#pragma unroll
        for (int ai = 0; ai < 2; ++ai)
#pragma unroll
            for (int m = 0; m < 4; ++m) { const int row = row0 + ai * 128 + m * 16;
#pragma unroll
                for (int bj = 0; bj < 2; ++bj) { const int c = u.pn * 256 + bj * 128 + wc * 32 + 8 * fq, t = c >> 4, h0 = c & 15; f32x4 o[2];
#pragma unroll
                    for (int n = 0; n < 2; ++n)
#pragma unroll
                        for (int e = 0; e < 4; ++e) o[n][e] = fgelu_tanh(acc[ai][bj][m][n][e]);
                    *(GAS u32x4*)(YA + ((size_t)row * 64 + t) * 512 + u.pb * 16 + h0) = pack8(o[0], o[1]); } }
    }
};
struct EpiMerge {
    static constexpr bool HAS_MID = true; static constexpr int TMID = 8;
    const bf16_t *R, *SB; bf16_t* O; int wave_s;
    DI void scale(AccT& acc, const Unit& u, int, int, int, int, const bf16_t* P) const {
        const int t_ = opaque_tid(wave_s), wid = __builtin_amdgcn_readfirstlane(t_ >> 6), ln = t_ & 63, wr = wid >> 2, wc = wid & 3, fr = ln & 15, fq = ln >> 4;
        const int row0 = u.pm * 256 + wr * 64 + fr, col0 = u.pn * 256 + wc * 32 + 8 * fq;
#pragma unroll
        for (int ai = 0; ai < 2; ++ai)
#pragma unroll
            for (int m = 0; m < 4; ++m)
#pragma unroll
                for (int bj = 0; bj < 2; ++bj) { const u32x4 w = *(const GAS u32x4*)(P + (size_t)(row0 + ai * 128 + m * 16) * 1024 + col0 + bj * 128); f32x4 a, b; unpack8(w, a, b);
                    acc[ai][bj][m][0] *= a; acc[ai][bj][m][1] *= b; }
    }
    DI void mid(AccT& acc, const Unit& u, int wr, int wc, int fr, int fq) const { scale(acc, u, wr, wc, fr, fq, R); }
    DI void operator()(AccT& acc, const Unit& u, int wr, int wc, int fr, int fq) const {
        scale(acc, u, wr, wc, fr, fq, SB);
        const int row0 = u.pm * 256 + wr * 64 + fr, col0 = u.pn * 256 + wc * 32 + 8 * fq;
#pragma unroll
        for (int ai = 0; ai < 2; ++ai)
#pragma unroll
            for (int m = 0; m < 4; ++m)
#pragma unroll
                for (int bj = 0; bj < 2; ++bj) *(GAS u32x4*)(O + (size_t)(row0 + ai * 128 + m * 16) * 1024 + col0 + bj * 128) = pack8(acc[ai][bj][m][0], acc[ai][bj][m][1]);
    }
};

struct Params { const float* in[20]; float* out; unsigned char* ws; };
enum { I_X = 0, I_GAINS, I_WGATE, I_WUP, I_WDOWN, I_WIN, I_LRE, I_LIM, I_LOGDT, I_BRE, I_BIM, I_CRE, I_CIM, I_DSKIP, I_GLUV, I_GLUG, I_OSSM, I_RELB, I_OATT, I_WO };

DI int map_row(int map, int n) {
    if (map == 0) return n;
    if (map == 1) return 256 * (n >> 7) + (n & 127);
    if (map == 2) return 256 * (n >> 7) + 128 + (n & 127);
    if (n < 2048) return n;
    if (n < 3072) { const int j = n - 2048; return 2048 + 256 * (j >> 7) + (j & 127); }
    const int j = n - 3072; return 2048 + 256 * (j >> 7) + 128 + (j & 127);
}
DI void cvt_item(const float* W, int K, int N, bf16_t* WT, int ldk, int koff, int map, LAS float* scr, int item, int lane, const float* gk = nullptr) {
    const int nblk = N / 32, kb = item / nblk, nb = item % nblk, k0 = 64 * kb, n0 = 32 * nb;
    const float sc = (map == 3 && n0 >= 512 && n0 < 1024) ? 0.125f * 1.4426950408889634f : 1.f;
    { const int kq = lane >> 3, n4 = (lane & 7) * 4;
      f32x4 wv[8];
#pragma unroll
      for (int i = 0; i < 8; ++i) wv[i] = *(const GAS f32x4*)(W + (size_t)(k0 + i * 8 + kq) * N + n0 + n4);
#pragma unroll
      for (int i = 0; i < 8; ++i) { const int kk = i * 8 + kq; const float m = gk ? sc * gk[k0 + kk] : sc;
          scr[kk * 33 + n4] = wv[i][0] * m; scr[kk * 33 + n4 + 1] = wv[i][1] * m; scr[kk * 33 + n4 + 2] = wv[i][2] * m; scr[kk * 33 + n4 + 3] = wv[i][3] * m; } }
    asm volatile("s_waitcnt lgkmcnt(0)" ::: "memory");
    const int c = lane & 7;
#pragma unroll
    for (int j = 0; j < 4; ++j) { const int n = (lane >> 3) + 8 * j; const LAS float* s = scr + (8 * c) * 33 + n;
        u32x4 o; o.x = pk2(s[0 * 33], s[1 * 33]); o.y = pk2(s[2 * 33], s[3 * 33]); o.z = pk2(s[4 * 33], s[5 * 33]); o.w = pk2(s[6 * 33], s[7 * 33]);
        *(GAS u32x4*)(WT + (size_t)map_row(map, n0 + n) * ldk + koff + k0 + 8 * c) = o; }
    asm volatile("s_waitcnt lgkmcnt(0)" ::: "memory");
}
DI void cvt_matrix(const float* W, int K, int N, bf16_t* WT, int ldk, int koff, int map, LAS float* scr, int gw, int NGW, int lane) {
    const int nitems = (K / 64) * (N / 32);
    for (int it = gw; it < nitems; it += NGW) cvt_item(W, K, N, WT, ldk, koff, map, scr, it, lane);
}

DI void s5_tables(const Params& P, LAS unsigned char* lds, int lg) {
    LAS float* pw = (LAS float*)lds;
    LAS float* bb = pw + 65 * 64 * 2;
    LAS float* cc = bb + 64 * 16 * 2;
    LAS float* ff = cc + 16 * 64 * 2;
    const int tid = threadIdx.x;
    unsigned char* ws = P.ws;
    float* gPW = (float*)(ws + OFF_PW + (size_t)lg * SZ_PW1);
    float* gBB = (float*)(ws + OFF_BB + (size_t)lg * SZ_BB1);
    float* gKE = (float*)(ws + OFF_KERN + (size_t)lg * SZ_KE1);
    const double dt = exp((double)P.in[I_LOGDT][lg]);
    const float* lre = P.in[I_LRE] + (size_t)lg * 64; const float* lim = P.in[I_LIM] + (size_t)lg * 64;
    for (int idx = tid; idx < 65 * 64; idx += NTHREADS) {
        const int tau = idx >> 6, p = idx & 63;
        const double lr = lre[p], li = lim[p];
        const float mag = __expf((float)(lr * dt * tau));
        double rev = li * dt * tau * 0.15915494309189535; rev -= rint(rev);
        const float cs = __builtin_amdgcn_cosf((float)rev), sn = __builtin_amdgcn_sinf((float)rev);
        const float re = mag * cs, im = mag * sn;
        pw[idx * 2] = re; pw[idx * 2 + 1] = im; gPW[idx * 2] = re; gPW[idx * 2 + 1] = im;
        if (tau == 1) {
            const double nr = (double)re - 1.0, ni = im, den = lr * lr + li * li;
            ff[p * 2] = (float)((nr * lr + ni * li) / den); ff[p * 2 + 1] = (float)((ni * lr - nr * li) / den);
        }
    }
    __syncthreads();
    const float* bre = P.in[I_BRE] + (size_t)lg * 1024; const float* bim = P.in[I_BIM] + (size_t)lg * 1024;
    const float* cre = P.in[I_CRE] + (size_t)lg * 1024; const float* cim = P.in[I_CIM] + (size_t)lg * 1024;
    for (int idx = tid; idx < 1024; idx += NTHREADS) {
        const int p = idx >> 4;
        const float fr_ = ff[p * 2], fi_ = ff[p * 2 + 1], br = bre[idx], bi = bim[idx];
        const float re = fr_ * br - fi_ * bi, im = fr_ * bi + fi_ * br;
        bb[idx * 2] = re; bb[idx * 2 + 1] = im; gBB[idx * 2] = re; gBB[idx * 2 + 1] = im;
        cc[idx * 2] = cre[idx]; cc[idx * 2 + 1] = cim[idx];
    }
    __syncthreads();
    const float* dsk = P.in[I_DSKIP] + (size_t)lg * 16;
    for (int pair = tid; pair < 1024; pair += NTHREADS) {
        const int tau = pair >> 4, h = pair & 15;
        float a[16];
#pragma unroll
        for (int j = 0; j < 16; ++j) a[j] = 0.f;
        for (int p = 0; p < 64; ++p) {
            const float cr = cc[(h * 64 + p) * 2], ci = cc[(h * 64 + p) * 2 + 1], pr = pw[(tau * 64 + p) * 2], pi = pw[(tau * 64 + p) * 2 + 1];
            const float xr = cr * pr - ci * pi, xi = cr * pi + ci * pr;
#pragma unroll
            for (int j = 0; j < 16; ++j) a[j] += xr * bb[(p * 16 + j) * 2] - xi * bb[(p * 16 + j) * 2 + 1];
        }
        const float dv = dsk[h];
#pragma unroll
        for (int j = 0; j < 16; ++j) gKE[(size_t)pair * 16 + j] = a[j] + ((tau == 0 && j == h) ? dv : 0.f);
    }
    __syncthreads();
}

DI void build_w12(const Params& P, int l, int wave_s) {
    unsigned char* ws = P.ws;
    const float* gPW = (const float*)(ws + OFF_PW) + (size_t)l * 32 * (65 * 64 * 2);
    const float* gBB = (const float*)(ws + OFF_BB) + (size_t)l * 32 * (64 * 16 * 2);
    const float* gKE = (const float*)(ws + OFF_KERN) + (size_t)l * 32 * (64 * 256);
    bf16_t* W1 = (bf16_t*)(ws + OFF_W1); bf16_t* W2 = (bf16_t*)(ws + OFF_W2);
    const int gt = blockIdx.x * NTHREADS + opaque_tid(wave_s), NT = gridDim.x * NTHREADS;
    for (int it = gt; it < 32 * 256 * 128; it += NT) {
        const int kk = it & 127, n = (it >> 7) & 255, g = it >> 15;
        float v[8];
        if (n >= 128) {
#pragma unroll
            for (int e = 0; e < 8; ++e) v[e] = 0.f;
        } else {
            const int p = n & 63, im = n >> 6, j = kk >> 1, h0 = (kk & 1) * 8;
            const float* pwp = gPW + ((size_t)g * 65 + (63 - j)) * 128 + p * 2; const float pr = pwp[0], pi = pwp[1];
            const float* bp = gBB + ((size_t)g * 64 + p) * 32 + h0 * 2;
#pragma unroll
            for (int e = 0; e < 8; ++e) { const float br = bp[e * 2], bi = bp[e * 2 + 1]; v[e] = im ? (pr * bi + pi * br) : (pr * br - pi * bi); }
        }
        u32x4 o; o.x = pk2(v[0], v[1]); o.y = pk2(v[2], v[3]); o.z = pk2(v[4], v[5]); o.w = pk2(v[6], v[7]);
        *(GAS u32x4*)(W1 + (size_t)it * 8) = o;
    }
    const float* cre = P.in[I_CRE] + (size_t)l * 32 * 1024; const float* cim = P.in[I_CIM] + (size_t)l * 32 * 1024;
    for (int it = gt; it < 32 * 1024 * 144; it += NT) {
        const int kk = it % 144, n = (it / 144) & 1023, g = it / (144 * 1024), t = n >> 4, h = n & 15;
        float v[8];
        if (kk < 16) {
            const int im = kk >> 3, p0 = (kk & 7) * 8;
            const float* pwp = gPW + ((size_t)g * 65 + (t + 1)) * 128 + p0 * 2;
            const float* crp = cre + ((size_t)g * 16 + h) * 64 + p0; const float* cip = cim + ((size_t)g * 16 + h) * 64 + p0;
#pragma unroll
            for (int e = 0; e < 8; ++e) { const float cr = crp[e], ci = cip[e], pr = pwp[e * 2], pi = pwp[e * 2 + 1]; v[e] = im ? -(cr * pi + ci * pr) : (cr * pr - ci * pi); }
        } else {
            const int j = (kk - 16) >> 1, h0 = ((kk - 16) & 1) * 8;
            if (j <= t) { const float* kp = gKE + (((size_t)g * 64 + (t - j)) * 16 + h) * 16 + h0;
#pragma unroll
                for (int e = 0; e < 8; ++e) v[e] = kp[e];
            } else {
#pragma unroll
                for (int e = 0; e < 8; ++e) v[e] = 0.f;
            }
        }
        u32x4 o; o.x = pk2(v[0], v[1]); o.y = pk2(v[2], v[3]); o.z = pk2(v[4], v[5]); o.w = pk2(v[6], v[7]);
        *(GAS u32x4*)(W2 + (size_t)it * 8) = o;
    }
}

DI void ew_rows(unsigned char* ws, float* outp, const float* xin, bool first, bool last, float coef, const float* gpost, int rbeg, int rend, int lane) {
    const bf16_t* M1 = (const bf16_t*)(ws + OFF_M1); const float* ssp = (const float*)(ws + OFF_SSP); bf16_t* XB = (bf16_t*)(ws + OFF_XN); float* RS = (float*)(ws + OFF_RS);
    for (int r0 = rbeg; r0 < rend; r0 += 4) {
        f32x4 ssv = {0.f, 0.f, 0.f, 0.f};
        u32x2 xr[4][4], mr[4][4]; f32x4 xf[4][4];
        if (first) {
#pragma unroll
            for (int q = 0; q < 4; ++q)
#pragma unroll
                for (int j = 0; j < 4; ++j) xf[q][j] = *(const GAS f32x4*)(xin + (size_t)(r0 + q) * 1024 + j * 256 + lane * 4);
        } else {
            ssv = *(const GAS f32x4*)(ssp + (size_t)lane * NTOK + r0);
#pragma unroll
            for (int q = 0; q < 4; ++q)
#pragma unroll
                for (int j = 0; j < 4; ++j) { xr[q][j] = *(const GAS u32x2*)(XB + (size_t)(r0 + q) * 1024 + j * 256 + lane * 4); mr[q][j] = *(const GAS u32x2*)(M1 + (size_t)(r0 + q) * 1024 + j * 256 + lane * 4); }
        }
#pragma unroll
        for (int q = 0; q < 4; ++q) {
            const int row = r0 + q;
            f32x4 v[4];
            if (first) {
#pragma unroll
                for (int j = 0; j < 4; ++j) v[j] = xf[q][j];
            } else {
                const float rstd = __builtin_amdgcn_rsqf(wave_sum(ssv[q], lane) * (1.f / 1024.f) + RMS_EPS) * coef;
#pragma unroll
                for (int j = 0; j < 4; ++j) {
                    const u32x2 xw = xr[q][j], w = mr[q][j];
                    const f32x4 gp = *(const GAS f32x4*)(gpost + j * 256 + lane * 4);
                    const f32x4 xv = {bflo(xw.x), bfhi(xw.x), bflo(xw.y), bfhi(xw.y)};
                    const f32x4 mv = {bflo(w.x), bfhi(w.x), bflo(w.y), bfhi(w.y)};
                    v[j] = xv + gp * mv * rstd;
                }
            }
            if (last) {
#pragma unroll
                for (int j = 0; j < 4; ++j) *(GAS f32x4*)(outp + (size_t)row * 1024 + j * 256 + lane * 4) = v[j];
            } else {
                float ss = 0.f;
#pragma unroll
                for (int j = 0; j < 4; ++j) ss += (v[j][0] * v[j][0] + v[j][1] * v[j][1]) + (v[j][2] * v[j][2] + v[j][3] * v[j][3]);
                const float rstd2 = __builtin_amdgcn_rsqf(wave_sum(ss, lane) * (1.f / 1024.f) + RMS_EPS);
                if (lane == 0) ((GAS float*)RS)[row] = rstd2;
#pragma unroll
                for (int j = 0; j < 4; ++j) { u32x2 w; w.x = pk2(v[j][0], v[j][1]); w.y = pk2(v[j][2], v[j][3]);
                    *(GAS u32x2*)(XB + (size_t)row * 1024 + j * 256 + lane * 4) = w; }
            }
        }
    }
}
DI void ew_phase(const Params& P, bool first, bool last, float coef, const float* gpost, int wave_s) {
    const int tid_ = opaque_tid(wave_s), lane = tid_ & 63, wave = __builtin_amdgcn_readfirstlane(tid_ >> 6);
    const int vb = gridDim.x == 256 ? ((int)(blockIdx.x & 7) * 32 + (int)(blockIdx.x >> 3)) : (int)blockIdx.x;
    const int gw = vb * NWAVES + wave, NGW = gridDim.x * NWAVES;
    const int rpw = (NTOK / 4 + NGW - 1) / NGW * 4;
    const int rbeg = gw * rpw, rend = (rbeg + rpw) < NTOK ? (rbeg + rpw) : NTOK;
    ew_rows(P.ws, P.out, P.in[I_X], first, last, coef, gpost, rbeg, rend, lane);
}

DI void carry_phase(const Params& P, int l, int wave_s) {
    const int tid_ = opaque_tid(wave_s), lane = tid_ & 63, wave = __builtin_amdgcn_readfirstlane(tid_ >> 6);
    unsigned char* ws = P.ws;
    const float* gPW = (const float*)(ws + OFF_PW) + (size_t)l * 32 * (65 * 64 * 2);
    const float* S = (const float*)(ws + OFF_S); bf16_t* U = (bf16_t*)(ws + OFF_U);
    const int gw = blockIdx.x * NWAVES + wave, NGW = gridDim.x * NWAVES;
    for (int task = gw; task < 512; task += NGW) {
        const int g = task >> 4, b = task & 15, p = lane;
        const float ar = gPW[((size_t)g * 65 + 64) * 128 + p * 2], ai = gPW[((size_t)g * 65 + 64) * 128 + p * 2 + 1];
        float xr = 0.f, xi = 0.f;
        const GAS float* sp = (const GAS float*)(S + ((size_t)g * 1024 + b * 64) * 128); GAS bf16_t* up = (GAS bf16_t*)(U + ((size_t)g * 1024 + b * 64) * 1152);
#pragma unroll
        for (int c0 = 0; c0 < 64; c0 += 32) {
            float sr[32], si[32];
#pragma unroll
            for (int c = 0; c < 32; ++c) { sr[c] = sp[(c0 + c) * 128 + p]; si[c] = sp[(c0 + c) * 128 + 64 + p]; }
#pragma unroll
            for (int c = 0; c < 32; ++c) {
                up[(size_t)(c0 + c) * 1152 + p] = (bf16_t)(pk2(xr, 0.f) & 0xffff); up[(size_t)(c0 + c) * 1152 + 64 + p] = (bf16_t)(pk2(xi, 0.f) & 0xffff);
                const float nr = ar * xr - ai * xi + sr[c], ni = ar * xi + ai * xr + si[c];
                xr = nr; xi = ni;
            }
        }
    }
}

DI int crow(int reg, int h) { return (reg & 3) + 8 * (reg >> 2) + 4 * h; }
#define MFMA32(a, b, c) __builtin_amdgcn_mfma_f32_32x32x16_bf16((a), (b), (c), 0, 0, 0)
DI bf16x8 pack_step(const f32x16& x, int s) {
    u32x4 p; p.x = pk2(x[8 * s], x[8 * s + 1]); p.y = pk2(x[8 * s + 2], x[8 * s + 3]); p.z = pk2(x[8 * s + 4], x[8 * s + 5]); p.w = pk2(x[8 * s + 6], x[8 * s + 7]);
    return __builtin_bit_cast(bf16x8, p);
}
#define ATTN_STEP(KT, BUF, KREG, VREG) \
            { LAS unsigned char* kb = kbuf + BUF * 9216; LAS unsigned char* vb = vbuf + BUF * 8704; \
            *(LAS u32x4*)(kb + lr * 144 + lsg * 16) = KREG; \
            { u32x2 a; a.x = VREG.x; a.y = VREG.y; u32x2 c; c.x = VREG.z; c.y = VREG.w; \
              *(LAS u32x2*)(vb + lr * 136 + lsg * 16) = a; *(LAS u32x2*)(vb + lr * 136 + lsg * 16 + 8) = c; } \
            __syncthreads(); \
            if (KT + 2 <= kthi) { KREG = *(const GAS u32x4*)(kgp + (size_t)(KT + 2) * 64 * 512); VREG = *(const GAS u32x4*)(vgp + (KT + 2) * 64); } \
            if (KT + 8 >= cc && KT <= cc) { \
                f32x16 s0, s1; \
_Pragma("unroll") \
                for (int i = 0; i < 16; ++i) { s0[i] = 0.f; s1[i] = 0.f; } \
_Pragma("unroll") \
                for (int ks = 0; ks < 4; ++ks) { \
                    const bf16x8 k0 = *(const LAS bf16x8*)(kb + n * 144 + ks * 32 + gq * 16), k1 = *(const LAS bf16x8*)(kb + (32 + n) * 144 + ks * 32 + gq * 16); \
                    s0 = MFMA32(k0, Qf[ks], s0); s1 = MFMA32(k1, Qf[ks], s1); \
                } \
                const int delta = cc - (KT); \
                if (delta < 3) { const int base = 64 * delta + qh * 32 + n + 128; \
_Pragma("unroll") \
                    for (int i = 0; i < 16; ++i) { const int key = crow(i, gq); int i0 = base - key, i1 = base - key - 32; \
                        i0 = i0 > 256 ? 256 : i0; i1 = i1 > 256 ? 256 : i1; i0 = i0 < 0 ? 0 : i0; i1 = i1 < 0 ? 0 : i1; \
                        s0[i] += bth[i0]; s1[i] += bth[i1]; } \
                } \
                float mx = s0[0]; \
_Pragma("unroll") \
                for (int i = 1; i < 16; ++i) mx = fmaxf(mx, s0[i]); \
_Pragma("unroll") \
                for (int i = 0; i < 16; ++i) mx = fmaxf(mx, s1[i]); \
                mx = fmaxf(mx, shx(mx, lane, 32)); \
                const float mnew = fmaxf(mrun, mx), alpha = __builtin_amdgcn_exp2f(mrun - mnew); mrun = mnew; \
                float ps = 0.f; \
_Pragma("unroll") \
                for (int i = 0; i < 16; ++i) { s0[i] = __builtin_amdgcn_exp2f(s0[i] - mnew); s1[i] = __builtin_amdgcn_exp2f(s1[i] - mnew); ps += s0[i] + s1[i]; } \
                lrun = lrun * alpha + ps; \
_Pragma("unroll") \
                for (int i = 0; i < 16; ++i) { O0[i] *= alpha; O1[i] *= alpha; } \
_Pragma("unroll") \
                for (int kg = 0; kg < 2; ++kg) \
_Pragma("unroll") \
                    for (int s = 0; s < 2; ++s) { \
                        const bf16x8 Pf = pack_step(kg == 0 ? s0 : s1, s); \
                        const LAS unsigned char* v0 = vb + n * 136 + 64 * kg + 32 * s + 8 * gq; \
                        const s16x4 lo0 = *(const LAS s16x4*)(v0), hi0 = *(const LAS s16x4*)(v0 + 16); \
                        const s16x4 lo1 = *(const LAS s16x4*)(v0 + 32 * 136), hi1 = *(const LAS s16x4*)(v0 + 32 * 136 + 16); \
                        const bf16x8 V0 = __builtin_shufflevector(lo0, hi0, 0, 1, 2, 3, 4, 5, 6, 7), V1 = __builtin_shufflevector(lo1, hi1, 0, 1, 2, 3, 4, 5, 6, 7); \
                        O0 = MFMA32(V0, Pf, O0); O1 = MFMA32(V1, Pf, O1); \
                    } \
            } }
DI void attn_phase(const Params& P, int l, LAS unsigned char* lds, int wave_s) {
    const int tid_ = opaque_tid(wave_s), lane = tid_ & 63, wave = __builtin_amdgcn_readfirstlane(tid_ >> 6);
    unsigned char* ws = P.ws;
    const bf16_t* Q = (const bf16_t*)(ws + OFF_Q); const bf16_t* K = (const bf16_t*)(ws + OFF_K); const bf16_t* VT = (const bf16_t*)(ws + OFF_VT);
    bf16_t* ZA = (bf16_t*)P.out;
    LAS float* bt = (LAS float*)lds;
    LAS unsigned char* kbuf = lds + 8448;
    LAS unsigned char* vbuf = kbuf + 2 * 9216;
    const float* relb = P.in[I_RELB] + (size_t)l * 8 * 257;
    for (int i = tid_; i < 8 * 257; i += NTHREADS) bt[i] = (relb[i] - relb[(i / 257) * 257 + 256]) * 1.4426950408889634f;
    __syncthreads();
    const int n = lane & 31, gq = lane >> 5;
    const int ci = wave >> 1, qh = wave & 1;
    const int lr = tid_ >> 3, lsg = tid_ & 7;
    for (int it = blockIdx.x; it < 2048; it += gridDim.x) {
        const int y = it >> 4, cg4 = ((it & 15) + (it >> 8)) & 15, hd = y & 7, b = y >> 3;
        const int c0 = cg4 * 4, cc = c0 + ci;
        const int ktlo = c0 > 8 ? c0 - 8 : 0, kthi = c0 + 3;
        const size_t tok0 = (size_t)b * SEQ + cc * 64 + qh * 32;
        bf16x8 Qf[4];
        { const bf16_t* qp = Q + (tok0 + n) * 512 + hd * 64 + gq * 8;
#pragma unroll
          for (int ks = 0; ks < 4; ++ks) Qf[ks] = *(const GAS bf16x8*)(qp + ks * 16); }
        f32x16 O0, O1;
#pragma unroll
        for (int i = 0; i < 16; ++i) { O0[i] = 0.f; O1[i] = 0.f; }
        float mrun = -1e30f, lrun = 0.f;
        const LAS float* bth = bt + hd * 257;
        const bf16_t* kgp = K + ((size_t)b * SEQ + lr) * 512 + hd * 64 + lsg * 8;
        const bf16_t* vgp = VT + (((size_t)b * 8 + hd) * 64 + lr) * SEQ + lsg * 8;
        u32x4 kregA = *(const GAS u32x4*)(kgp + (size_t)ktlo * 64 * 512), vregA = *(const GAS u32x4*)(vgp + ktlo * 64);
        u32x4 kregB = *(const GAS u32x4*)(kgp + (size_t)(ktlo + 1) * 64 * 512), vregB = *(const GAS u32x4*)(vgp + (ktlo + 1) * 64);
        for (int kt = ktlo; kt <= kthi; kt += 2) {
            ATTN_STEP(kt, 0, kregA, vregA)
            ATTN_STEP(kt + 1, 1, kregB, vregB)
        }
        lrun += shx(lrun, lane, 32);
        const float inv = 1.f / lrun;
        bf16_t* op = ZA + (tok0 + n) * 1024 + 512 + hd * 64 + gq * 4;
#pragma unroll
        for (int g4 = 0; g4 < 4; ++g4) {
            u32x2 w0, w1;
            w0.x = pk2(O0[4 * g4] * inv, O0[4 * g4 + 1] * inv); w0.y = pk2(O0[4 * g4 + 2] * inv, O0[4 * g4 + 3] * inv);
            w1.x = pk2(O1[4 * g4] * inv, O1[4 * g4 + 1] * inv); w1.y = pk2(O1[4 * g4 + 2] * inv, O1[4 * g4 + 3] * inv);
            *(GAS u32x2*)(op + 8 * g4) = w0; *(GAS u32x2*)(op + 32 + 8 * g4) = w1;
        }
        __syncthreads();
    }
}

__global__ void __launch_bounds__(NTHREADS, 2) mk_fwd(Params P) {
    extern __shared__ __attribute__((aligned(16))) unsigned char lds_raw[];
    LAS unsigned char* lds = (LAS unsigned char*)lds_raw;
    cg::grid_group grid = cg::this_grid();
    const int tid = threadIdx.x, lane = tid & 63, wave = __builtin_amdgcn_readfirstlane(tid >> 6);
    const int G = gridDim.x, bx = blockIdx.x;
    unsigned char* ws = P.ws;
    const int gw = bx * NWAVES + wave, NGW = G * NWAVES;
    volatile LAS unsigned* xst = (volatile LAS unsigned*)(lds + LDS_MAIN);
    if (tid == 0) { xst[0] = 0u; xst[1] = 0u; }
    __syncthreads();
    XcdBarrier xbar; xbar.bar = (unsigned*)(ws + OFF_BAR); xbar.x = xb_xcc_id(); xbar.st = xst;
    if (tid == 0) (void)xb_add(&xbar.bar[XB_XCNT(xbar.x)], 1u);

    {
        _Pragma("unroll 1") for (int rp_ = 0; rp_ < REP_PRO; ++rp_) {
        for (int lg = bx; lg < 128; lg += G) s5_tables(P, lds, lg);
        __syncthreads();
        LAS float* scr = (LAS float*)(lds + wave * 8704);
        for (int it = gw; it < 4 * 11776; it += NGW) {
            const int l = it / 11776; int r = it - l * 11776;
            if (r < 6 * 1408) {
                const int which = r / 1408, f = which & 1, kind = which >> 1; r -= which * 1408;
                bf16_t* wgu = (bf16_t*)(ws + OFF_WGU + (size_t)(l * 2 + f) * SZ_WGU);
                const float* gk = P.in[I_GAINS] + (size_t)(l * 6 + 4 * f) * 1024;
                if (kind == 0) cvt_item(P.in[I_WGATE] + (size_t)(l * 2 + f) * 1024 * 2816, 1024, 2816, wgu, 1024, 0, 1, scr, r, lane, gk);
                else if (kind == 1) cvt_item(P.in[I_WUP] + (size_t)(l * 2 + f) * 1024 * 2816, 1024, 2816, wgu, 1024, 0, 2, scr, r, lane, gk);
                else cvt_item(P.in[I_WDOWN] + (size_t)(l * 2 + f) * 2816 * 1024, 2816, 1024, (bf16_t*)(ws + OFF_WD + (size_t)(l * 2 + f) * SZ_WD), 2816, 0, 0, scr, r, lane);
                continue;
            }
            r -= 6 * 1408;
            if (r < 2048) { cvt_item(P.in[I_WIN] + (size_t)l * 1024 * 4096, 1024, 4096, (bf16_t*)(ws + OFF_WIN + (size_t)l * SZ_WIN), 1024, 0, 3, scr, r, lane, P.in[I_GAINS] + (size_t)(l * 6 + 2) * 1024); continue; }
            r -= 2048;
            if (r < 256) { const int gsel = r >> 7; r &= 127;
                cvt_item(P.in[gsel ? I_GLUG : I_GLUV] + (size_t)l * 512 * 512, 512, 512, (bf16_t*)(ws + OFF_WGL + (size_t)l * SZ_WGL), 512, 0, 1 + gsel, scr, r, lane); continue; }
            r -= 256;
            if (r < 512) { const int osel = r >> 8; r &= 255;
                cvt_item(P.in[osel ? I_OATT : I_OSSM] + (size_t)l * 512 * 1024, 512, 1024, (bf16_t*)(ws + OFF_WOUT + (size_t)l * SZ_WOUT), 1024, osel * 512, 0, scr, r, lane); continue; }
            r -= 512;
            cvt_item(P.in[I_WO] + (size_t)l * 1024 * 1024, 1024, 1024, (bf16_t*)(ws + OFF_WO + (size_t)l * SZ_WO), 1024, 0, 0, scr, r, lane);
        }
        __syncthreads();
        }
        ew_phase(P, true, false, 0.f, nullptr, wave);
        __syncthreads();
    }
    if (tid == 0) __hip_atomic_store((unsigned*)(ws + OFF_BAR) + 4096 + bx, xb_xcc_id(), __ATOMIC_RELAXED, __HIP_MEMORY_SCOPE_AGENT);
    grid.sync();

    bool local_ok = (G == 256);
    if (local_ok) {
        unsigned* xt = (unsigned*)(ws + OFF_BAR) + 4096;
        const int ok = (tid < 256) ? (xb_ld(xt + tid) == xb_ld(xt + (tid & 7))) : 1;
        local_ok = __syncthreads_and(ok) != 0;
    }
    unsigned* vxcnt = (unsigned*)(ws + OFF_BAR) + 3456 + 64 * (bx & 7);
    unsigned vxgen = 0u;
#define LSYNC() do { if (local_ok) { vxgen += 32u; vx_barrier(vxcnt, vxgen, wave); } else { GSYNC(); } } while (0)
    for (int step = 0; step < 12; ++step) {
        const int l = step / 3, s = step % 3;
        unsigned char* ws = P.ws; asm volatile("" : "+s"(ws));
        pg8::Gemm gfin;
        if (s != 1) {
            const int f = s >> 1;
            pg8::Gemm g{(const char*)(ws + OFF_XN), (const char*)(ws + OFF_WGU + (size_t)(l * 2 + f) * SZ_WGU), 1024, 1024, (size_t)256 * 1024 * 2, 0, (size_t)256 * 1024 * 2, 0, 16, 0};
            pg8::Order S; S.init(256, 22, 1, 0, G, bx);
            EpiGated<0> E{(bf16_t*)(ws + OFF_H), 2816, (const float*)(ws + OFF_RS)};
            _Pragma("unroll 1") for (int rep_ = 0; rep_ < REP_GEMM; ++rep_) pg8::gemm_phase(lds, g, S, E, wave);
            LSYNC();
            gfin = pg8::Gemm{(const char*)(ws + OFF_H), (const char*)(ws + OFF_WD + (size_t)(l * 2 + f) * SZ_WD), 2816, 2816, (size_t)256 * 2816 * 2, 0, (size_t)256 * 2816 * 2, 0, 44, 0};
        } else {
            {
                pg8::Gemm g{(const char*)(ws + OFF_XN), (const char*)(ws + OFF_WIN + (size_t)l * SZ_WIN), 1024, 1024, (size_t)256 * 1024 * 2, 0, (size_t)256 * 1024 * 2, 0, 16, 0};
                pg8::Order S; S.init(256, 16, 1, 0, G, bx);
                EpiWin E{(bf16_t*)(ws + OFF_U), (bf16_t*)(ws + OFF_Q), (bf16_t*)(ws + OFF_K), (bf16_t*)(ws + OFF_VT), (bf16_t*)(ws + OFF_M1), (bf16_t*)(ws + OFF_SB), (const float*)(ws + OFF_RS)};
                _Pragma("unroll 1") for (int rep_ = 0; rep_ < REP_GEMM; ++rep_) pg8::gemm_phase(lds, g, S, E, wave);
            }
            GSYNC();
            {
                pg8::Gemm g{(const char*)(ws + OFF_U) + 256, (const char*)(ws + OFF_W1), 1152, 1024, (size_t)256 * 1152 * 2, (size_t)1024 * 1152 * 2, 0, (size_t)256 * 1024 * 2, 16, 0};
                pg8::Order S; S.init(4, 1, 32, 1, G, bx);
                EpiS E{(float*)(ws + OFF_S)};
                _Pragma("unroll 1") for (int rep_ = 0; rep_ < REP_GEMM; ++rep_) pg8::gemm_phase(lds, g, S, E, wave);
                __syncthreads();
                _Pragma("unroll 1") for (int rep_ = 0; rep_ < REP_ATTN; ++rep_) attn_phase(P, l, lds, wave);
            }
            GSYNC();
            _Pragma("unroll 1") for (int rc_ = 0; rc_ < REP_CARRY; ++rc_) carry_phase(P, l, wave);
            GSYNC();
            {
                pg8::Gemm g{(const char*)(ws + OFF_U), (const char*)(ws + OFF_W2), 1152, 1152, (size_t)256 * 1152 * 2, (size_t)1024 * 1152 * 2, (size_t)256 * 1152 * 2, (size_t)1024 * 1152 * 2, 6, 4};
                pg8::Order S; S.init(4, 4, 32, 2, G, bx);
                EpiY E{(bf16_t*)(ws + OFF_Q)};
                _Pragma("unroll 1") for (int rep_ = 0; rep_ < REP_GEMM; ++rep_) pg8::gemm_phase(lds, g, S, E, wave);
            }
            GSYNC();
            {
                pg8::Gemm g{(const char*)(ws + OFF_Q), (const char*)(ws + OFF_WGL + (size_t)l * SZ_WGL), 512, 512, (size_t)256 * 512 * 2, 0, (size_t)256 * 512 * 2, 0, 8, 0};
                pg8::Order S; S.init(256, 4, 1, 0, G, bx);
                EpiGated<1> E{(bf16_t*)P.out, 1024, nullptr};
                _Pragma("unroll 1") for (int rep_ = 0; rep_ < REP_GEMM; ++rep_) pg8::gemm_phase(lds, g, S, E, wave);
            }
            LSYNC();
            {
                pg8::Gemm g{(const char*)P.out, (const char*)(ws + OFF_WOUT + (size_t)l * SZ_WOUT), 1024, 1024, (size_t)256 * 1024 * 2, 0, (size_t)256 * 1024 * 2, 0, 16, 0};
                pg8::Order S; S.init(256, 4, 1, 0, G, bx);
                EpiMerge E{(const bf16_t*)(ws + OFF_M1), (const bf16_t*)(ws + OFF_SB), (bf16_t*)(ws + OFF_K), wave};
                _Pragma("unroll 1") for (int rep_ = 0; rep_ < REP_GEMM; ++rep_) pg8::gemm_phase(lds, g, S, E, wave);
            }
            LSYNC();
            gfin = pg8::Gemm{(const char*)(ws + OFF_K), (const char*)(ws + OFF_WO + (size_t)l * SZ_WO), 1024, 1024, (size_t)256 * 1024 * 2, 0, (size_t)256 * 1024 * 2, 0, 16, 0};
        }
        {
            pg8::Order S; S.init(256, 4, 1, 0, G, bx);
            EpiDown E{(bf16_t*)(ws + OFF_M1), (float*)(ws + OFF_SSP)};
            _Pragma("unroll 1") for (int rep_ = 0; rep_ < REP_GEMM; ++rep_) pg8::gemm_phase(lds, gfin, S, E, wave);
        }
        LSYNC();
        {
            const float* gains = P.in[I_GAINS];
            ew_phase(P, false, step == 11, s == 1 ? 1.f : 0.5f, gains + (size_t)(2 * step + 1) * 1024, wave);
            if (s == 0) { _Pragma("unroll 1") for (int rb_ = 0; rb_ < REP_BUILD; ++rb_) build_w12(P, l, wave); }
        }
        if (step != 11) { if (s == 2) LSYNC(); else GSYNC(); }
    }
}

extern "C" void kernel_launch(void* const* d_in, const int* in_sizes, int n_in, void* d_out, int out_size, void* d_ws, size_t ws_size, hipStream_t stream) {
    static int grid = 0;
    if (grid == 0) {
        if (n_in != 20 || out_size != NTOK * DM || ws_size < WS_END) { fprintf(stderr, "kernel_launch: unexpected shapes: n_in %d out %d ws %zu (need %zu)\n", n_in, out_size, ws_size, (size_t)WS_END); grid = -1; return; }
        int dev = 0, cus = 0, per_cu = 0;
        hipGetDevice(&dev);
        hipDeviceGetAttribute(&cus, hipDeviceAttributeMultiprocessorCount, dev);
        if (hipFuncSetAttribute((const void*)mk_fwd, hipFuncAttributeMaxDynamicSharedMemorySize, LDS_BYTES) != hipSuccess) { fprintf(stderr, "kernel_launch: hipFuncSetAttribute failed\n"); grid = -1; return; }
        if (hipOccupancyMaxActiveBlocksPerMultiprocessor(&per_cu, (const void*)mk_fwd, NTHREADS, LDS_BYTES) != hipSuccess || per_cu < 1) { fprintf(stderr, "kernel_launch: occupancy query failed (%d)\n", per_cu); per_cu = 1; }
        (void)hipGetLastError();
        grid = cus * per_cu;
    }
    if (grid < 0) return;
    if (hipMemsetAsync((char*)d_ws + OFF_BAR, 0, BAR_BYTES, stream) != hipSuccess) { fprintf(stderr, "kernel_launch: memset failed\n"); return; }
    Params p{};
    for (int i = 0; i < 20; ++i) p.in[i] = (const float*)d_in[i];
    p.out = (float*)d_out; p.ws = (unsigned char*)d_ws;
    void* args[] = {&p};
    hipError_t e = hipLaunchCooperativeKernel((const void*)mk_fwd, dim3(grid), dim3(NTHREADS), args, LDS_BYTES, stream);
    if (e != hipSuccess) fprintf(stderr, "cooperative launch failed: %s (grid %d)\n", hipGetErrorString(e), grid);
}
```

```cpp
#include <hip/hip_runtime.h>
#include <hip/hip_cooperative_groups.h>
#include <cstdio>
#include <cstdint>
namespace cg = cooperative_groups;

#define LAS __attribute__((address_space(3)))
#define GAS __attribute__((address_space(1)))
typedef unsigned short bf16_t;
typedef short bf16x8 __attribute__((ext_vector_type(8)));
typedef short s16x4 __attribute__((ext_vector_type(4)));
typedef float f32x4 __attribute__((ext_vector_type(4)));
typedef float f32x2 __attribute__((ext_vector_type(2)));
typedef float f32x16 __attribute__((ext_vector_type(16)));
typedef unsigned u32x4 __attribute__((ext_vector_type(4)));
typedef unsigned u32x2 __attribute__((ext_vector_type(2)));
typedef __bf16 bf2_t __attribute__((ext_vector_type(2)));
#define DI __device__ __forceinline__

constexpr int NTOK = 65536, DM = 1024, FF = 2816, NL = 4, NGRP = 32, SEQ = 4096;
constexpr float RMS_EPS = 1e-6f;
constexpr int NTHREADS = 512, NWAVES = 8;
constexpr int LDS_MAIN = 131072, LDS_BYTES = LDS_MAIN + 16;
#ifndef REP_GEMM
#define REP_GEMM 1
#endif
#ifndef REP_SYNC
#define REP_SYNC 1
#endif
#ifndef REP_EW
#define REP_EW 0
#endif
#ifndef REP_PRO
#define REP_PRO 1
#endif
#ifndef REP_CARRY
#define REP_CARRY 1
#endif
#ifndef REP_BUILD
#define REP_BUILD 1
#endif
#define GSYNC() do { _Pragma("unroll 1") for (int rs_ = 0; rs_ < REP_SYNC; ++rs_) xcd_barrier(xbar, wave); } while (0)
#ifndef REP_ATTN
#define REP_ATTN 1
#endif

constexpr size_t SZ_WGU = (size_t)5632 * 1024 * 2, SZ_WD = (size_t)1024 * 2816 * 2, SZ_WIN = (size_t)4096 * 1024 * 2;
constexpr size_t SZ_WGL = (size_t)1024 * 512 * 2, SZ_WOUT = (size_t)1024 * 1024 * 2, SZ_WO = (size_t)1024 * 1024 * 2;
constexpr size_t OFF_WGU = 0;
constexpr size_t OFF_WD = OFF_WGU + 8 * SZ_WGU;
constexpr size_t OFF_WIN = OFF_WD + 8 * SZ_WD;
constexpr size_t OFF_WGL = OFF_WIN + 4 * SZ_WIN;
constexpr size_t OFF_WOUT = OFF_WGL + 4 * SZ_WGL;
constexpr size_t OFF_WO = OFF_WOUT + 4 * SZ_WOUT;
constexpr size_t SZ_PW1 = (size_t)65 * 64 * 2 * 4;
constexpr size_t SZ_BB1 = (size_t)64 * 16 * 2 * 4;
constexpr size_t SZ_KE1 = (size_t)64 * 256 * 4;
constexpr size_t OFF_PW = OFF_WO + 4 * SZ_WO;
constexpr size_t OFF_BB = OFF_PW + 128 * SZ_PW1;
constexpr size_t OFF_KERN = OFF_BB + 128 * SZ_BB1;
constexpr size_t OFF_W1 = OFF_KERN + 128 * SZ_KE1;
constexpr size_t OFF_W2 = OFF_W1 + (size_t)32 * 256 * 1024 * 2;
constexpr size_t OFF_XN = OFF_W2 + (size_t)32 * 1024 * 1152 * 2;
constexpr size_t OFF_M1 = OFF_XN + (size_t)NTOK * 1024 * 2;
constexpr size_t OFF_SSP = OFF_M1 + (size_t)NTOK * 1024 * 2;
constexpr size_t OFF_RS = OFF_SSP + (size_t)64 * NTOK * 4;
constexpr size_t OFF_OV = OFF_RS + (size_t)NTOK * 4;
constexpr size_t OFF_H = OFF_OV;
constexpr size_t OFF_U = OFF_OV;
constexpr size_t OFF_Q = OFF_U + (size_t)32 * 1024 * 1152 * 2;
constexpr size_t OFF_K = OFF_Q + (size_t)NTOK * 512 * 2;
constexpr size_t OFF_VT = OFF_K + (size_t)NTOK * 512 * 2;
constexpr size_t OFF_SB = OFF_VT + (size_t)NTOK * 512 * 2;
constexpr size_t OFF_S = OFF_SB + (size_t)NTOK * 1024 * 2;
constexpr size_t OV_MIX = OFF_S + (size_t)32 * 1024 * 128 * 4 - OFF_OV;
constexpr size_t OV_FFN = (size_t)NTOK * 2816 * 2;
constexpr size_t OFF_BAR = OFF_OV + (OV_MIX > OV_FFN ? OV_MIX : OV_FFN);
constexpr size_t BAR_BYTES = 32768;
constexpr size_t WS_END = OFF_BAR + BAR_BYTES;

DI const char* uni_ptr(const char* p) { const unsigned long long v = (unsigned long long)p; const unsigned lo = __builtin_amdgcn_readfirstlane((unsigned)v), hi = __builtin_amdgcn_readfirstlane((unsigned)(v >> 32)); return (const char*)(((unsigned long long)hi << 32) | lo); }
DI int opaque_tid(int wave_s) { int t = wave_s * 64 + (int)__builtin_amdgcn_mbcnt_hi(~0u, __builtin_amdgcn_mbcnt_lo(~0u, 0u)); asm volatile("" : "+v"(t)); return t; }
DI unsigned pk2(float a, float b) { f32x2 v = {a, b}; bf2_t r = __builtin_convertvector(v, bf2_t); return __builtin_bit_cast(unsigned, r); }
DI float bflo(unsigned u) { return __uint_as_float(u << 16); }
DI float bfhi(unsigned u) { return __uint_as_float(u & 0xffff0000u); }
DI float shx(float v, int lane, int o) { return __int_as_float(__builtin_amdgcn_ds_bpermute((lane ^ o) << 2, __float_as_int(v))); }
DI float wave_sum(float v, int lane) {
#pragma unroll
    for (int o = 1; o < 64; o <<= 1) v += shx(v, lane, o);
    return v;
}
DI float fsigmoid(float x) { return __builtin_amdgcn_rcpf(1.f + __expf(-x)); }
DI float fsilu(float x) { return x * fsigmoid(x); }
DI float fgelu_tanh(float x) { return x * fsigmoid(1.5957691216f * (x + 0.044715f * x * x * x)); }
DI u32x4 pack8(const f32x4 a, const f32x4 b) { u32x4 w; w.x = pk2(a[0], a[1]); w.y = pk2(a[2], a[3]); w.z = pk2(b[0], b[1]); w.w = pk2(b[2], b[3]); return w; }
DI void unpack8(const u32x4 w, f32x4& a, f32x4& b) { a = (f32x4){bflo(w.x), bfhi(w.x), bflo(w.y), bfhi(w.y)}; b = (f32x4){bflo(w.z), bfhi(w.z), bflo(w.w), bfhi(w.w)}; }


#define XB_TMO      128
#define XB_XCNT(j)  (256  + 64 * (j))
#define XB_XSUB(j)  (1280 + 64 * (j))
#define XB_XGEN(j)  (2304 + 64 * (j))
#define XB_TOP      3328
#define XB_TOPGEN   3392
#define XCD_BAR_WORDS 3456
#define XB_SPIN_CAP (1u << 20)
DI unsigned xb_ld(unsigned* p)              { return __hip_atomic_load(p, __ATOMIC_RELAXED, __HIP_MEMORY_SCOPE_AGENT); }
DI unsigned xb_add(unsigned* p, unsigned v) { return __hip_atomic_fetch_add(p, v, __ATOMIC_RELAXED, __HIP_MEMORY_SCOPE_AGENT); }
DI unsigned xb_xcc_id() { return (unsigned)__builtin_amdgcn_s_getreg((3 << 11) | 20) & 0xFu; }
#define XB_SPIN(cond, bar) do { unsigned _sp = 0; while (cond) { __builtin_amdgcn_s_sleep(1); \
    if ((++_sp & 255u) == 0u) { if (xb_ld(&(bar)[XB_TMO])) break; if (_sp > XB_SPIN_CAP) { atomicAdd(&(bar)[XB_TMO], 1u); break; } } } } while (0)
struct XcdBarrier { unsigned* bar; unsigned x; volatile LAS unsigned* st; };
DI void xcd_barrier_complete(unsigned* bar, unsigned x, unsigned& nloc, unsigned& nx) {
    const unsigned G = gridDim.x;
    unsigned sum, cnt, mine, sp = 0u;
    for (;;) {
        sum = 0u; cnt = 0u; mine = 0u;
#pragma unroll
        for (unsigned j = 0; j < 16; ++j) { const unsigned c = xb_ld(&bar[XB_XCNT(j)]); sum += c; cnt += (c > 0u) ? 1u : 0u; mine = (j == x) ? c : mine; }
        if (sum == G) break;
        __builtin_amdgcn_s_sleep(1);
        if ((++sp & 255u) == 0u) { if (xb_ld(&bar[XB_TMO])) break; if (sp > XB_SPIN_CAP) { atomicAdd(&bar[XB_TMO], 1u); break; } }
    }
    nloc = mine > 0u ? mine : 1u; nx = cnt > 0u ? cnt : 1u;
}
DI void xcd_barrier(const XcdBarrier& b, int wave_s) {
    asm volatile("s_waitcnt vmcnt(0)" ::: "memory");
    __syncthreads();
    if (opaque_tid(wave_s) == 0) {
        unsigned* bar = b.bar;
        __builtin_amdgcn_s_waitcnt(0);
        unsigned nloc = b.st[0], nx = b.st[1];
        if (nloc == 0u) { xcd_barrier_complete(bar, b.x, nloc, nx); b.st[0] = nloc; b.st[1] = nx; }
        const unsigned old = xb_add(&bar[XB_XSUB(b.x)], 1u);
        const unsigned gen = old / nloc;
        if (old + 1u == (gen + 1u) * nloc) {
            __builtin_amdgcn_fence(__ATOMIC_RELEASE, "agent");
            asm volatile("s_waitcnt vmcnt(0)" ::: "memory");
            const unsigned og = xb_add(&bar[XB_TOP], 1u);
            const unsigned tg = og / nx;
            if (og + 1u == (tg + 1u) * nx) xb_add(&bar[XB_TOPGEN], 1u);
            else XB_SPIN(xb_ld(&bar[XB_TOPGEN]) == tg, bar);
            __builtin_amdgcn_fence(__ATOMIC_ACQUIRE, "agent");
            xb_add(&bar[XB_XGEN(b.x)], 1u);
            asm volatile("s_waitcnt vmcnt(0)" ::: "memory");
        } else {
            XB_SPIN(xb_ld(&bar[XB_XGEN(b.x)]) == gen, bar);
            __builtin_amdgcn_fence(__ATOMIC_ACQUIRE, "agent");
            asm volatile("s_waitcnt vmcnt(0)" ::: "memory");
        }
    }
    __syncthreads();
}

DI void vx_barrier(unsigned* cnt, unsigned target, int wave_s) {
    asm volatile("s_waitcnt vmcnt(0)" ::: "memory");
    __syncthreads();
    if (opaque_tid(wave_s) == 0) {
        __builtin_amdgcn_s_waitcnt(0);
        (void)xb_add(cnt, 1u);
        unsigned sp = 0u;
        while (xb_ld(cnt) < target) { __builtin_amdgcn_s_sleep(1); if (++sp > (1u << 22)) break; }
        __builtin_amdgcn_fence(__ATOMIC_ACQUIRE, "agent");
        asm volatile("s_waitcnt vmcnt(0)" ::: "memory");
    }
    __syncthreads();
}

namespace pg8 {
constexpr int BM = 256, BK = 64, HALF = 128, HTB = HALF * BK * 2, STAGE_BYTES = 8 * HTB, NXCD = 8, WGM = 8;
DI int lds_byte(int r, int c) { const int st = (r >> 4) * 2 + (c >> 5), rr = r & 15, cc = c & 31, ob = rr * 64 + cc * 2; return st * 1024 + (ob ^ (((ob >> 9) & 1) << 5)); }
DI void stage_rc(int b, int& R, int& C) { const int st = b / 1024, sb = b % 1024, swz = sb ^ (((sb >> 9) & 1) << 5); R = (st >> 1) * 16 + swz / 64; C = (st & 1) * 32 + (swz % 64) / 2; }
DI int perm32(int rho) { const int n = rho >> 4, i = rho & 15; return 8 * (i >> 2) + 4 * n + (i & 3); }

struct Unit { int pm, pn, pb; };
struct Gemm { const char* A; const char* B; int lda, ldb; size_t a_pm, a_pb, b_pn, b_pb; int nt0, ntstep; };
struct Order {
    int nM, nN, nB, nwg, G, c, mode;
    DI void init(int nM_, int nN_, int nB_, int mode_, int G_, int c_) { nM = nM_; nN = nN_; nB = nB_; mode = mode_; nwg = nM * nN * nB; G = G_; c = c_; }
    DI bool next(int i, Unit& u) const {
        const long L = (long)i * G + c; if (L >= nwg) return false;
        if (mode == 0) {
            int wgid = (int)L; { const int q = nwg / NXCD, r = nwg % NXCD, xcd = wgid % NXCD, off = wgid / NXCD; wgid = (xcd < r ? xcd * (q + 1) : r * (q + 1) + (xcd - r) * q) + off; }
            const int nig = WGM * nN, gid = wgid / nig, fm = gid * WGM, gsz = (nM - fm) < WGM ? (nM - fm) : WGM;
            u.pm = fm + ((wgid % nig) % gsz); u.pn = (wgid % nig) / gsz; u.pb = 0;
        } else {
            const int per = nM * nN, l = (int)L; u.pb = l / per; const int rem = l % per; u.pm = rem / nN; int pn = rem % nN;
            if (mode == 2 && (i & 1)) pn = nN - 1 - pn;
            u.pn = pn;
        }
        u.pm = __builtin_amdgcn_readfirstlane(u.pm); u.pn = __builtin_amdgcn_readfirstlane(u.pn); u.pb = __builtin_amdgcn_readfirstlane(u.pb);
        return true;
    }
};

template <class Epi>
DI void gemm_phase(LAS unsigned char* lds, const Gemm g, const Order& S, const Epi& E, int wave_s) {
    const int tid = opaque_tid(wave_s);
    const int wid = __builtin_amdgcn_readfirstlane(tid >> 6), lane = tid & 63, wr = wid >> 2, wc = wid & 3, fr = lane & 15, fq = lane >> 4;
    unsigned voffA[2], voffB[2];
#pragma unroll
    for (int i = 0; i < 2; ++i) { int R, C; stage_rc(tid * 16 + i * 8192, R, C); const int Rb = (R & ~31) + perm32(R & 31);
        voffA[i] = (unsigned)(R * g.lda + C) * 2u; voffB[i] = (unsigned)(Rb * g.ldb + C) * 2u; }
    const size_t kstep = (size_t)(BK * 2);
    const size_t hstepA = (size_t)HALF * g.lda * 2, hstepB = (size_t)HALF * g.ldb * 2;
    const unsigned ldsw = (unsigned)wid * 1024u;
    const int aoff = lds_byte(wr * 64 + fr, fq * 8), boff = lds_byte(wc * 32 + fr, fq * 8);
#define PG8_SA(b, h) (((b) * 2 + (h)) * HTB)
#define PG8_SB(b, h) ((4 + (b) * 2 + (h)) * HTB)
#define PG8_STAGE(bufoff, gbase, voff) do { _Pragma("unroll") for (int _i = 0; _i < 2; ++_i) \
        __builtin_amdgcn_global_load_lds((const unsigned*)((const char*)(gbase) + (voff)[_i]), (LAS unsigned*)(lds + (bufoff) + ldsw + _i * 8192), 16, 0, 0); } while (0)
#define PG8_LDA(dst, b, h) do { _Pragma("unroll") for (int m = 0; m < 4; ++m) _Pragma("unroll") for (int k = 0; k < 2; ++k) dst[m][k] = *(const LAS bf16x8*)(lds + PG8_SA(b, h) + aoff + m * 2048 + k * 1024); } while (0)
#define PG8_LDB(dst, b, h) do { _Pragma("unroll") for (int n = 0; n < 2; ++n) _Pragma("unroll") for (int k = 0; k < 2; ++k) dst[n][k] = *(const LAS bf16x8*)(lds + PG8_SB(b, h) + boff + n * 2048 + k * 1024); } while (0)
#define PG8_MMA(ai, bj, At, Bt) do { __builtin_amdgcn_s_setprio(1); _Pragma("unroll") for (int m = 0; m < 4; ++m) _Pragma("unroll") for (int n = 0; n < 2; ++n) _Pragma("unroll") for (int k = 0; k < 2; ++k) \
        acc[ai][bj][m][n] = __builtin_amdgcn_mfma_f32_16x16x32_bf16(Bt[n][k], At[m][k], acc[ai][bj][m][n], 0, 0, 0); __builtin_amdgcn_s_setprio(0); } while (0)
#define PG8_WAIT_V(n) asm volatile("s_waitcnt vmcnt(" #n ")" ::: "memory")
#define PG8_WAIT_L(n) asm volatile("s_waitcnt lgkmcnt(" #n ")" ::: "memory")
#define PG8_BAR __builtin_amdgcn_s_barrier()
#define PG8_SCHED __builtin_amdgcn_sched_barrier(0)
    Unit cur, nxt; int ui = 0;
    if (!S.next(0, cur)) return;
    f32x4 acc[2][2][4][2];
#pragma unroll
    for (int a = 0; a < 2; ++a)
#pragma unroll
        for (int b = 0; b < 2; ++b)
#pragma unroll
            for (int m = 0; m < 4; ++m)
#pragma unroll
                for (int n = 0; n < 2; ++n) acc[a][b][m][n] = (f32x4){0.f, 0.f, 0.f, 0.f};
    bf16x8 At[4][2], B0[2][2], B1[2][2];
    const char* cA = uni_ptr(g.A + (size_t)cur.pb * g.a_pb + (size_t)cur.pm * g.a_pm);
    const char* cB = uni_ptr(g.B + (size_t)cur.pb * g.b_pb + (size_t)cur.pn * g.b_pn);
    PG8_STAGE(PG8_SB(0, 0), cB, voffB); PG8_STAGE(PG8_SB(0, 1), cB + hstepB, voffB); PG8_STAGE(PG8_SA(0, 0), cA, voffA); PG8_STAGE(PG8_SA(0, 1), cA + hstepA, voffA);
    if (wr == 1) PG8_BAR;
    PG8_WAIT_V(2); PG8_BAR;
    PG8_STAGE(PG8_SB(1, 0), cB + kstep, voffB); PG8_STAGE(PG8_SA(1, 0), cA + kstep, voffA); PG8_STAGE(PG8_SB(1, 1), cB + hstepB + kstep, voffB);
    PG8_WAIT_V(6); PG8_BAR;
    for (;;) {
        const bool has_next = S.next(ui + 1, nxt);
        const char* nA = uni_ptr(has_next ? g.A + (size_t)nxt.pb * g.a_pb + (size_t)nxt.pm * g.a_pm : cA);
        const char* nB = uni_ptr(has_next ? g.B + (size_t)nxt.pb * g.b_pb + (size_t)nxt.pn * g.b_pn : cB);
        const int nt = g.nt0 + g.ntstep * cur.pn;
        for (int t = 0; t < nt; t += 2) {
            const bool last = (t == nt - 2);
            if constexpr (Epi::HAS_MID) { if (t == Epi::TMID) E.mid(acc, cur, wr, wc, fr, fq); }
            const char* a1 = cA + (size_t)(t + 1) * kstep;
            const char* a2 = last ? nA : cA + (size_t)(t + 2) * kstep; const char* b2 = last ? nB : cB + (size_t)(t + 2) * kstep;
            const char* a3 = a2 + kstep; const char* b3 = b2 + kstep;
            PG8_LDB(B0, 0, 0); PG8_LDB(B1, 0, 1); PG8_SCHED; PG8_LDA(At, 0, 0); PG8_STAGE(PG8_SA(1, 1), a1 + hstepA, voffA);
            PG8_WAIT_V(8); PG8_WAIT_L(0); PG8_BAR; PG8_MMA(0, 0, At, B0); PG8_MMA(0, 1, At, B1); PG8_BAR; PG8_SCHED;
            PG8_LDA(At, 0, 1); PG8_STAGE(PG8_SB(0, 0), b2, voffB); PG8_STAGE(PG8_SB(0, 1), b2 + hstepB, voffB); PG8_STAGE(PG8_SA(0, 0), a2, voffA);
            PG8_WAIT_V(8); PG8_WAIT_L(0); PG8_BAR; PG8_MMA(1, 0, At, B0); PG8_MMA(1, 1, At, B1); PG8_BAR; PG8_SCHED;
            PG8_LDB(B0, 1, 0); PG8_LDB(B1, 1, 1); PG8_SCHED; PG8_LDA(At, 1, 0); PG8_STAGE(PG8_SA(0, 1), a2 + hstepA, voffA);
            PG8_WAIT_V(8); PG8_WAIT_L(0); PG8_BAR; PG8_MMA(0, 0, At, B0); PG8_MMA(0, 1, At, B1); PG8_BAR; PG8_SCHED;
            PG8_LDA(At, 1, 1); PG8_STAGE(PG8_SB(1, 0), b3, voffB); PG8_STAGE(PG8_SB(1, 1), b3 + hstepB, voffB); PG8_STAGE(PG8_SA(1, 0), a3, voffA);
            PG8_WAIT_V(8); PG8_WAIT_L(0); PG8_BAR; PG8_MMA(1, 0, At, B0); PG8_MMA(1, 1, At, B1); PG8_BAR; PG8_SCHED;
        }
        if (wr == 0) PG8_BAR;
        E(acc, cur, wr, wc, fr, fq);
        if (!has_next) break;
#pragma unroll
        for (int a = 0; a < 2; ++a)
#pragma unroll
            for (int b = 0; b < 2; ++b)
#pragma unroll
                for (int m = 0; m < 4; ++m)
#pragma unroll
                    for (int n = 0; n < 2; ++n) acc[a][b][m][n] = (f32x4){0.f, 0.f, 0.f, 0.f};
        cur = nxt; cA = nA; cB = nB; ++ui;
        if (wr == 1) PG8_BAR;
    }
    PG8_WAIT_V(0);
    PG8_BAR;
#undef PG8_SA
#undef PG8_SB
#undef PG8_STAGE
#undef PG8_LDA
#undef PG8_LDB
#undef PG8_MMA
#undef PG8_WAIT_V
#undef PG8_WAIT_L
#undef PG8_BAR
#undef PG8_SCHED
}
}
using pg8::Unit;
typedef f32x4 AccT[2][2][4][2];

template <int ACT> struct EpiGated {
    static constexpr bool HAS_MID = false; static constexpr int TMID = -1;
    bf16_t* O; int ldc; const float* rs;
    DI void mid(AccT&, const Unit&, int, int, int, int) const {}
    DI void operator()(const AccT& acc, const Unit& u, int wr, int wc, int fr, int fq) const {
        const int row0 = u.pm * 256 + wr * 64 + fr, col0 = u.pn * 128 + wc * 32 + 8 * fq;
#pragma unroll
        for (int ai = 0; ai < 2; ++ai)
#pragma unroll
            for (int m = 0; m < 4; ++m) {
                f32x4 o[2]; const float rv = rs ? ((const GAS float*)rs)[row0 + ai * 128 + m * 16] : 1.f;
#pragma unroll
                for (int n = 0; n < 2; ++n)
#pragma unroll
                    for (int e = 0; e < 4; e += 2) {
                        const float a0 = acc[ai][0][m][n][e] * rv, b0 = acc[ai][1][m][n][e] * rv, a1 = acc[ai][0][m][n][e + 1] * rv, b1 = acc[ai][1][m][n][e + 1] * rv;
                        const float g0 = ACT == 0 ? a0 : b0, g1 = ACT == 0 ? a1 : b1;
                        const float x0 = 1.f + __builtin_amdgcn_exp2f(fminf(-1.4426950408889634f * g0, 57.f)), x1 = 1.f + __builtin_amdgcn_exp2f(fminf(-1.4426950408889634f * g1, 57.f));
                        const float q = __builtin_amdgcn_rcpf(x0 * x1), s0 = q * x1, s1 = q * x0;
                        o[n][e] = (ACT == 0 ? a0 * b0 : a0) * s0; o[n][e + 1] = (ACT == 0 ? a1 * b1 : a1) * s1; }
                *(GAS u32x4*)(O + (size_t)(row0 + ai * 128 + m * 16) * ldc + col0) = pack8(o[0], o[1]);
            }
    }
};
struct EpiDown {
    static constexpr bool HAS_MID = false; static constexpr int TMID = -1;
    bf16_t* O; float* ssp;
    DI void mid(AccT&, const Unit&, int, int, int, int) const {}
    DI void operator()(const AccT& acc, const Unit& u, int wr, int wc, int fr, int fq) const {
        const int row0 = u.pm * 256 + wr * 64 + fr, col0 = u.pn * 256 + wc * 32 + 8 * fq;
#pragma unroll
        for (int ai = 0; ai < 2; ++ai)
#pragma unroll
            for (int m = 0; m < 4; ++m) {
                const int row = row0 + ai * 128 + m * 16; float ss = 0.f;
#pragma unroll
                for (int bj = 0; bj < 2; ++bj) {
                    const f32x4 v0 = acc[ai][bj][m][0], v1 = acc[ai][bj][m][1];
                    ss += (v0[0] * v0[0] + v0[1] * v0[1]) + (v0[2] * v0[2] + v0[3] * v0[3]) + (v1[0] * v1[0] + v1[1] * v1[1]) + (v1[2] * v1[2] + v1[3] * v1[3]);
                    *(GAS u32x4*)(O + (size_t)row * 1024 + col0 + bj * 128) = pack8(v0, v1);
                }
                ((GAS float*)ssp)[(size_t)(u.pn * 16 + wc * 4 + fq) * NTOK + row] = ss;
            }
    }
};
struct EpiWin {
    static constexpr bool HAS_MID = false; static constexpr int TMID = -1;
    bf16_t *U, *Q, *K, *VT, *R, *SB; const float* rs;
    DI void mid(AccT&, const Unit&, int, int, int, int) const {}
    DI void operator()(AccT& acc, const Unit& u, int wr, int wc, int fr, int fq) const {
        const int row0 = u.pm * 256 + wr * 64 + fr, pn = u.pn;
#pragma unroll
        for (int ai = 0; ai < 2; ++ai)
#pragma unroll
            for (int m = 0; m < 4; ++m) { const float rv = ((const GAS float*)rs)[row0 + ai * 128 + m * 16];
#pragma unroll
                for (int bj = 0; bj < 2; ++bj) { acc[ai][bj][m][0] *= rv; acc[ai][bj][m][1] *= rv; } }
        if (pn < 2) {
#pragma unroll
            for (int ai = 0; ai < 2; ++ai)
#pragma unroll
                for (int m = 0; m < 4; ++m) { const int row = row0 + ai * 128 + m * 16, bc = row >> 6, j = row & 63;
#pragma unroll
                    for (int bj = 0; bj < 2; ++bj) { const int c = pn * 256 + bj * 128 + wc * 32 + 8 * fq, gi = c >> 4, h0 = c & 15;
                        *(GAS u32x4*)(U + ((size_t)gi * 1024 + bc) * 1152 + 128 + j * 16 + h0) = pack8(acc[ai][bj][m][0], acc[ai][bj][m][1]); } }
        } else if (pn < 6) {
            bf16_t* O = pn < 4 ? Q : K; const int cb = (pn & 1) * 256 + wc * 32 + 8 * fq;
#pragma unroll
            for (int ai = 0; ai < 2; ++ai)
#pragma unroll
                for (int m = 0; m < 4; ++m) { const int row = row0 + ai * 128 + m * 16;
#pragma unroll
                    for (int bj = 0; bj < 2; ++bj) *(GAS u32x4*)(O + (size_t)row * 512 + cb + bj * 128) = pack8(acc[ai][bj][m][0], acc[ai][bj][m][1]); }
        } else if (pn < 8) {
#pragma unroll
            for (int ai = 0; ai < 2; ++ai)
#pragma unroll
                for (int m = 0; m < 4; ++m) { const int row = row0 + ai * 128 + m * 16, b = row >> 12, s = row & 4095;
#pragma unroll
                    for (int bj = 0; bj < 2; ++bj) { const int c = (pn - 6) * 256 + bj * 128 + wc * 32 + 8 * fq, hd = c >> 6, d0 = c & 63;
                        GAS bf16_t* o = (GAS bf16_t*)(VT + (((size_t)b * 8 + hd) * 64 + d0) * 4096 + s);
                        const u32x4 w = pack8(acc[ai][bj][m][0], acc[ai][bj][m][1]);
                        o[0 * 4096] = (bf16_t)(w.x & 0xffff); o[1 * 4096] = (bf16_t)(w.x >> 16); o[2 * 4096] = (bf16_t)(w.y & 0xffff); o[3 * 4096] = (bf16_t)(w.y >> 16);
                        o[4 * 4096] = (bf16_t)(w.z & 0xffff); o[5 * 4096] = (bf16_t)(w.z >> 16); o[6 * 4096] = (bf16_t)(w.w & 0xffff); o[7 * 4096] = (bf16_t)(w.w >> 16); } }
        } else {
            const int cb = (pn - 8) * 128 + wc * 32 + 8 * fq;
#pragma unroll
            for (int ai = 0; ai < 2; ++ai)
#pragma unroll
                for (int m = 0; m < 4; ++m) { const int row = row0 + ai * 128 + m * 16; f32x4 r[2], sb[2];
#pragma unroll
                    for (int n = 0; n < 2; ++n)
#pragma unroll
                        for (int e = 0; e < 4; ++e) {
                            const float ea = __builtin_amdgcn_exp2f(fminf(-1.4426950408889634f * acc[ai][0][m][n][e], 57.f)), eb = __builtin_amdgcn_exp2f(fminf(-1.4426950408889634f * acc[ai][1][m][n][e], 57.f));
                            const float pa = 1.f + ea, pb = 1.f + eb, q = __builtin_amdgcn_rcpf(pa * pb); sb[n][e] = q * pa; r[n][e] = q * pb * pb; }
                    *(GAS u32x4*)(R + (size_t)row * 1024 + cb) = pack8(r[0], r[1]);
                    *(GAS u32x4*)(SB + (size_t)row * 1024 + cb) = pack8(sb[0], sb[1]); }
        }
    }
};
struct EpiS {
    static constexpr bool HAS_MID = false; static constexpr int TMID = -1;
    float* S;
    DI void mid(AccT&, const Unit&, int, int, int, int) const {}
    DI void operator()(const AccT& acc, const Unit& u, int wr, int wc, int fr, int fq) const {
        const int row0 = u.pm * 256 + wr * 64 + fr, col0 = wc * 32 + 8 * fq;
#pragma unroll
        for (int ai = 0; ai < 2; ++ai)
#pragma unroll
            for (int m = 0; m < 4; ++m) { GAS float* o = (GAS float*)(S + ((size_t)u.pb * 1024 + row0 + ai * 128 + m * 16) * 128 + col0);
                *(f32x4*)o = acc[ai][0][m][0]; *(GAS f32x4*)(o + 4) = acc[ai][0][m][1]; }
    }
};
struct EpiY {
    static constexpr bool HAS_MID = false; static constexpr int TMID = -1;
    bf16_t* YA;
    DI void mid(AccT&, const Unit&, int, int, int, int) const {}
    DI void operator()(const AccT& acc, const Unit& u, int wr, int wc, int fr, int fq) const {
        const int row0 = u.pm * 256 + wr * 64 + fr;
#pragma unroll
        for (int ai = 0; ai < 2; ++ai)
#pragma unroll
            for (int m = 0; m < 4; ++m) { const int row = row0 + ai * 128 + m * 16;
#pragma unroll
                for (int bj = 0; bj < 2; ++bj) { const int c = u.pn * 256 + bj * 128 + wc * 32 + 8 * fq, t = c >> 4, h0 = c & 15; f32x4 o[2];
#pragma unroll
                    for (int n = 0; n < 2; ++n)
#pragma unroll
                        for (int e = 0; e < 4; ++e) o[n][e] = fgelu_tanh(acc[ai][bj][m][n][e]);
                    *(GAS u32x4*)(YA + ((size_t)row * 64 + t) * 512 + u.pb * 16 + h0) = pack8(o[0], o[1]); } }
    }
};
struct EpiMerge {
    static constexpr bool HAS_MID = true; static constexpr int TMID = 8;
    const bf16_t *R, *SB; bf16_t* O; int wave_s;
    DI void scale(AccT& acc, const Unit& u, int, int, int, int, const bf16_t* P) const {
        const int t_ = opaque_tid(wave_s), wid = __builtin_amdgcn_readfirstlane(t_ >> 6), ln = t_ & 63, wr = wid >> 2, wc = wid & 3, fr = ln & 15, fq = ln >> 4;
        const int row0 = u.pm * 256 + wr * 64 + fr, col0 = u.pn * 256 + wc * 32 + 8 * fq;
#pragma unroll
        for (int ai = 0; ai < 2; ++ai)
#pragma unroll
            for (int m = 0; m < 4; ++m)
#pragma unroll
                for (int bj = 0; bj < 2; ++bj) { const u32x4 w = *(const GAS u32x4*)(P + (size_t)(row0 + ai * 128 + m * 16) * 1024 + col0 + bj * 128); f32x4 a, b; unpack8(w, a, b);
                    acc[ai][bj][m][0] *= a; acc[ai][bj][m][1] *= b; }
    }
    DI void mid(AccT& acc, const Unit& u, int wr, int wc, int fr, int fq) const { scale(acc, u, wr, wc, fr, fq, R); }
    DI void operator()(AccT& acc, const Unit& u, int wr, int wc, int fr, int fq) const {
        scale(acc, u, wr, wc, fr, fq, SB);
        const int row0 = u.pm * 256 + wr * 64 + fr, col0 = u.pn * 256 + wc * 32 + 8 * fq;
#pragma unroll
        for (int ai = 0; ai < 2; ++ai)
#pragma unroll
            for (int m = 0; m < 4; ++m)
#pragma unroll
                for (int bj = 0; bj < 2; ++bj) *(GAS u32x4*)(O + (size_t)(row0 + ai * 128 + m * 16) * 1024 + col0 + bj * 128) = pack8(acc[ai][bj][m][0], acc[ai][bj][m][1]);
    }
};

struct Params { const float* in[20]; float* out; unsigned char* ws; };
enum { I_X = 0, I_GAINS, I_WGATE, I_WUP, I_WDOWN, I_WIN, I_LRE, I_LIM, I_LOGDT, I_BRE, I_BIM, I_CRE, I_CIM, I_DSKIP, I_GLUV, I_GLUG, I_OSSM, I_RELB, I_OATT, I_WO };

DI int map_row(int map, int n) {
    if (map == 0) return n;
    if (map == 1) return 256 * (n >> 7) + (n & 127);
    if (map == 2) return 256 * (n >> 7) + 128 + (n & 127);
    if (n < 2048) return n;
    if (n < 3072) { const int j = n - 2048; return 2048 + 256 * (j >> 7) + (j & 127); }
    const int j = n - 3072; return 2048 + 256 * (j >> 7) + 128 + (j & 127);
}
DI void cvt_item(const float* W, int K, int N, bf16_t* WT, int ldk, int koff, int map, LAS float* scr, int item, int lane, const float* gk = nullptr) {
    const int nblk = N / 32, kb = item / nblk, nb = item % nblk, k0 = 64 * kb, n0 = 32 * nb;
    const float sc = (map == 3 && n0 >= 512 && n0 < 1024) ? 0.125f * 1.4426950408889634f : 1.f;
    { const int kq = lane >> 3, n4 = (lane & 7) * 4;
      f32x4 wv[8];
#pragma unroll
      for (int i = 0; i < 8; ++i) wv[i] = *(const GAS f32x4*)(W + (size_t)(k0 + i * 8 + kq) * N + n0 + n4);
#pragma unroll
      for (int i = 0; i < 8; ++i) { const int kk = i * 8 + kq; const float m = gk ? sc * gk[k0 + kk] : sc;
          scr[kk * 33 + n4] = wv[i][0] * m; scr[kk * 33 + n4 + 1] = wv[i][1] * m; scr[kk * 33 + n4 + 2] = wv[i][2] * m; scr[kk * 33 + n4 + 3] = wv[i][3] * m; } }
    asm volatile("s_waitcnt lgkmcnt(0)" ::: "memory");
    const int c = lane & 7;
#pragma unroll
    for (int j = 0; j < 4; ++j) { const int n = (lane >> 3) + 8 * j; const LAS float* s = scr + (8 * c) * 33 + n;
        u32x4 o; o.x = pk2(s[0 * 33], s[1 * 33]); o.y = pk2(s[2 * 33], s[3 * 33]); o.z = pk2(s[4 * 33], s[5 * 33]); o.w = pk2(s[6 * 33], s[7 * 33]);
        *(GAS u32x4*)(WT + (size_t)map_row(map, n0 + n) * ldk + koff + k0 + 8 * c) = o; }
    asm volatile("s_waitcnt lgkmcnt(0)" ::: "memory");
}
DI void cvt_matrix(const float* W, int K, int N, bf16_t* WT, int ldk, int koff, int map, LAS float* scr, int gw, int NGW, int lane) {
    const int nitems = (K / 64) * (N / 32);
    for (int it = gw; it < nitems; it += NGW) cvt_item(W, K, N, WT, ldk, koff, map, scr, it, lane);
}

DI void s5_tables(const Params& P, LAS unsigned char* lds, int lg) {
    LAS float* pw = (LAS float*)lds;
    LAS float* bb = pw + 65 * 64 * 2;
    LAS float* cc = bb + 64 * 16 * 2;
    LAS float* ff = cc + 16 * 64 * 2;
    const int tid = threadIdx.x;
    unsigned char* ws = P.ws;
    float* gPW = (float*)(ws + OFF_PW + (size_t)lg * SZ_PW1);
    float* gBB = (float*)(ws + OFF_BB + (size_t)lg * SZ_BB1);
    float* gKE = (float*)(ws + OFF_KERN + (size_t)lg * SZ_KE1);
    const double dt = exp((double)P.in[I_LOGDT][lg]);
    const float* lre = P.in[I_LRE] + (size_t)lg * 64; const float* lim = P.in[I_LIM] + (size_t)lg * 64;
    for (int idx = tid; idx < 65 * 64; idx += NTHREADS) {
        const int tau = idx >> 6, p = idx & 63;
        const double lr = lre[p], li = lim[p];
        const float mag = __expf((float)(lr * dt * tau));
        double rev = li * dt * tau * 0.15915494309189535; rev -= rint(rev);
        const float cs = __builtin_amdgcn_cosf((float)rev), sn = __builtin_amdgcn_sinf((float)rev);
        const float re = mag * cs, im = mag * sn;
        pw[idx * 2] = re; pw[idx * 2 + 1] = im; gPW[idx * 2] = re; gPW[idx * 2 + 1] = im;
        if (tau == 1) {
            const double nr = (double)re - 1.0, ni = im, den = lr * lr + li * li;
            ff[p * 2] = (float)((nr * lr + ni * li) / den); ff[p * 2 + 1] = (float)((ni * lr - nr * li) / den);
        }
    }
    __syncthreads();
    const float* bre = P.in[I_BRE] + (size_t)lg * 1024; const float* bim = P.in[I_BIM] + (size_t)lg * 1024;
    const float* cre = P.in[I_CRE] + (size_t)lg * 1024; const float* cim = P.in[I_CIM] + (size_t)lg * 1024;
    for (int idx = tid; idx < 1024; idx += NTHREADS) {
        const int p = idx >> 4;
        const float fr_ = ff[p * 2], fi_ = ff[p * 2 + 1], br = bre[idx], bi = bim[idx];
        const float re = fr_ * br - fi_ * bi, im = fr_ * bi + fi_ * br;
        bb[idx * 2] = re; bb[idx * 2 + 1] = im; gBB[idx * 2] = re; gBB[idx * 2 + 1] = im;
        cc[idx * 2] = cre[idx]; cc[idx * 2 + 1] = cim[idx];
    }
    __syncthreads();
    const float* dsk = P.in[I_DSKIP] + (size_t)lg * 16;
    for (int pair = tid; pair < 1024; pair += NTHREADS) {
        const int tau = pair >> 4, h = pair & 15;
        float a[16];
#pragma unroll
        for (int j = 0; j < 16; ++j) a[j] = 0.f;
        for (int p = 0; p < 64; ++p) {
            const float cr = cc[(h * 64 + p) * 2], ci = cc[(h * 64 + p) * 2 + 1], pr = pw[(tau * 64 + p) * 2], pi = pw[(tau * 64 + p) * 2 + 1];
            const float xr = cr * pr - ci * pi, xi = cr * pi + ci * pr;
#pragma unroll
            for (int j = 0; j < 16; ++j) a[j] += xr * bb[(p * 16 + j) * 2] - xi * bb[(p * 16 + j) * 2 + 1];
        }
        const float dv = dsk[h];
#pragma unroll
        for (int j = 0; j < 16; ++j) gKE[(size_t)pair * 16 + j] = a[j] + ((tau == 0 && j == h) ? dv : 0.f);
    }
    __syncthreads();
}

DI void build_w12(const Params& P, int l, int wave_s) {
    unsigned char* ws = P.ws;
    const float* gPW = (const float*)(ws + OFF_PW) + (size_t)l * 32 * (65 * 64 * 2);
    const float* gBB = (const float*)(ws + OFF_BB) + (size_t)l * 32 * (64 * 16 * 2);
    const float* gKE = (const float*)(ws + OFF_KERN) + (size_t)l * 32 * (64 * 256);
    bf16_t* W1 = (bf16_t*)(ws + OFF_W1); bf16_t* W2 = (bf16_t*)(ws + OFF_W2);
    const int gt = blockIdx.x * NTHREADS + opaque_tid(wave_s), NT = gridDim.x * NTHREADS;
    for (int it = gt; it < 32 * 256 * 128; it += NT) {
        const int kk = it & 127, n = (it >> 7) & 255, g = it >> 15;
        float v[8];
        if (n >= 128) {
#pragma unroll
            for (int e = 0; e < 8; ++e) v[e] = 0.f;
        } else {
            const int p = n & 63, im = n >> 6, j = kk >> 1, h0 = (kk & 1) * 8;
            const float* pwp = gPW + ((size_t)g * 65 + (63 - j)) * 128 + p * 2; const float pr = pwp[0], pi = pwp[1];
            const float* bp = gBB + ((size_t)g * 64 + p) * 32 + h0 * 2;
#pragma unroll
            for (int e = 0; e < 8; ++e) { const float br = bp[e * 2], bi = bp[e * 2 + 1]; v[e] = im ? (pr * bi + pi * br) : (pr * br - pi * bi); }
        }
        u32x4 o; o.x = pk2(v[0], v[1]); o.y = pk2(v[2], v[3]); o.z = pk2(v[4], v[5]); o.w = pk2(v[6], v[7]);
        *(GAS u32x4*)(W1 + (size_t)it * 8) = o;
    }
    const float* cre = P.in[I_CRE] + (size_t)l * 32 * 1024; const float* cim = P.in[I_CIM] + (size_t)l * 32 * 1024;
    for (int it = gt; it < 32 * 1024 * 144; it += NT) {
        const int kk = it % 144, n = (it / 144) & 1023, g = it / (144 * 1024), t = n >> 4, h = n & 15;
        float v[8];
        if (kk < 16) {
            const int im = kk >> 3, p0 = (kk & 7) * 8;
            const float* pwp = gPW + ((size_t)g * 65 + (t + 1)) * 128 + p0 * 2;
            const float* crp = cre + ((size_t)g * 16 + h) * 64 + p0; const float* cip = cim + ((size_t)g * 16 + h) * 64 + p0;
#pragma unroll
            for (int e = 0; e < 8; ++e) { const float cr = crp[e], ci = cip[e], pr = pwp[e * 2], pi = pwp[e * 2 + 1]; v[e] = im ? -(cr * pi + ci * pr) : (cr * pr - ci * pi); }
        } else {
            const int j = (kk - 16) >> 1, h0 = ((kk - 16) & 1) * 8;
            if (j <= t) { const float* kp = gKE + (((size_t)g * 64 + (t - j)) * 16 + h) * 16 + h0;
#pragma unroll
                for (int e = 0; e < 8; ++e) v[e] = kp[e];
            } else {
#pragma unroll
                for (int e = 0; e < 8; ++e) v[e] = 0.f;
            }
        }
        u32x4 o; o.x = pk2(v[0], v[1]); o.y = pk2(v[2], v[3]); o.z = pk2(v[4], v[5]); o.w = pk2(v[6], v[7]);
        *(GAS u32x4*)(W2 + (size_t)it * 8) = o;
    }
}

DI void ew_rows(unsigned char* ws, float* outp, const float* xin, bool first, bool last, float coef, const float* gpost, int rbeg, int rend, int lane) {
    const bf16_t* M1 = (const bf16_t*)(ws + OFF_M1); const float* ssp = (const float*)(ws + OFF_SSP); bf16_t* XB = (bf16_t*)(ws + OFF_XN); float* RS = (float*)(ws + OFF_RS);
    for (int r0 = rbeg; r0 < rend; r0 += 4) {
        f32x4 ssv = {0.f, 0.f, 0.f, 0.f};
        u32x2 xr[4][4], mr[4][4]; f32x4 xf[4][4];
        if (first) {
#pragma unroll
            for (int q = 0; q < 4; ++q)
#pragma unroll
                for (int j = 0; j < 4; ++j) xf[q][j] = *(const GAS f32x4*)(xin + (size_t)(r0 + q) * 1024 + j * 256 + lane * 4);
        } else {
            ssv = *(const GAS f32x4*)(ssp + (size_t)lane * NTOK + r0);
#pragma unroll
            for (int q = 0; q < 4; ++q)
#pragma unroll
                for (int j = 0; j < 4; ++j) { xr[q][j] = *(const GAS u32x2*)(XB + (size_t)(r0 + q) * 1024 + j * 256 + lane * 4); mr[q][j] = *(const GAS u32x2*)(M1 + (size_t)(r0 + q) * 1024 + j * 256 + lane * 4); }
        }
#pragma unroll
        for (int q = 0; q < 4; ++q) {
            const int row = r0 + q;
            f32x4 v[4];
            if (first) {
#pragma unroll
                for (int j = 0; j < 4; ++j) v[j] = xf[q][j];
            } else {
                const float rstd = __builtin_amdgcn_rsqf(wave_sum(ssv[q], lane) * (1.f / 1024.f) + RMS_EPS) * coef;
#pragma unroll
                for (int j = 0; j < 4; ++j) {
                    const u32x2 xw = xr[q][j], w = mr[q][j];
                    const f32x4 gp = *(const GAS f32x4*)(gpost + j * 256 + lane * 4);
                    const f32x4 xv = {bflo(xw.x), bfhi(xw.x), bflo(xw.y), bfhi(xw.y)};
                    const f32x4 mv = {bflo(w.x), bfhi(w.x), bflo(w.y), bfhi(w.y)};
                    v[j] = xv + gp * mv * rstd;
                }
            }
            if (last) {
#pragma unroll
                for (int j = 0; j < 4; ++j) *(GAS f32x4*)(outp + (size_t)row * 1024 + j * 256 + lane * 4) = v[j];
            } else {
                float ss = 0.f;
#pragma unroll
                for (int j = 0; j < 4; ++j) ss += (v[j][0] * v[j][0] + v[j][1] * v[j][1]) + (v[j][2] * v[j][2] + v[j][3] * v[j][3]);
                const float rstd2 = __builtin_amdgcn_rsqf(wave_sum(ss, lane) * (1.f / 1024.f) + RMS_EPS);
                if (lane == 0) ((GAS float*)RS)[row] = rstd2;
#pragma unroll
                for (int j = 0; j < 4; ++j) { u32x2 w; w.x = pk2(v[j][0], v[j][1]); w.y = pk2(v[j][2], v[j][3]);
                    *(GAS u32x2*)(XB + (size_t)row * 1024 + j * 256 + lane * 4) = w; }
            }
        }
    }
}
DI void ew_phase(const Params& P, bool first, bool last, float coef, const float* gpost, int wave_s) {
    const int tid_ = opaque_tid(wave_s), lane = tid_ & 63, wave = __builtin_amdgcn_readfirstlane(tid_ >> 6);
    const int vb = gridDim.x == 256 ? ((int)(blockIdx.x & 7) * 32 + (int)(blockIdx.x >> 3)) : (int)blockIdx.x;
    const int gw = vb * NWAVES + wave, NGW = gridDim.x * NWAVES;
    const int rpw = (NTOK / 4 + NGW - 1) / NGW * 4;
    const int rbeg = gw * rpw, rend = (rbeg + rpw) < NTOK ? (rbeg + rpw) : NTOK;
    ew_rows(P.ws, P.out, P.in[I_X], first, last, coef, gpost, rbeg, rend, lane);
}

DI void carry_phase(const Params& P, int l, int wave_s) {
    const int tid_ = opaque_tid(wave_s), lane = tid_ & 63, wave = __builtin_amdgcn_readfirstlane(tid_ >> 6);
    unsigned char* ws = P.ws;
    const float* gPW = (const float*)(ws + OFF_PW) + (size_t)l * 32 * (65 * 64 * 2);
    const float* S = (const float*)(ws + OFF_S); bf16_t* U = (bf16_t*)(ws + OFF_U);
    const int gw = blockIdx.x * NWAVES + wave, NGW = gridDim.x * NWAVES;
    for (int task = gw; task < 512; task += NGW) {
        const int g = task >> 4, b = task & 15, p = lane;
        const float ar = gPW[((size_t)g * 65 + 64) * 128 + p * 2], ai = gPW[((size_t)g * 65 + 64) * 128 + p * 2 + 1];
        float xr = 0.f, xi = 0.f;
        const GAS float* sp = (const GAS float*)(S + ((size_t)g * 1024 + b * 64) * 128); GAS bf16_t* up = (GAS bf16_t*)(U + ((size_t)g * 1024 + b * 64) * 1152);
#pragma unroll
        for (int c0 = 0; c0 < 64; c0 += 32) {
            float sr[32], si[32];
#pragma unroll
            for (int c = 0; c < 32; ++c) { sr[c] = sp[(c0 + c) * 128 + p]; si[c] = sp[(c0 + c) * 128 + 64 + p]; }
#pragma unroll
            for (int c = 0; c < 32; ++c) {
                up[(size_t)(c0 + c) * 1152 + p] = (bf16_t)(pk2(xr, 0.f) & 0xffff); up[(size_t)(c0 + c) * 1152 + 64 + p] = (bf16_t)(pk2(xi, 0.f) & 0xffff);
                const float nr = ar * xr - ai * xi + sr[c], ni = ar * xi + ai * xr + si[c];
                xr = nr; xi = ni;
            }
        }
    }
}

DI int crow(int reg, int h) { return (reg & 3) + 8 * (reg >> 2) + 4 * h; }
#define MFMA32(a, b, c) __builtin_amdgcn_mfma_f32_32x32x16_bf16((a), (b), (c), 0, 0, 0)
DI bf16x8 pack_step(const f32x16& x, int s) {
    u32x4 p; p.x = pk2(x[8 * s], x[8 * s + 1]); p.y = pk2(x[8 * s + 2], x[8 * s + 3]); p.z = pk2(x[8 * s + 4], x[8 * s + 5]); p.w = pk2(x[8 * s + 6], x[8 * s + 7]);
    return __builtin_bit_cast(bf16x8, p);
}
#define ATTN_STEP(KT, BUF, KREG, VREG) \
            { LAS unsigned char* kb = kbuf + BUF * 9216; LAS unsigned char* vb = vbuf + BUF * 8704; \
            *(LAS u32x4*)(kb + lr * 144 + lsg * 16) = KREG; \
            { u32x2 a; a.x = VREG.x; a.y = VREG.y; u32x2 c; c.x = VREG.z; c.y = VREG.w; \
              *(LAS u32x2*)(vb + lr * 136 + lsg * 16) = a; *(LAS u32x2*)(vb + lr * 136 + lsg * 16 + 8) = c; } \
            __syncthreads(); \
            if (KT + 2 <= kthi) { KREG = *(const GAS u32x4*)(kgp + (size_t)(KT + 2) * 64 * 512); VREG = *(const GAS u32x4*)(vgp + (KT + 2) * 64); } \
            if (KT + 8 >= cc && KT <= cc) { \
                f32x16 s0, s1; \
_Pragma("unroll") \
                for (int i = 0; i < 16; ++i) { s0[i] = 0.f; s1[i] = 0.f; } \
_Pragma("unroll") \
                for (int ks = 0; ks < 4; ++ks) { \
                    const bf16x8 k0 = *(const LAS bf16x8*)(kb + n * 144 + ks * 32 + gq * 16), k1 = *(const LAS bf16x8*)(kb + (32 + n) * 144 + ks * 32 + gq * 16); \
                    s0 = MFMA32(k0, Qf[ks], s0); s1 = MFMA32(k1, Qf[ks], s1); \
                } \
                const int delta = cc - (KT); \
                if (delta < 3) { const int base = 64 * delta + qh * 32 + n + 128; \
_Pragma("unroll") \
                    for (int i = 0; i < 16; ++i) { const int key = crow(i, gq); int i0 = base - key, i1 = base - key - 32; \
                        i0 = i0 > 256 ? 256 : i0; i1 = i1 > 256 ? 256 : i1; i0 = i0 < 0 ? 0 : i0; i1 = i1 < 0 ? 0 : i1; \
                        s0[i] += bth[i0]; s1[i] += bth[i1]; } \
                } \
                float mx = s0[0]; \
_Pragma("unroll") \
                for (int i = 1; i < 16; ++i) mx = fmaxf(mx, s0[i]); \
_Pragma("unroll") \
                for (int i = 0; i < 16; ++i) mx = fmaxf(mx, s1[i]); \
                mx = fmaxf(mx, shx(mx, lane, 32)); \
                const float mnew = fmaxf(mrun, mx), alpha = __builtin_amdgcn_exp2f(mrun - mnew); mrun = mnew; \
                float ps = 0.f; \
_Pragma("unroll") \
                for (int i = 0; i < 16; ++i) { s0[i] = __builtin_amdgcn_exp2f(s0[i] - mnew); s1[i] = __builtin_amdgcn_exp2f(s1[i] - mnew); ps += s0[i] + s1[i]; } \
                lrun = lrun * alpha + ps; \
_Pragma("unroll") \
                for (int i = 0; i < 16; ++i) { O0[i] *= alpha; O1[i] *= alpha; } \
_Pragma("unroll") \
                for (int kg = 0; kg < 2; ++kg) \
_Pragma("unroll") \
                    for (int s = 0; s < 2; ++s) { \
                        const bf16x8 Pf = pack_step(kg == 0 ? s0 : s1, s); \
                        const LAS unsigned char* v0 = vb + n * 136 + 64 * kg + 32 * s + 8 * gq; \
                        const s16x4 lo0 = *(const LAS s16x4*)(v0), hi0 = *(const LAS s16x4*)(v0 + 16); \
                        const s16x4 lo1 = *(const LAS s16x4*)(v0 + 32 * 136), hi1 = *(const LAS s16x4*)(v0 + 32 * 136 + 16); \
                        const bf16x8 V0 = __builtin_shufflevector(lo0, hi0, 0, 1, 2, 3, 4, 5, 6, 7), V1 = __builtin_shufflevector(lo1, hi1, 0, 1, 2, 3, 4, 5, 6, 7); \
                        O0 = MFMA32(V0, Pf, O0); O1 = MFMA32(V1, Pf, O1); \
                    } \
            } }
DI void attn_phase(const Params& P, int l, LAS unsigned char* lds, int wave_s) {
    const int tid_ = opaque_tid(wave_s), lane = tid_ & 63, wave = __builtin_amdgcn_readfirstlane(tid_ >> 6);
    unsigned char* ws = P.ws;
    const bf16_t* Q = (const bf16_t*)(ws + OFF_Q); const bf16_t* K = (const bf16_t*)(ws + OFF_K); const bf16_t* VT = (const bf16_t*)(ws + OFF_VT);
    bf16_t* ZA = (bf16_t*)P.out;
    LAS float* bt = (LAS float*)lds;
    LAS unsigned char* kbuf = lds + 8448;
    LAS unsigned char* vbuf = kbuf + 2 * 9216;
    const float* relb = P.in[I_RELB] + (size_t)l * 8 * 257;
    for (int i = tid_; i < 8 * 257; i += NTHREADS) bt[i] = (relb[i] - relb[(i / 257) * 257 + 256]) * 1.4426950408889634f;
    __syncthreads();
    const int n = lane & 31, gq = lane >> 5;
    const int ci = wave >> 1, qh = wave & 1;
    const int lr = tid_ >> 3, lsg = tid_ & 7;
    for (int it = blockIdx.x; it < 2048; it += gridDim.x) {
        int y = it >> 4, cg4 = ((it & 15) + (it >> 8)) & 15;
        if (gridDim.x == 256) {
            const int r = it >> 8, bxx = it & 255, xvv = bxx & 7, jj = bxx >> 3;
            y = r * 16 + xvv * 2 + (jj >> 4); cg4 = ((jj & 15) + r) & 15;
        }
        const int hd = y & 7, b = y >> 3;
        const int c0 = cg4 * 4, cc = c0 + ci;
        const int ktlo = c0 > 8 ? c0 - 8 : 0, kthi = c0 + 3;
        const size_t tok0 = (size_t)b * SEQ + cc * 64 + qh * 32;
        bf16x8 Qf[4];
        { const bf16_t* qp = Q + (tok0 + n) * 512 + hd * 64 + gq * 8;
#pragma unroll
          for (int ks = 0; ks < 4; ++ks) Qf[ks] = *(const GAS bf16x8*)(qp + ks * 16); }
        f32x16 O0, O1;
#pragma unroll
        for (int i = 0; i < 16; ++i) { O0[i] = 0.f; O1[i] = 0.f; }
        float mrun = -1e30f, lrun = 0.f;
        const LAS float* bth = bt + hd * 257;
        const bf16_t* kgp = K + ((size_t)b * SEQ + lr) * 512 + hd * 64 + lsg * 8;
        const bf16_t* vgp = VT + (((size_t)b * 8 + hd) * 64 + lr) * SEQ + lsg * 8;
        u32x4 kregA = *(const GAS u32x4*)(kgp + (size_t)ktlo * 64 * 512), vregA = *(const GAS u32x4*)(vgp + ktlo * 64);
        u32x4 kregB = *(const GAS u32x4*)(kgp + (size_t)(ktlo + 1) * 64 * 512), vregB = *(const GAS u32x4*)(vgp + (ktlo + 1) * 64);
        for (int kt = ktlo; kt <= kthi; kt += 2) {
            ATTN_STEP(kt, 0, kregA, vregA)
            ATTN_STEP(kt + 1, 1, kregB, vregB)
        }
        lrun += shx(lrun, lane, 32);
        const float inv = 1.f / lrun;
        bf16_t* op = ZA + (tok0 + n) * 1024 + 512 + hd * 64 + gq * 4;
#pragma unroll
        for (int g4 = 0; g4 < 4; ++g4) {
            u32x2 w0, w1;
            w0.x = pk2(O0[4 * g4] * inv, O0[4 * g4 + 1] * inv); w0.y = pk2(O0[4 * g4 + 2] * inv, O0[4 * g4 + 3] * inv);
            w1.x = pk2(O1[4 * g4] * inv, O1[4 * g4 + 1] * inv); w1.y = pk2(O1[4 * g4 + 2] * inv, O1[4 * g4 + 3] * inv);
            *(GAS u32x2*)(op + 8 * g4) = w0; *(GAS u32x2*)(op + 32 + 8 * g4) = w1;
        }
        __syncthreads();
    }
}

__global__ void __launch_bounds__(NTHREADS, 2) mk_fwd(Params P) {
    extern __shared__ __attribute__((aligned(16))) unsigned char lds_raw[];
    LAS unsigned char* lds = (LAS unsigned char*)lds_raw;
    cg::grid_group grid = cg::this_grid();
    const int tid = threadIdx.x, lane = tid & 63, wave = __builtin_amdgcn_readfirstlane(tid >> 6);
    const int G = gridDim.x, bx = blockIdx.x;
    unsigned char* ws = P.ws;
    const int gw = bx * NWAVES + wave, NGW = G * NWAVES;
    volatile LAS unsigned* xst = (volatile LAS unsigned*)(lds + LDS_MAIN);
    if (tid == 0) { xst[0] = 0u; xst[1] = 0u; }
    __syncthreads();
    XcdBarrier xbar; xbar.bar = (unsigned*)(ws + OFF_BAR); xbar.x = xb_xcc_id(); xbar.st = xst;
    if (tid == 0) (void)xb_add(&xbar.bar[XB_XCNT(xbar.x)], 1u);

    {
        _Pragma("unroll 1") for (int rp_ = 0; rp_ < REP_PRO; ++rp_) {
        for (int lg = bx; lg < 128; lg += G) s5_tables(P, lds, lg);
        __syncthreads();
        LAS float* scr = (LAS float*)(lds + wave * 8704);
        for (int it = gw; it < 4 * 11776; it += NGW) {
            const int l = it / 11776; int r = it - l * 11776;
            if (r < 6 * 1408) {
                const int which = r / 1408, f = which & 1, kind = which >> 1; r -= which * 1408;
                bf16_t* wgu = (bf16_t*)(ws + OFF_WGU + (size_t)(l * 2 + f) * SZ_WGU);
                const float* gk = P.in[I_GAINS] + (size_t)(l * 6 + 4 * f) * 1024;
                if (kind == 0) cvt_item(P.in[I_WGATE] + (size_t)(l * 2 + f) * 1024 * 2816, 1024, 2816, wgu, 1024, 0, 1, scr, r, lane, gk);
                else if (kind == 1) cvt_item(P.in[I_WUP] + (size_t)(l * 2 + f) * 1024 * 2816, 1024, 2816, wgu, 1024, 0, 2, scr, r, lane, gk);
                else cvt_item(P.in[I_WDOWN] + (size_t)(l * 2 + f) * 2816 * 1024, 2816, 1024, (bf16_t*)(ws + OFF_WD + (size_t)(l * 2 + f) * SZ_WD), 2816, 0, 0, scr, r, lane);
                continue;
            }
            r -= 6 * 1408;
            if (r < 2048) { cvt_item(P.in[I_WIN] + (size_t)l * 1024 * 4096, 1024, 4096, (bf16_t*)(ws + OFF_WIN + (size_t)l * SZ_WIN), 1024, 0, 3, scr, r, lane, P.in[I_GAINS] + (size_t)(l * 6 + 2) * 1024); continue; }
            r -= 2048;
            if (r < 256) { const int gsel = r >> 7; r &= 127;
                cvt_item(P.in[gsel ? I_GLUG : I_GLUV] + (size_t)l * 512 * 512, 512, 512, (bf16_t*)(ws + OFF_WGL + (size_t)l * SZ_WGL), 512, 0, 1 + gsel, scr, r, lane); continue; }
            r -= 256;
            if (r < 512) { const int osel = r >> 8; r &= 255;
                cvt_item(P.in[osel ? I_OATT : I_OSSM] + (size_t)l * 512 * 1024, 512, 1024, (bf16_t*)(ws + OFF_WOUT + (size_t)l * SZ_WOUT), 1024, osel * 512, 0, scr, r, lane); continue; }
            r -= 512;
            cvt_item(P.in[I_WO] + (size_t)l * 1024 * 1024, 1024, 1024, (bf16_t*)(ws + OFF_WO + (size_t)l * SZ_WO), 1024, 0, 0, scr, r, lane);
        }
        __syncthreads();
        }
        ew_phase(P, true, false, 0.f, nullptr, wave);
        __syncthreads();
    }
    if (tid == 0) __hip_atomic_store((unsigned*)(ws + OFF_BAR) + 4096 + bx, xb_xcc_id(), __ATOMIC_RELAXED, __HIP_MEMORY_SCOPE_AGENT);
    grid.sync();

    bool local_ok = (G == 256);
    if (local_ok) {
        unsigned* xt = (unsigned*)(ws + OFF_BAR) + 4096;
        const int ok = (tid < 256) ? (xb_ld(xt + tid) == xb_ld(xt + (tid & 7))) : 1;
        local_ok = __syncthreads_and(ok) != 0;
    }
    unsigned* vxcnt = (unsigned*)(ws + OFF_BAR) + 3456 + 64 * (bx & 7);
    unsigned vxgen = 0u;
#define LSYNC() do { if (local_ok) { vxgen += 32u; vx_barrier(vxcnt, vxgen, wave); } else { GSYNC(); } } while (0)
    for (int step = 0; step < 12; ++step) {
        const int l = step / 3, s = step % 3;
        unsigned char* ws = P.ws; asm volatile("" : "+s"(ws));
        pg8::Gemm gfin;
        if (s != 1) {
            const int f = s >> 1;
            pg8::Gemm g{(const char*)(ws + OFF_XN), (const char*)(ws + OFF_WGU + (size_t)(l * 2 + f) * SZ_WGU), 1024, 1024, (size_t)256 * 1024 * 2, 0, (size_t)256 * 1024 * 2, 0, 16, 0};
            pg8::Order S; S.init(256, 22, 1, 0, G, bx);
            EpiGated<0> E{(bf16_t*)(ws + OFF_H), 2816, (const float*)(ws + OFF_RS)};
            _Pragma("unroll 1") for (int rep_ = 0; rep_ < REP_GEMM; ++rep_) pg8::gemm_phase(lds, g, S, E, wave);
            LSYNC();
            gfin = pg8::Gemm{(const char*)(ws + OFF_H), (const char*)(ws + OFF_WD + (size_t)(l * 2 + f) * SZ_WD), 2816, 2816, (size_t)256 * 2816 * 2, 0, (size_t)256 * 2816 * 2, 0, 44, 0};
        } else {
            {
                pg8::Gemm g{(const char*)(ws + OFF_XN), (const char*)(ws + OFF_WIN + (size_t)l * SZ_WIN), 1024, 1024, (size_t)256 * 1024 * 2, 0, (size_t)256 * 1024 * 2, 0, 16, 0};
                pg8::Order S; S.init(256, 16, 1, 0, G, bx);
                EpiWin E{(bf16_t*)(ws + OFF_U), (bf16_t*)(ws + OFF_Q), (bf16_t*)(ws + OFF_K), (bf16_t*)(ws + OFF_VT), (bf16_t*)(ws + OFF_M1), (bf16_t*)(ws + OFF_SB), (const float*)(ws + OFF_RS)};
                _Pragma("unroll 1") for (int rep_ = 0; rep_ < REP_GEMM; ++rep_) pg8::gemm_phase(lds, g, S, E, wave);
            }
            GSYNC();
            {
                pg8::Gemm g{(const char*)(ws + OFF_U) + 256, (const char*)(ws + OFF_W1), 1152, 1024, (size_t)256 * 1152 * 2, (size_t)1024 * 1152 * 2, 0, (size_t)256 * 1024 * 2, 16, 0};
                pg8::Order S; S.init(4, 1, 32, 1, G, bx);
                EpiS E{(float*)(ws + OFF_S)};
                _Pragma("unroll 1") for (int rep_ = 0; rep_ < REP_GEMM; ++rep_) pg8::gemm_phase(lds, g, S, E, wave);
                __syncthreads();
                _Pragma("unroll 1") for (int rep_ = 0; rep_ < REP_ATTN; ++rep_) attn_phase(P, l, lds, wave);
            }
            GSYNC();
            _Pragma("unroll 1") for (int rc_ = 0; rc_ < REP_CARRY; ++rc_) carry_phase(P, l, wave);
            GSYNC();
            {
                pg8::Gemm g{(const char*)(ws + OFF_U), (const char*)(ws + OFF_W2), 1152, 1152, (size_t)256 * 1152 * 2, (size_t)1024 * 1152 * 2, (size_t)256 * 1152 * 2, (size_t)1024 * 1152 * 2, 6, 4};
                pg8::Order S; S.init(4, 4, 32, 2, G, bx);
                EpiY E{(bf16_t*)(ws + OFF_Q)};
                _Pragma("unroll 1") for (int rep_ = 0; rep_ < REP_GEMM; ++rep_) pg8::gemm_phase(lds, g, S, E, wave);
            }
            GSYNC();
            {
                pg8::Gemm g{(const char*)(ws + OFF_Q), (const char*)(ws + OFF_WGL + (size_t)l * SZ_WGL), 512, 512, (size_t)256 * 512 * 2, 0, (size_t)256 * 512 * 2, 0, 8, 0};
                pg8::Order S; S.init(256, 4, 1, 0, G, bx);
                EpiGated<1> E{(bf16_t*)P.out, 1024, nullptr};
                _Pragma("unroll 1") for (int rep_ = 0; rep_ < REP_GEMM; ++rep_) pg8::gemm_phase(lds, g, S, E, wave);
            }
            LSYNC();
            {
                pg8::Gemm g{(const char*)P.out, (const char*)(ws + OFF_WOUT + (size_t)l * SZ_WOUT), 1024, 1024, (size_t)256 * 1024 * 2, 0, (size_t)256 * 1024 * 2, 0, 16, 0};
                pg8::Order S; S.init(256, 4, 1, 0, G, bx);
                EpiMerge E{(const bf16_t*)(ws + OFF_M1), (const bf16_t*)(ws + OFF_SB), (bf16_t*)(ws + OFF_K), wave};
                _Pragma("unroll 1") for (int rep_ = 0; rep_ < REP_GEMM; ++rep_) pg8::gemm_phase(lds, g, S, E, wave);
            }
            LSYNC();
            gfin = pg8::Gemm{(const char*)(ws + OFF_K), (const char*)(ws + OFF_WO + (size_t)l * SZ_WO), 1024, 1024, (size_t)256 * 1024 * 2, 0, (size_t)256 * 1024 * 2, 0, 16, 0};
        }
        {
            pg8::Order S; S.init(256, 4, 1, 0, G, bx);
            EpiDown E{(bf16_t*)(ws + OFF_M1), (float*)(ws + OFF_SSP)};
            _Pragma("unroll 1") for (int rep_ = 0; rep_ < REP_GEMM; ++rep_) pg8::gemm_phase(lds, gfin, S, E, wave);
        }
        LSYNC();
        {
            const float* gains = P.in[I_GAINS];
            ew_phase(P, false, step == 11, s == 1 ? 1.f : 0.5f, gains + (size_t)(2 * step + 1) * 1024, wave);
            if (s == 0) { _Pragma("unroll 1") for (int rb_ = 0; rb_ < REP_BUILD; ++rb_) build_w12(P, l, wave); }
        }
        if (step != 11) { if (s == 2) LSYNC(); else GSYNC(); }
    }
}

extern "C" void kernel_launch(void* const* d_in, const int* in_sizes, int n_in, void* d_out, int out_size, void* d_ws, size_t ws_size, hipStream_t stream) {
    static int grid = 0;
    if (grid == 0) {
        if (n_in != 20 || out_size != NTOK * DM || ws_size < WS_END) { fprintf(stderr, "kernel_launch: unexpected shapes: n_in %d out %d ws %zu (need %zu)\n", n_in, out_size, ws_size, (size_t)WS_END); grid = -1; return; }
        int dev = 0, cus = 0, per_cu = 0;
        hipGetDevice(&dev);
        hipDeviceGetAttribute(&cus, hipDeviceAttributeMultiprocessorCount, dev);
        if (hipFuncSetAttribute((const void*)mk_fwd, hipFuncAttributeMaxDynamicSharedMemorySize, LDS_BYTES) != hipSuccess) { fprintf(stderr, "kernel_launch: hipFuncSetAttribute failed\n"); grid = -1; return; }
        if (hipOccupancyMaxActiveBlocksPerMultiprocessor(&per_cu, (const void*)mk_fwd, NTHREADS, LDS_BYTES) != hipSuccess || per_cu < 1) { fprintf(stderr, "kernel_launch: occupancy query failed (%d)\n", per_cu); per_cu = 1; }
        (void)hipGetLastError();
        grid = cus * per_cu;
    }
    if (grid < 0) return;
    if (hipMemsetAsync((char*)d_ws + OFF_BAR, 0, BAR_BYTES, stream) != hipSuccess) { fprintf(stderr, "kernel_launch: memset failed\n"); return; }
    Params p{};
    for (int i = 0; i < 20; ++i) p.in[i] = (const float*)d_in[i];
    p.out = (float*)d_out; p.ws = (unsigned char*)d_ws;
    void* args[] = {&p};
    hipError_t e = hipLaunchCooperativeKernel((const void*)mk_fwd, dim3(grid), dim3(NTHREADS), args, LDS_BYTES, stream);
    if (e != hipSuccess) fprintf(stderr, "cooperative launch failed: %s (grid %d)\n", hipGetErrorString(e), grid);
}
```
